# Optimizing an MI355X kernel written in HIP

```python
import jax
import jax.numpy as jnp
from jax import lax
import numpy as np

D_MODEL = 1024
BATCH = 4
SEQ = 4096
DEPTH = 2
DEC_BATCH = 128
DEC_SEQ = 8
PAST_LEN = 2048
PAGE_SIZE = 128

N_EVEN = (DEPTH + 1) // 2
N_ODD = DEPTH // 2
EPS = 1e-6
F32 = jnp.float32
A_HEADS = 4
A_DK = 128
A_DV = 128
A_CONV = 4
A_CHUNK = 64
A_QK = A_HEADS * A_DK
A_V = A_HEADS * A_DV
A_CONV_DIM = 2 * A_QK + A_V
A_IN = A_CONV_DIM + A_V + 2 * A_HEADS
B_WIDTH = D_MODEL // 2
B_CONV = 3
B_IN = 3 * B_WIDTH
C_HEADS = 8
C_KV_HEADS = 2
C_HD = 64
C_CMP_STRIDE = 16
C_CMP_LEN = 2 * C_CMP_STRIDE
C_CMP_HID = 2 * C_HD
C_SEL_LEN = 64
C_TOPN = 16
C_WINDOW = 512
C_QBLK = 128
C_Q = C_HEADS * C_HD
C_GATES = 3 * C_HEADS
C_IN = C_Q + C_GATES + 3 * 2 * C_KV_HEADS * C_HD
D_GROUPS = 8
D_WIDTH = D_MODEL // 2
D_CHUNK = 128
D_IN = 2 * D_WIDTH
D_FF = 2816
EVEN_IN = A_IN + B_IN
EVEN_OUT = A_V + B_WIDTH
ODD_IN = C_IN + D_IN
ODD_OUT = C_Q + D_WIDTH
BIG = 1e4
NEG = -1e30

kernel_name = 'hybrid_gdn_shortconv_nsa_chunkmlp_step'


def rmsnorm(x, g):
    xf = x.astype(F32)
    y = xf * lax.rsqrt(jnp.mean(xf * xf, axis=-1, keepdims=True) + EPS)
    return (y * g.astype(F32)).astype(x.dtype)


def l2norm(x):
    x = x.astype(F32)
    return x * lax.rsqrt(jnp.sum(x * x, axis=-1, keepdims=True) + EPS)


def swiglu(x, w_gate, w_up, w_down):
    return (jax.nn.silu(x @ w_gate) * (x @ w_up)) @ w_down


def masked_softmax(s, mask):
    s = jnp.where(mask, s, NEG)
    m = jnp.max(s, axis=-1, keepdims=True)
    e = jnp.where(mask, jnp.exp(s - m), 0.0)
    return e / jnp.maximum(jnp.sum(e, axis=-1, keepdims=True), 1e-30)


def alibi_slopes():
    return 2.0 ** (-8.0 * jnp.arange(1, C_HEADS + 1, dtype=F32) / C_HEADS)


def causal_dwconv(x, buf, w):
    T = x.shape[1]
    K = w.shape[0]
    xp = jnp.concatenate([buf.astype(x.dtype), x], axis=1)
    y = sum(xp[:, i:i + T] * w[i] for i in range(K))
    return y, xp[:, T:]


def gated_delta_rule(q, k, v, g, beta, s0):
    B, T, H, _ = q.shape
    C = A_CHUNK if T >= A_CHUNK else T
    pad = (-T) % C
    padt = lambda a: jnp.pad(a, [(0, 0), (0, pad)] + [(0, 0)] * (a.ndim - 2))
    N = (T + pad) // C
    chunks = lambda a: jnp.moveaxis(padt(a).astype(F32).reshape((B, N, C) + a.shape[2:]), 3, 1)
    qc, kc, vc = chunks(q), chunks(k), chunks(v)
    gc = jnp.cumsum(chunks(g), axis=-1)
    bc = chunks(beta)
    tri_incl = jnp.tril(jnp.ones((C, C), bool))
    tri_strict = jnp.tril(jnp.ones((C, C), bool), -1)
    dmask = jnp.where(tri_incl, jnp.exp(jnp.where(tri_incl, gc[..., :, None] - gc[..., None, :], 0.0)), 0.0)
    kb = kc * bc[..., None]
    vb = vc * bc[..., None]
    a_mat = jnp.where(tri_strict, jnp.einsum('bhncd,bhnsd->bhncs', kb, kc) * dmask, 0.0)
    eye = jnp.eye(C, dtype=F32)
    t_mat = lax.linalg.triangular_solve(eye + a_mat, jnp.broadcast_to(eye, a_mat.shape),
                                        left_side=True, lower=True, unit_diagonal=True)
    u = jnp.einsum('bhncs,bhnsd->bhncd', t_mat, vb)
    w = jnp.einsum('bhncs,bhnsd->bhncd', t_mat, kb * jnp.exp(gc)[..., None])
    intra = jnp.where(tri_incl, jnp.einsum('bhncd,bhnsd->bhncs', qc, kc) * dmask, 0.0)
    g_last = gc[..., -1]
    k_tail = kc * jnp.exp(g_last[..., None] - gc)[..., None]
    q_dec = qc * jnp.exp(gc)[..., None]

    def step(s, inp):
        w_n, u_n, qd_n, in_n, kt_n, gl_n = inp
        v_new = u_n - jnp.einsum('bhcd,bhde->bhce', w_n, s)
        o = jnp.einsum('bhcd,bhde->bhce', qd_n, s) + jnp.einsum('bhcs,bhse->bhce', in_n, v_new)
        s = s * jnp.exp(gl_n)[..., None, None] + jnp.einsum('bhcd,bhce->bhde', kt_n, v_new)
        return s, o

    xs = tuple(jnp.moveaxis(a, 2, 0) for a in (w, u, q_dec, intra, k_tail, g_last))
    s_fin, o = lax.scan(step, s0.astype(F32), xs)
    o = jnp.transpose(o, (1, 0, 3, 2, 4)).reshape(B, N * C, H, -1)[:, :T]
    return o, s_fin


def gdn_mixer(p, conv_buf, s0, w_conv, a_log, dt_bias, g_norm):
    B, T, _ = p.shape
    qkv, conv_new = causal_dwconv(p[..., :A_CONV_DIM], conv_buf, w_conv)
    qkv = jax.nn.silu(qkv.astype(F32))
    q = l2norm(qkv[..., :A_QK].reshape(B, T, A_HEADS, A_DK)) * (A_DK ** -0.5)
    k = l2norm(qkv[..., A_QK:2 * A_QK].reshape(B, T, A_HEADS, A_DK))
    v = qkv[..., 2 * A_QK:].reshape(B, T, A_HEADS, A_DV)
    z = p[..., A_CONV_DIM:A_CONV_DIM + A_V].reshape(B, T, A_HEADS, A_DV).astype(F32)
    b = p[..., A_CONV_DIM + A_V:A_CONV_DIM + A_V + A_HEADS].astype(F32)
    a = p[..., A_CONV_DIM + A_V + A_HEADS:].astype(F32)
    beta = jax.nn.sigmoid(b)
    g = -jnp.exp(a_log.astype(F32)) * jax.nn.softplus(a + dt_bias.astype(F32))
    o, s = gated_delta_rule(q, k, v, g, beta, s0)
    o = rmsnorm(o, g_norm) * jax.nn.silu(z)
    return o.reshape(B, T, A_V), s, conv_new


def shortconv_mixer(p, conv_buf, w_conv):
    h = p[..., :B_WIDTH]
    gate_b = p[..., B_WIDTH:2 * B_WIDTH]
    gate_c = p[..., 2 * B_WIDTH:]
    y, conv_new = causal_dwconv(gate_c * h, conv_buf, w_conv)
    return gate_b * y, conv_new


def even_mix(h, s0, conv_a0, conv_b0, w_in, w_out, a_conv, a_log, dt_bias, a_norm, b_conv):
    p = h @ w_in
    o_a, s, conv_a = gdn_mixer(p[..., :A_IN], conv_a0, s0, a_conv, a_log, dt_bias, a_norm)
    o_b, conv_b = shortconv_mixer(p[..., A_IN:], conv_b0, b_conv)
    y = jnp.concatenate([o_a.astype(h.dtype), o_b.astype(h.dtype)], axis=-1) @ w_out
    return y, s, conv_a, conv_b


def compress(rows, pe, w1, w2):
    B, Tk, G, dh = rows.shape
    S = C_CMP_STRIDE
    nh = Tk // S
    halves = rows[:, :nh * S].reshape(B, nh, S, G, dh).astype(F32)
    pa = jnp.einsum('bnsgd,sdh->bngh', halves + pe[:S, None, :], w1[:S])
    pb = jnp.einsum('bnsgd,sdh->bngh', halves + pe[S:, None, :], w1[S:])
    hid = jax.nn.silu(pa[:, :-1] + pb[:, 1:])
    return jnp.einsum('bngh,hd->bgnd', hid, w2)


def cmp_to_sel(nc, ns):
    cs = C_CMP_STRIDE * jnp.arange(nc)[:, None]
    ss = C_SEL_LEN * jnp.arange(ns)[None, :]
    ov = jnp.clip(jnp.minimum(cs + C_CMP_LEN, ss + C_SEL_LEN) - jnp.maximum(cs, ss), 0, None)
    return ov.astype(F32) / C_CMP_LEN


def nsa_attend(q, gates, q_pos, k_cmp, v_cmp, cmp_end, m_cs, k_selb, v_selb, k_win, v_win, w_pos, w_lo):
    B, Tq = q.shape[:2]
    G, R, dh = C_KV_HEADS, C_HEADS // C_KV_HEADS, C_HD
    qg = jnp.transpose(q.reshape(B, Tq, G, R, dh), (0, 2, 1, 3, 4)).astype(F32) * (dh ** -0.5)
    slopes = alibi_slopes().reshape(G, R)
    qp = q_pos.astype(F32)
    mask_c = cmp_end[None, :] <= q_pos[:, None]
    dist_c = qp[:, None] - cmp_end.astype(F32)[None, :]
    s_c = jnp.einsum('bgtrd,bgnd->bgtrn', qg, k_cmp) - slopes[:, None, :, None] * dist_c[None, :, None, :]
    p_c = masked_softmax(s_c, mask_c[None, None, :, None, :])
    o_c = jnp.einsum('bgtrn,bgnd->bgtrd', p_c, v_cmp)
    ns = k_selb.shape[2]
    n_top = min(C_TOPN, ns)
    imp = jnp.einsum('bgtrn,ns->bgts', p_c, m_cs)
    blk = jnp.arange(ns)[None, :]
    cur = (q_pos // C_SEL_LEN)[:, None]
    valid = blk <= cur
    forced = (blk == 0) | (blk == cur) | (blk == cur - 1)
    score = jnp.where(valid, jnp.where(forced, BIG, imp), NEG)
    top_val, top_idx = lax.top_k(score, n_top)
    picked = top_val > 0.5 * NEG
    take = jax.vmap(jax.vmap(lambda blocks, idx: blocks[idx]))
    k_s = take(k_selb, top_idx).reshape(B, G, Tq, n_top * C_SEL_LEN, dh)
    v_s = take(v_selb, top_idx).reshape(B, G, Tq, n_top * C_SEL_LEN, dh)
    pos_s = top_idx[..., None] * C_SEL_LEN + jnp.arange(C_SEL_LEN)
    mask_s = (picked[..., None] & (pos_s <= q_pos[None, None, :, None, None])).reshape(B, G, Tq, 1, -1)
    dist_s = (qp[None, None, :, None, None] - pos_s.astype(F32)).reshape(B, G, Tq, 1, -1)
    s_s = jnp.einsum('bgtrd,bgtkd->bgtrk', qg, k_s.astype(F32)) - slopes[None, :, None, :, None] * dist_s
    p_s = masked_softmax(s_s, mask_s)
    o_s = jnp.einsum('bgtrk,bgtkd->bgtrd', p_s, v_s.astype(F32))
    dist_w = qp[:, None] - w_pos.astype(F32)[None, :]
    mask_w = ((w_pos[None, :] <= q_pos[:, None]) & (q_pos[:, None] - w_pos[None, :] < C_WINDOW)
              & (w_pos[None, :] >= w_lo))
    s_w = jnp.einsum('bgtrd,bgkd->bgtrk', qg, k_win.astype(F32)) - slopes[:, None, :, None] * dist_w[None, :, None, :]
    p_w = masked_softmax(s_w, mask_w[None, None, :, None, :])
    o_w = jnp.einsum('bgtrk,bgkd->bgtrd', p_w, v_win.astype(F32))
    gt = jnp.transpose(gates.reshape(B, Tq, G, R, 3), (0, 2, 1, 3, 4))
    o = gt[..., 0:1] * o_c + gt[..., 1:2] * o_s + gt[..., 2:3] * o_w
    return jnp.transpose(o, (0, 2, 1, 3, 4)).reshape(B, Tq, C_HEADS * dh)


def nsa_core(q, gates, q_start, cmp_all, sel_all, win_all, win_start, pe, w1, w2):
    B, Tq = q.shape[:2]
    Tk = cmp_all.shape[1]
    k_cmp = compress(cmp_all[:, :, 0], pe[0], w1[0], w2[0])
    v_cmp = compress(cmp_all[:, :, 1], pe[1], w1[1], w2[1])
    nc = k_cmp.shape[2]
    cmp_end = C_CMP_STRIDE * jnp.arange(nc) + C_CMP_LEN - 1
    ns = -(-Tk // C_SEL_LEN)
    selp = jnp.pad(sel_all, ((0, 0), (0, ns * C_SEL_LEN - Tk), (0, 0), (0, 0), (0, 0)))
    selp = selp.reshape(B, ns, C_SEL_LEN, 2, C_KV_HEADS, C_HD)
    k_selb = jnp.transpose(selp[:, :, :, 0], (0, 3, 1, 2, 4))
    v_selb = jnp.transpose(selp[:, :, :, 1], (0, 3, 1, 2, 4))
    m_cs = cmp_to_sel(nc, ns)
    k_win = jnp.transpose(win_all[:, :, 0], (0, 2, 1, 3))
    v_win = jnp.transpose(win_all[:, :, 1], (0, 2, 1, 3))
    shared = (k_cmp, v_cmp, cmp_end, m_cs, k_selb, v_selb)
    if Tq <= C_QBLK:
        q_pos = q_start + jnp.arange(Tq)
        w_pos = win_start + jnp.arange(k_win.shape[2])
        return nsa_attend(q, gates, q_pos, *shared, k_win, v_win, w_pos, win_start)
    off = q_start - win_start
    pad_w = ((0, 0), (0, 0), (C_WINDOW, 0), (0, 0))
    kwp = jnp.pad(k_win, pad_w)
    vwp = jnp.pad(v_win, pad_w)
    nkw = C_WINDOW + C_QBLK

    def block(i):
        q0 = i * C_QBLK
        qb = lax.dynamic_slice_in_dim(q, q0, C_QBLK, axis=1)
        gb = lax.dynamic_slice_in_dim(gates, q0, C_QBLK, axis=1)
        kw = lax.dynamic_slice_in_dim(kwp, off + q0, nkw, axis=2)
        vw = lax.dynamic_slice_in_dim(vwp, off + q0, nkw, axis=2)
        q_pos = q_start + q0 + jnp.arange(C_QBLK)
        w_pos = q_start + q0 - C_WINDOW + jnp.arange(nkw)
        return nsa_attend(qb, gb, q_pos, *shared, kw, vw, w_pos, win_start)

    out = lax.map(block, jnp.arange(Tq // C_QBLK))
    return jnp.moveaxis(out, 0, 1).reshape(B, Tq, C_HEADS * C_HD)


def chunk_mlp(p, ws, bs, ln_g, ln_b):
    B, T, _ = p.shape
    z = jax.nn.gelu(p.astype(F32))
    u, v = z[..., :D_WIDTH], z[..., D_WIDTH:]
    mu = jnp.mean(v, axis=-1, keepdims=True)
    var = jnp.mean(jnp.square(v - mu), axis=-1, keepdims=True)
    v = (v - mu) * lax.rsqrt(var + EPS) * ln_g.astype(F32) + ln_b.astype(F32)
    pad = (-T) % D_CHUNK
    nch = (T + pad) // D_CHUNK
    vc = jnp.pad(v, ((0, 0), (0, pad), (0, 0))).reshape(B, nch, D_CHUNK, D_GROUPS, D_WIDTH // D_GROUPS)
    w_causal = jnp.where(jnp.tril(jnp.ones((D_CHUNK, D_CHUNK), bool)), ws.astype(F32), 0.0)
    mixed = jnp.einsum('gts,bnsgc->bntgc', w_causal, vc) + bs.astype(F32).T[None, None, :, :, None]
    mixed = mixed.reshape(B, nch * D_CHUNK, D_WIDTH)[:, :T]
    return u * mixed, v.astype(p.dtype)


def odd_mix(h, past_cmp, past_sel, win_buf, q_start, w_in, w_out, pe, w1, w2, ws, bs, ln_g, ln_b):
    B, T, _ = h.shape
    p = h @ w_in
    pc = p[..., :C_IN]
    q = pc[..., :C_Q].reshape(B, T, C_HEADS, C_HD)
    gates = jax.nn.sigmoid(pc[..., C_Q:C_Q + C_GATES].astype(F32)).reshape(B, T, C_HEADS, 3)
    kv = pc[..., C_Q + C_GATES:].reshape(B, T, 3, 2, C_KV_HEADS, C_HD)
    cmp_new, sel_new, win_new = kv[:, :, 0], kv[:, :, 1], kv[:, :, 2]
    cmp_all = jnp.concatenate([past_cmp.astype(h.dtype), cmp_new], axis=1)
    sel_all = jnp.concatenate([past_sel.astype(h.dtype), sel_new], axis=1)
    win_all = jnp.concatenate([win_buf.astype(h.dtype), win_new], axis=1)
    win_start = q_start - win_buf.shape[1]
    o_c = nsa_core(q, gates, q_start, cmp_all, sel_all, win_all, win_start, pe, w1, w2)
    o_d, v_rows = chunk_mlp(p[..., C_IN:], ws, bs, ln_g, ln_b)
    y = jnp.concatenate([o_c.astype(h.dtype), o_d.astype(h.dtype)], axis=-1) @ w_out
    n_keep = min(C_WINDOW, q_start + T)
    win_keep = win_all[:, win_all.shape[1] - n_keep:]
    return y, cmp_new, sel_new, win_keep, v_rows


def gather_paged(pool, page_table):
    pages = jnp.moveaxis(pool[page_table], 2, 1)
    db, nl, npg, pg = pages.shape[:4]
    return pages.reshape((db, nl, npg * pg) + pages.shape[4:])


def trunk(x, q_start, delta0, conv_a0, conv_b0, past_cmp, past_sel, win_buf,
          norm_g, ffn_gate, ffn_up, ffn_down,
          ev_w_in, ev_w_out, ev_a_conv, ev_a_log, ev_dt_bias, ev_a_norm, ev_b_conv,
          od_w_in, od_w_out, od_cmp_pe, od_cmp_w1, od_cmp_w2, od_d_ws, od_d_bs, od_d_ln_g, od_d_ln_b):
    deltas, convs_a, convs_b = [], [], []
    cmps, sels, wins, dvs = [], [], [], []
    for li in range(DEPTH):
        j = li // 2
        g = norm_g[li]
        x = x + 0.5 * rmsnorm(swiglu(rmsnorm(x, g[0]), ffn_gate[li, 0], ffn_up[li, 0], ffn_down[li, 0]), g[1])
        h = rmsnorm(x, g[2])
        if li % 2 == 0:
            y, s, ca, cb = even_mix(h, delta0[:, j], conv_a0[:, j], conv_b0[:, j], ev_w_in[j], ev_w_out[j],
                                    ev_a_conv[j], ev_a_log[j], ev_dt_bias[j], ev_a_norm[j], ev_b_conv[j])
            deltas.append(s)
            convs_a.append(ca)
            convs_b.append(cb)
        else:
            y, rc, rs, wb, dv = odd_mix(h, past_cmp[:, j], past_sel[:, j], win_buf[:, j], q_start,
                                        od_w_in[j], od_w_out[j], od_cmp_pe[j], od_cmp_w1[j], od_cmp_w2[j],
                                        od_d_ws[j], od_d_bs[j], od_d_ln_g[j], od_d_ln_b[j])
            cmps.append(rc)
            sels.append(rs)
            wins.append(wb)
            dvs.append(dv)
        x = x + rmsnorm(y, g[3])
        x = x + 0.5 * rmsnorm(swiglu(rmsnorm(x, g[4]), ffn_gate[li, 1], ffn_up[li, 1], ffn_down[li, 1]), g[5])
    st = lambda a: jnp.stack(a, axis=1)
    return x, st(deltas), st(convs_a), st(convs_b), st(cmps), st(sels), st(wins), st(dvs)


def setup_inputs(seed: int = 0) -> dict:
    key = jax.random.key(seed)
    ks = iter(jax.random.split(key, 32))
    nrm = lambda shape, scale: jax.random.normal(next(ks), shape, F32) * scale
    n_pages = PAST_LEN // PAGE_SIZE
    n_used = DEC_BATCH * n_pages
    n_pool = n_used + n_used // 4
    win_rows = min(C_WINDOW, PAST_LEN)
    kv_row = (2, C_KV_HEADS, C_HD)
    page_table = jax.random.permutation(next(ks), n_pool)[:n_used].reshape(DEC_BATCH, n_pages).astype(jnp.int32)
    return {
        'x_prompt': nrm((BATCH, SEQ, D_MODEL), 1.0),
        'x_sample': nrm((DEC_BATCH, DEC_SEQ, D_MODEL), 1.0),
        'state_delta': nrm((DEC_BATCH, N_EVEN, A_HEADS, A_DK, A_DV), 0.1),
        'state_conv_a': nrm((DEC_BATCH, N_EVEN, A_CONV - 1, A_CONV_DIM), 1.0),
        'state_conv_b': nrm((DEC_BATCH, N_EVEN, B_CONV - 1, B_WIDTH), 1.0),
        'cache_cmp_kv': nrm((n_pool, N_ODD, PAGE_SIZE) + kv_row, 1.0),
        'cache_sel_kv': nrm((n_pool, N_ODD, PAGE_SIZE) + kv_row, 1.0),
        'cache_win_kv': nrm((DEC_BATCH, N_ODD, win_rows) + kv_row, 1.0),
        'page_table': page_table,
        'norm_g': 1.0 + nrm((DEPTH, 6, D_MODEL), 0.01),
        'ffn_gate': nrm((DEPTH, 2, D_MODEL, D_FF), D_MODEL ** -0.5),
        'ffn_up': nrm((DEPTH, 2, D_MODEL, D_FF), D_MODEL ** -0.5),
        'ffn_down': nrm((DEPTH, 2, D_FF, D_MODEL), D_FF ** -0.5),
        'ev_w_in': nrm((N_EVEN, D_MODEL, EVEN_IN), D_MODEL ** -0.5),
        'ev_w_out': nrm((N_EVEN, EVEN_OUT, D_MODEL), EVEN_OUT ** -0.5),
        'ev_a_conv': nrm((N_EVEN, A_CONV, A_CONV_DIM), A_CONV ** -0.5),
        'ev_a_log': jnp.log(jax.random.uniform(next(ks), (N_EVEN, A_HEADS), F32, 1.0, 16.0)),
        'ev_dt_bias': -4.0 + nrm((N_EVEN, A_HEADS), 0.1),
        'ev_a_norm': 1.0 + nrm((N_EVEN, A_DV), 0.01),
        'ev_b_conv': nrm((N_EVEN, B_CONV, B_WIDTH), B_CONV ** -0.5),
        'od_w_in': nrm((N_ODD, D_MODEL, ODD_IN), D_MODEL ** -0.5),
        'od_w_out': nrm((N_ODD, ODD_OUT, D_MODEL), ODD_OUT ** -0.5),
        'od_cmp_pe': nrm((N_ODD, 2, C_CMP_LEN, C_HD), 0.02),
        'od_cmp_w1': nrm((N_ODD, 2, C_CMP_LEN, C_HD, C_CMP_HID), (C_CMP_LEN * C_HD) ** -0.5),
        'od_cmp_w2': nrm((N_ODD, 2, C_CMP_HID, C_HD), C_CMP_HID ** -0.5),
        'od_d_ws': nrm((N_ODD, D_GROUPS, D_CHUNK, D_CHUNK), D_CHUNK ** -0.5),
        'od_d_bs': 1.0 + nrm((N_ODD, D_GROUPS, D_CHUNK), 0.01),
        'od_d_ln_g': 1.0 + nrm((N_ODD, D_WIDTH), 0.01),
        'od_d_ln_b': nrm((N_ODD, D_WIDTH), 0.01),
    }


def reference(x_prompt, x_sample, state_delta, state_conv_a, state_conv_b, cache_cmp_kv, cache_sel_kv,
              cache_win_kv, page_table, norm_g, ffn_gate, ffn_up, ffn_down,
              ev_w_in, ev_w_out, ev_a_conv, ev_a_log, ev_dt_bias, ev_a_norm, ev_b_conv,
              od_w_in, od_w_out, od_cmp_pe, od_cmp_w1, od_cmp_w2, od_d_ws, od_d_bs, od_d_ln_g, od_d_ln_b):
    weights = (norm_g, ffn_gate, ffn_up, ffn_down,
               ev_w_in, ev_w_out, ev_a_conv, ev_a_log, ev_dt_bias, ev_a_norm, ev_b_conv,
               od_w_in, od_w_out, od_cmp_pe, od_cmp_w1, od_cmp_w2, od_d_ws, od_d_bs, od_d_ln_g, od_d_ln_b)
    dt = x_prompt.dtype
    bp = x_prompt.shape[0]
    no_rows = jnp.zeros((bp, N_ODD, 0, 2, C_KV_HEADS, C_HD), dt)
    (y_prompt, delta_p, conv_a_p, conv_b_p, cmp_p, sel_p, win_p, _) = trunk(
        x_prompt, 0,
        jnp.zeros((bp, N_EVEN, A_HEADS, A_DK, A_DV), F32),
        jnp.zeros((bp, N_EVEN, A_CONV - 1, A_CONV_DIM), dt),
        jnp.zeros((bp, N_EVEN, B_CONV - 1, B_WIDTH), dt),
        no_rows, no_rows, no_rows, *weights)
    past_len = page_table.shape[1] * cache_cmp_kv.shape[2]
    (y_sample, delta_s, conv_a_s, conv_b_s, cmp_s, sel_s, win_s, dv_s) = trunk(
        x_sample, past_len, state_delta, state_conv_a, state_conv_b,
        gather_paged(cache_cmp_kv, page_table), gather_paged(cache_sel_kv, page_table),
        cache_win_kv, *weights)
    return (y_prompt, y_sample, delta_p, delta_s, conv_a_p, conv_a_s, conv_b_p, conv_b_s,
            cmp_p, cmp_s, sel_p, sel_s, win_p, win_s, dv_s)
```

```cpp
#include <hip/hip_runtime.h>
#include <hip/hip_cooperative_groups.h>
#include <cstdio>
#include <cstdint>
namespace cg = cooperative_groups;
#define DEBUG_FILL 0

typedef unsigned short bf16_t;
typedef short bf16x8 __attribute__((ext_vector_type(8)));
typedef float f32x4 __attribute__((ext_vector_type(4)));
typedef unsigned u32x4 __attribute__((ext_vector_type(4)));
typedef unsigned u32x2 __attribute__((ext_vector_type(2)));
#define DEV __device__ __forceinline__
#define LAS __attribute__((address_space(3)))

constexpr int D = 1024, NP = 16384, NS = 1024, NT = NP + NS, SEQ = 4096, NB = 4, DB = 128, DSQ = 8, PAST = 2048;
constexpr int FF = 2816;
constexpr int EV_N = 3584, EV_SRC = 3592, OD_N = 2304, OD_SRC = 2328;
constexpr int NTHR = 512;

constexpr size_t O_YP = 0, O_YS = O_YP + (size_t)NP * D, O_DP = O_YS + (size_t)NS * D, O_DS = O_DP + 4 * 4 * 128 * 128,
                 O_CAP = O_DS + (size_t)128 * 4 * 128 * 128, O_CAS = O_CAP + 4 * 3 * 1536, O_CBP = O_CAS + 128 * 3 * 1536,
                 O_CBS = O_CBP + 4 * 2 * 512, O_CMP = O_CBS + 128 * 2 * 512, O_CMS = O_CMP + (size_t)NP * 256,
                 O_SLP = O_CMS + (size_t)NS * 256, O_SLS = O_SLP + (size_t)NP * 256, O_WNP = O_SLS + (size_t)NS * 256,
                 O_WNS = O_WNP + 4 * 512 * 256, O_DV = O_WNS + (size_t)128 * 512 * 256, O_END = O_DV + (size_t)NS * 512;

constexpr size_t al256(size_t x) { return (x + 255) & ~(size_t)255; }
constexpr size_t WS_WGU = 0;
constexpr size_t WS_WD = WS_WGU + (size_t)4 * 5632 * 1024 * 2;
constexpr size_t WS_WEIN = WS_WD + (size_t)4 * 1024 * 2816 * 2;
constexpr size_t WS_WEOUT = WS_WEIN + (size_t)EV_N * 1024 * 2;
constexpr size_t WS_WOIN = WS_WEOUT + (size_t)1024 * 1024 * 2;
constexpr size_t WS_WOOUT = WS_WOIN + (size_t)OD_N * 1024 * 2;
constexpr size_t WS_WC1 = WS_WOOUT + (size_t)1024 * 1024 * 2;
constexpr size_t WS_WC2 = WS_WC1 + (size_t)2 * 256 * 1024 * 2;
constexpr size_t WS_WDS = WS_WC2 + (size_t)2 * 64 * 128 * 2;
constexpr size_t WS_CBIAS = WS_WDS + (size_t)8 * 128 * 128 * 2;
constexpr size_t WS_X = al256(WS_CBIAS + 2 * 128 * 4);
constexpr size_t WS_H = WS_X + (size_t)NT * D * 4;
constexpr size_t WS_ACT = WS_H + (size_t)NT * D * 2;
constexpr size_t WS_Y = WS_ACT + (size_t)NT * FF * 2;
constexpr size_t WS_P = WS_Y + (size_t)NT * D * 4;
constexpr size_t WS_EXT = WS_P + (size_t)NT * EV_N * 2;
constexpr size_t WS_MIX = al256(WS_EXT + (size_t)NT * 24 * 4);
constexpr size_t WS_OB = WS_MIX + (size_t)NT * D * 2;
constexpr size_t WS_CW = WS_OB + (size_t)NT * 512 * 4;
constexpr size_t WS_CQ = WS_CW + (size_t)1024 * 64 * 128 * 2;
constexpr size_t WS_CKT = WS_CQ + (size_t)1024 * 64 * 128 * 2;
constexpr size_t WS_CU = WS_CKT + (size_t)1024 * 64 * 128 * 2;
constexpr size_t WS_CI = WS_CU + (size_t)1024 * 64 * 128 * 4;
constexpr size_t WS_CGL = WS_CI + (size_t)1024 * 64 * 64 * 2;
constexpr size_t WS_KC = al256(WS_CGL + 1024 * 4);
constexpr size_t KC_ELEMS = (size_t)(4 * 2 * 256 + 128 * 2 * 128) * 64;
constexpr size_t WS_VC = WS_KC + KC_ELEMS * 2;
constexpr size_t WS_QKV = al256(WS_VC + KC_ELEMS * 2);
constexpr size_t WS_GB = WS_QKV + (size_t)NT * 1536 * 4;
constexpr size_t WS_GATES = WS_GB + (size_t)NT * 8 * 4;
constexpr size_t WS_UG = al256(WS_GATES + (size_t)NT * 24 * 4);
constexpr size_t WS_VLN = WS_UG + (size_t)NT * 512 * 4;
constexpr size_t WS_KCF = WS_VLN + (size_t)NT * 512 * 4;
constexpr size_t WS_END = WS_KCF + KC_ELEMS * 2 * 4;

struct Params {
    const float* in[29];
    const int* page_table;
    float* out;
    unsigned char* ws;
};

DEV unsigned f2bf(float f) { unsigned u = __builtin_bit_cast(unsigned, f); return (u + 0x7fffu + ((u >> 16) & 1u)) >> 16; }
DEV unsigned pk2(float lo, float hi) { return f2bf(lo) | (f2bf(hi) << 16); }
DEV float bf2f(unsigned short v) { return __builtin_bit_cast(float, (unsigned)v << 16); }
DEV float bflo(unsigned v) { return __builtin_bit_cast(float, v << 16); }
DEV float bfhi(unsigned v) { return __builtin_bit_cast(float, v & 0xffff0000u); }
DEV float wave_sum(float v) {
#pragma unroll
    for (int o = 1; o < 64; o <<= 1) v += __shfl_xor(v, o);
    return v;
}
DEV float sigmoidf_(float x) { return 1.f / (1.f + __expf(-x)); }
DEV float siluf_(float x) { return x / (1.f + __expf(-x)); }
DEV float softplusf_(float x) { return x > 20.f ? x : log1pf(__expf(x)); }
DEV float geluf_(float x) { const float u = 0.7978845608028654f * (x + 0.044715f * x * x * x); return 0.5f * x * (1.f + tanhf(u)); }

DEV void transpose_item(const float* W, int ldn, int k0, int n0, bf16_t* WT, int ldk, int dst_row0, LAS float* scr, int lane) {
#pragma unroll 8
    for (int i = 0; i < 32; ++i) { const int kk = 2 * i + (lane >> 5); scr[kk * 33 + (lane & 31)] = W[(size_t)(k0 + kk) * ldn + n0 + (lane & 31)]; }
    asm volatile("s_waitcnt lgkmcnt(0)" ::: "memory");
    const int c = lane & 7;
#pragma unroll
    for (int j = 0; j < 4; ++j) { const int n = (lane >> 3) + 8 * j; const LAS float* s = scr + (8 * c) * 33 + n;
        u32x4 o; o.x = pk2(s[0 * 33], s[1 * 33]); o.y = pk2(s[2 * 33], s[3 * 33]); o.z = pk2(s[4 * 33], s[5 * 33]); o.w = pk2(s[6 * 33], s[7 * 33]);
        *(u32x4*)(WT + (size_t)(dst_row0 + n) * ldk + k0 + 8 * c) = o; }
    asm volatile("s_waitcnt lgkmcnt(0)" ::: "memory");
}

DEV void phase_prep(const Params& p, LAS unsigned char* lds, int gw, int ngw, int lane, int wave) {
    LAS float* scr = (LAS float*)(lds + wave * 16384);
    unsigned char* ws = p.ws;
    constexpr int I_G = 16 * 88;
    constexpr int I_D = 44 * 32;
    constexpr int I_EIN = 16 * 112, I_SQ = 16 * 32, I_OIN = 16 * 72, I_C1 = 4 * 16 * 4;
    constexpr int T0 = 4 * I_G, T1 = T0 + 4 * I_G, T2 = T1 + 4 * I_D, T3 = T2 + I_EIN, T4 = T3 + I_SQ, T5 = T4 + I_OIN, T6 = T5 + I_SQ, T7 = T6 + I_C1;
    for (int it = gw; it < T7; it += ngw) {
        if (it < T1) {
            const bool up = it >= T0; const int r = up ? it - T0 : it; const int mat = r / I_G, rr = r % I_G, kb = rr / 88, nb = rr % 88;
            const float* W = (up ? p.in[11] : p.in[10]) + (size_t)mat * 1024 * FF;
            bf16_t* WT = (bf16_t*)(ws + WS_WGU) + (size_t)mat * 5632 * 1024;
            const int n0 = nb * 32, pn = n0 / 128, c = n0 % 128;
            transpose_item(W, FF, kb * 64, n0, WT, 1024, pn * 256 + (up ? 128 : 0) + c, scr, lane);
        } else if (it < T2) {
            const int r = it - T1, mat = r / I_D, rr = r % I_D, kb = rr / 32, nb = rr % 32;
            transpose_item(p.in[12] + (size_t)mat * FF * 1024, 1024, kb * 64, nb * 32, (bf16_t*)(ws + WS_WD) + (size_t)mat * 1024 * FF, FF, nb * 32, scr, lane);
        } else if (it < T3) {
            const int r = it - T2, kb = r / 112, nb = r % 112, dr = nb * 32;
            transpose_item(p.in[13], EV_SRC, kb * 64, dr < 2048 ? dr : dr + 8, (bf16_t*)(ws + WS_WEIN), 1024, dr, scr, lane);
        } else if (it < T4) {
            const int r = it - T3, kb = r / 32, nb = r % 32;
            transpose_item(p.in[14], 1024, kb * 64, nb * 32, (bf16_t*)(ws + WS_WEOUT), 1024, nb * 32, scr, lane);
        } else if (it < T5) {
            const int r = it - T4, kb = r / 72, nb = r % 72, dr = nb * 32;
            transpose_item(p.in[20], OD_SRC, kb * 64, dr < 512 ? dr : dr + 24, (bf16_t*)(ws + WS_WOIN), 1024, dr, scr, lane);
        } else if (it < T6) {
            const int r = it - T5, kb = r / 32, nb = r % 32;
            transpose_item(p.in[21], 1024, kb * 64, nb * 32, (bf16_t*)(ws + WS_WOOUT), 1024, nb * 32, scr, lane);
        } else {
            const int r = it - T6, kvh = r / 64, rr = r % 64, kb = rr / 4, nb = rr % 4;
            const float* W = p.in[23] + (size_t)(kvh >> 1) * 2048 * 128 + (size_t)(kvh & 1) * 1024 * 128;
            transpose_item(W, 128, kb * 64, nb * 32, (bf16_t*)(ws + WS_WC1) + (size_t)(kvh >> 1) * 256 * 1024, 1024, (kvh & 1) * 128 + nb * 32, scr, lane);
        }
    }
    const int gt = gw * 64 + lane, ngt = ngw * 64;
    for (int i = gt; i < 2 * 64 * 128; i += ngt) {
        const int kv = i / 8192, r = i % 8192, d = r / 128, h = r % 128;
        ((bf16_t*)(ws + WS_WC2))[i] = (bf16_t)f2bf(p.in[24][(size_t)kv * 8192 + h * 64 + d]);
    }
    for (int i = gt; i < 8 * 128 * 128; i += ngt) {
        const int t = (i / 128) % 128, s = i % 128;
        ((bf16_t*)(ws + WS_WDS))[i] = (bf16_t)f2bf(s <= t ? p.in[25][i] : 0.f);
    }
    for (int o = gw; o < 256; o += ngw) {
        const int kv = o / 128, h = o % 128; float acc = 0.f;
        for (int k = lane; k < 2048; k += 64) acc += p.in[22][(size_t)kv * 2048 + k] * p.in[23][((size_t)kv * 2048 + k) * 128 + h];
        acc = wave_sum(acc);
        if (lane == 0) ((float*)(ws + WS_CBIAS))[o] = acc;
    }
}

struct RowNormArgs {
    const float* x_src_p; const float* x_src_s;
    const float* Y;
    const float* g_post; float scale;
    float* x_dst;
    const float* g_pre; bf16_t* h_dst;
    float* out_p; float* out_s;
    const float* w_ext; int ext_ld, ext_c0, n_ext;
    float* ext_dst;
};

DEV void phase_rownorm(const RowNormArgs& a, LAS unsigned char* lds, int gw, int ngw, int lane) {
    LAS float* wl = (LAS float*)lds;
    if (a.n_ext) {
        for (int i = threadIdx.x; i < 1024 * a.n_ext; i += NTHR) { const int k = i / a.n_ext, j = i % a.n_ext; wl[i] = a.w_ext[(size_t)k * a.ext_ld + a.ext_c0 + j]; }
        __syncthreads();
    }
    for (int row = gw; row < NT; row += ngw) {
        const float* xr = row < NP ? a.x_src_p + (size_t)row * D : a.x_src_s + (size_t)(row - NP) * D;
        f32x4 v[4];
#pragma unroll
        for (int j = 0; j < 4; ++j) v[j] = ((const f32x4*)xr)[lane + 64 * j];
        if (a.Y) {
            f32x4 y[4]; float s = 0.f;
#pragma unroll
            for (int j = 0; j < 4; ++j) { y[j] = ((const f32x4*)(a.Y + (size_t)row * D))[lane + 64 * j]; s += (y[j].x * y[j].x + y[j].y * y[j].y) + (y[j].z * y[j].z + y[j].w * y[j].w); }
            const float r = a.scale * rsqrtf(wave_sum(s) * (1.f / D) + 1e-6f);
#pragma unroll
            for (int j = 0; j < 4; ++j) { const f32x4 g = ((const f32x4*)a.g_post)[lane + 64 * j]; v[j] += y[j] * g * r; }
        }
        if (a.x_dst) {
#pragma unroll
            for (int j = 0; j < 4; ++j) ((f32x4*)(a.x_dst + (size_t)row * D))[lane + 64 * j] = v[j];
        }
        if (a.out_p) {
            float* o = row < NP ? a.out_p + (size_t)row * D : a.out_s + (size_t)(row - NP) * D;
#pragma unroll
            for (int j = 0; j < 4; ++j) ((f32x4*)o)[lane + 64 * j] = v[j];
        }
        if (a.h_dst) {
            float s = 0.f;
#pragma unroll
            for (int j = 0; j < 4; ++j) s += (v[j].x * v[j].x + v[j].y * v[j].y) + (v[j].z * v[j].z + v[j].w * v[j].w);
            const float r = rsqrtf(wave_sum(s) * (1.f / D) + 1e-6f);
#pragma unroll
            for (int j = 0; j < 4; ++j) { const f32x4 g = ((const f32x4*)a.g_pre)[lane + 64 * j]; v[j] = v[j] * g * r;
                u32x2 w; w.x = pk2(v[j].x, v[j].y); w.y = pk2(v[j].z, v[j].w);
                ((u32x2*)(a.h_dst + (size_t)row * D))[lane + 64 * j] = w; }
            if (a.n_ext) {
                for (int e = 0; e < a.n_ext; ++e) {
                    float acc = 0.f;
#pragma unroll
                    for (int j = 0; j < 4; ++j) { const int k = (lane + 64 * j) * 4;
                        acc += v[j].x * wl[(k + 0) * a.n_ext + e] + v[j].y * wl[(k + 1) * a.n_ext + e] + v[j].z * wl[(k + 2) * a.n_ext + e] + v[j].w * wl[(k + 3) * a.n_ext + e]; }
                    acc = wave_sum(acc);
                    if (lane == 0) a.ext_dst[(size_t)row * 24 + e] = acc;
                }
            }
        }
    }
}

constexpr int BM = 256, BK = 64, HALF = 128, NXCD = 8, WGM = 8, HT = HALF * BK;
DEV int lds_byte(int r, int c) { const int st = (r >> 4) * 2 + (c >> 5), rr = r & 15, cc = c & 31, ob = rr * 64 + cc * 2; return st * 1024 + (ob ^ (((ob >> 9) & 1) << 5)); }
DEV void stage_rc(int b, int& R, int& C) { const int st = b / 1024, sb = b % 1024, swz = sb ^ (((sb >> 9) & 1) << 5); R = (st >> 1) * 16 + swz / 64; C = (st & 1) * 32 + (swz % 64) / 2; }

struct EpiF32 {
    float* C; int ldc;
    DEV void operator()(const f32x4 (&acc)[2][2][4][2], int brow, int bcol, int wr, int wc, int fr, int fq) const {
#pragma unroll
        for (int ai = 0; ai < 2; ++ai)
#pragma unroll
            for (int bj = 0; bj < 2; ++bj)
#pragma unroll
                for (int m = 0; m < 4; ++m)
#pragma unroll
                    for (int n = 0; n < 2; ++n)
#pragma unroll
                        for (int j = 0; j < 4; ++j)
                            C[(size_t)(brow + ai * HALF + wr * 64 + m * 16 + fq * 4 + j) * ldc + (bcol + bj * HALF + wc * 32 + n * 16 + fr)] = acc[ai][bj][m][n][j];
    }
};
struct EpiBf16 {
    bf16_t* C; int ldc;
    DEV void operator()(const f32x4 (&acc)[2][2][4][2], int brow, int bcol, int wr, int wc, int fr, int fq) const {
#pragma unroll
        for (int ai = 0; ai < 2; ++ai)
#pragma unroll
            for (int bj = 0; bj < 2; ++bj)
#pragma unroll
                for (int m = 0; m < 4; ++m)
#pragma unroll
                    for (int n = 0; n < 2; ++n)
#pragma unroll
                        for (int j = 0; j < 4; ++j)
                            C[(size_t)(brow + ai * HALF + wr * 64 + m * 16 + fq * 4 + j) * ldc + (bcol + bj * HALF + wc * 32 + n * 16 + fr)] = (bf16_t)f2bf(acc[ai][bj][m][n][j]);
    }
};
struct EpiSwiglu {
    bf16_t* C;
    DEV void operator()(const f32x4 (&acc)[2][2][4][2], int brow, int bcol, int wr, int wc, int fr, int fq) const {
        const int c0 = (bcol >> 1) + wc * 32 + fr;
#pragma unroll
        for (int ai = 0; ai < 2; ++ai)
#pragma unroll
            for (int m = 0; m < 4; ++m)
#pragma unroll
                for (int n = 0; n < 2; ++n)
#pragma unroll
                    for (int j = 0; j < 4; ++j) {
                        const float g = acc[ai][0][m][n][j], u = acc[ai][1][m][n][j];
                        C[(size_t)(brow + ai * HALF + wr * 64 + m * 16 + fq * 4 + j) * FF + c0 + n * 16] = (bf16_t)f2bf(siluf_(g) * u);
                    }
    }
};

template <class Epi>
DEV void gemm_phase(LAS unsigned char* lds, const bf16_t* __restrict__ A, const bf16_t* __restrict__ Bt, int M, int N, int K, const Epi& E) {
    const int wid = __builtin_amdgcn_readfirstlane(threadIdx.x >> 6), lane = threadIdx.x & 63, wr = wid >> 2, wc = wid & 3, fr = lane & 15, fq = lane >> 4;
    unsigned voff[2];
#pragma unroll
    for (int i = 0; i < 2; ++i) { int R, C; stage_rc(threadIdx.x * 16 + i * 8192, R, C); voff[i] = (unsigned)(R * K + C) * 2u; }
    const size_t hstep = (size_t)HALF * K * 2;
    const unsigned ldsw = (unsigned)wid * 1024u;
    const int aoff = lds_byte(wr * 64 + fr, fq * 8), boff = lds_byte(wc * 32 + fr, fq * 8);
#define G_SA(b, h) (((b) * 2 + (h)) * (HT * 2))
#define G_SB(b, h) ((4 + (b) * 2 + (h)) * (HT * 2))
#define STAGE(bufoff, gbase) do { _Pragma("unroll") for (int _i = 0; _i < 2; ++_i) \
      __builtin_amdgcn_global_load_lds((const unsigned*)((const char*)(gbase) + voff[_i]), (LAS unsigned*)(lds + (bufoff) + ldsw + _i * 8192), 16, 0, 0); } while (0)
#define LDA(dst, b, h) do { _Pragma("unroll") for (int m = 0; m < 4; ++m) _Pragma("unroll") for (int k = 0; k < 2; ++k) dst[m][k] = *(const LAS bf16x8*)(lds + G_SA(b, h) + aoff + m * 2048 + k * 1024); } while (0)
#define LDB(dst, b, h) do { _Pragma("unroll") for (int n = 0; n < 2; ++n) _Pragma("unroll") for (int k = 0; k < 2; ++k) dst[n][k] = *(const LAS bf16x8*)(lds + G_SB(b, h) + boff + n * 2048 + k * 1024); } while (0)
#define MMA(ai, bj, At, Bq) do { __builtin_amdgcn_s_setprio(1); \
    _Pragma("unroll") for (int m = 0; m < 4; ++m) _Pragma("unroll") for (int n = 0; n < 2; ++n) _Pragma("unroll") for (int k = 0; k < 2; ++k) \
      acc[ai][bj][m][n] = __builtin_amdgcn_mfma_f32_16x16x32_bf16(At[m][k], Bq[n][k], acc[ai][bj][m][n], 0, 0, 0); \
    __builtin_amdgcn_s_setprio(0); } while (0)
#define WAIT_V(n) asm volatile("s_waitcnt vmcnt(" #n ")" ::: "memory")
#define WAIT_L(n) asm volatile("s_waitcnt lgkmcnt(" #n ")" ::: "memory")
#define BAR __builtin_amdgcn_s_barrier()
#define SCHED __builtin_amdgcn_sched_barrier(0)
    const int nM = M / BM, nN = N / BM, nwg = nM * nN;
    const int nt = K / BK;
    for (int L = blockIdx.x; L < nwg; L += gridDim.x) {
        int wgid = L;
        { const int q = nwg / NXCD, r = nwg % NXCD, xcd = wgid % NXCD, off = wgid / NXCD; wgid = (xcd < r ? xcd * (q + 1) : r * (q + 1) + (xcd - r) * q) + off; }
        const int nig = WGM * nN, gid = wgid / nig, fm = gid * WGM, gsz = min(nM - fm, WGM);
        const int pm = fm + ((wgid % nig) % gsz), pn = (wgid % nig) / gsz, brow = pm * BM, bcol = pn * BM;
        const char* cA = (const char*)A + (size_t)brow * K * 2; const char* cB = (const char*)Bt + (size_t)bcol * K * 2;
        f32x4 acc[2][2][4][2];
#pragma unroll
        for (int a = 0; a < 2; ++a)
#pragma unroll
            for (int b = 0; b < 2; ++b)
#pragma unroll
                for (int m = 0; m < 4; ++m)
#pragma unroll
                    for (int n = 0; n < 2; ++n) acc[a][b][m][n] = (f32x4){0.f, 0.f, 0.f, 0.f};
        bf16x8 At[4][2], B0[2][2], B1[2][2];
        STAGE(G_SB(0, 0), cB); STAGE(G_SA(0, 0), cA);
        STAGE(G_SB(0, 1), cB + hstep); STAGE(G_SA(0, 1), cA + hstep);
        if (wr == 1) BAR;
        WAIT_V(4); BAR;
        STAGE(G_SB(1, 0), cB + 128); STAGE(G_SA(1, 0), cA + 128); STAGE(G_SB(1, 1), cB + hstep + 128);
        WAIT_V(6); BAR;
        for (int t = 0; t < nt - 2; t += 2) {
            LDB(B0, 0, 0); SCHED; LDA(At, 0, 0); STAGE(G_SA(1, 1), cA + hstep + 128);
            WAIT_L(8); BAR; WAIT_L(0); MMA(0, 0, At, B0); BAR; SCHED;
            LDB(B1, 0, 1); STAGE(G_SB(0, 0), cB + 256);
            BAR; WAIT_L(0); MMA(0, 1, At, B1); BAR;
            LDA(At, 0, 1); STAGE(G_SA(0, 0), cA + 256);
            BAR; WAIT_L(0); MMA(1, 0, At, B0); BAR; SCHED;
            STAGE(G_SB(0, 1), cB + hstep + 256);
            WAIT_V(6); BAR; MMA(1, 1, At, B1); BAR;
            LDB(B0, 1, 0); SCHED; LDA(At, 1, 0); STAGE(G_SA(0, 1), cA + hstep + 256);
            WAIT_L(8); BAR; WAIT_L(0); MMA(0, 0, At, B0); BAR; SCHED;
            LDB(B1, 1, 1); STAGE(G_SB(1, 0), cB + 384);
            BAR; WAIT_L(0); MMA(0, 1, At, B1); BAR;
            LDA(At, 1, 1); STAGE(G_SA(1, 0), cA + 384);
            BAR; WAIT_L(0); MMA(1, 0, At, B0); BAR; SCHED;
            STAGE(G_SB(1, 1), cB + hstep + 384);
            WAIT_V(6); BAR; MMA(1, 1, At, B1); BAR;
            cA += 256; cB += 256;
        }
        { LDB(B0, 0, 0); LDA(At, 0, 0); STAGE(G_SA(1, 1), cA + hstep + 128);
          BAR; WAIT_L(0); MMA(0, 0, At, B0); BAR;
          LDB(B1, 0, 1); BAR; WAIT_L(0); MMA(0, 1, At, B1); BAR;
          LDA(At, 0, 1); WAIT_V(4); BAR; WAIT_L(0); MMA(1, 0, At, B0); MMA(1, 1, At, B1); BAR; }
        { LDB(B0, 1, 0); LDA(At, 1, 0); WAIT_V(2); BAR; WAIT_L(0); MMA(0, 0, At, B0); BAR;
          LDB(B1, 1, 1); WAIT_V(0); BAR; WAIT_L(0); MMA(0, 1, At, B1); BAR;
          LDA(At, 1, 1); BAR; WAIT_L(0); MMA(1, 0, At, B0); MMA(1, 1, At, B1); BAR; }
        if (wr == 0) BAR;
        E(acc, brow, bcol, wr, wc, fr, fq);
    }
    __syncthreads();
#undef G_SA
#undef G_SB
#undef STAGE
#undef LDA
#undef LDB
#undef MMA
}

DEV void phase_even_a(const Params& p, const bf16_t* P, const float* EXT, float* QKV, float* GB, int gw, int ngw, int lane) {
    const float* wconv = p.in[15]; const float* a_log = p.in[16]; const float* dt_bias = p.in[17];
    for (int tok = gw; tok < NT; tok += ngw) {
        int t, base; const float* buf = nullptr;
        if (tok < NP) { t = tok % SEQ; base = tok - t; } else { t = (tok - NP) % DSQ; base = tok - t; buf = p.in[3] + (size_t)((tok - NP) / DSQ) * 3 * 1536; }
        for (int seg = 0; seg < 3; ++seg) {
            const int c0 = seg * 512 + lane * 8;
            float y[8];
#pragma unroll
            for (int e = 0; e < 8; ++e) y[e] = 0.f;
            for (int j = 0; j < 4; ++j) {
                const int m = t - 3 + j; float xv[8];
                if (m >= 0) { const u32x4 r = *(const u32x4*)(P + (size_t)(base + m) * EV_N + c0);
                    xv[0] = bflo(r.x); xv[1] = bfhi(r.x); xv[2] = bflo(r.y); xv[3] = bfhi(r.y); xv[4] = bflo(r.z); xv[5] = bfhi(r.z); xv[6] = bflo(r.w); xv[7] = bfhi(r.w); }
                else if (buf) {
#pragma unroll
                    for (int e = 0; e < 8; ++e) xv[e] = buf[(size_t)(3 + m) * 1536 + c0 + e]; }
                else {
#pragma unroll
                    for (int e = 0; e < 8; ++e) xv[e] = 0.f; }
#pragma unroll
                for (int e = 0; e < 8; ++e) y[e] += wconv[j * 1536 + c0 + e] * xv[e];
            }
            float ss = 0.f;
#pragma unroll
            for (int e = 0; e < 8; ++e) { y[e] = siluf_(y[e]); ss += y[e] * y[e]; }
            if (seg < 2) {
                ss += __shfl_xor(ss, 1); ss += __shfl_xor(ss, 2); ss += __shfl_xor(ss, 4); ss += __shfl_xor(ss, 8);
                const float r = rsqrtf(ss + 1e-6f) * (seg == 0 ? 0.08838834764831845f : 1.f);
#pragma unroll
                for (int e = 0; e < 8; ++e) y[e] *= r;
            }
#pragma unroll
            for (int e = 0; e < 8; ++e) QKV[(size_t)tok * 1536 + c0 + e] = y[e];
        }
        if (lane < 4) {
            const float b = EXT[(size_t)tok * 24 + lane], a = EXT[(size_t)tok * 24 + 4 + lane];
            GB[(size_t)tok * 8 + lane] = -__expf(a_log[lane]) * softplusf_(a + dt_bias[lane]);
            GB[(size_t)tok * 8 + 4 + lane] = sigmoidf_(b);
        }
    }
    const int gt = gw * 64 + lane, ngt = ngw * 64;
    for (int i = gt; i < 4 * 3 * 1536; i += ngt) { const int b = i / 4608, r = (i / 1536) % 3, c = i % 1536; p.out[O_CAP + i] = bf2f(P[(size_t)(b * SEQ + 4093 + r) * EV_N + c]); }
    for (int i = gt; i < 128 * 3 * 1536; i += ngt) { const int b = i / 4608, r = (i / 1536) % 3, c = i % 1536; p.out[O_CAS + i] = bf2f(P[(size_t)(NP + b * 8 + 5 + r) * EV_N + c]); }
}

DEV void delta_recurrence(const Params& p, const float* QKV, const float* GB, float* OB, LAS unsigned char* lds, int first_item, int item_stride, int n_items_lo, int n_items_hi) {
    LAS float* kq = (LAS float*)lds;
    LAS float* red_kv = kq + 512;
    LAS float* red_o = red_kv + 512;
    const int tid = threadIdx.x, part = tid >> 7, j = tid & 127;
    for (int item = first_item; item < n_items_hi; item += item_stride) {
        if (item < n_items_lo) continue;
        int T, base, h; const float* S0 = nullptr; float* Sout;
        if (item < 16) { const int b = item >> 2; h = item & 3; T = SEQ; base = b * SEQ; Sout = p.out + O_DP + (size_t)(b * 4 + h) * 16384; }
        else { const int db = (item - 16) >> 2; h = (item - 16) & 3; T = DSQ; base = NP + db * DSQ; S0 = p.in[2] + (size_t)(db * 4 + h) * 16384; Sout = p.out + O_DS + (size_t)(db * 4 + h) * 16384; }
        float S[32];
#pragma unroll
        for (int i = 0; i < 32; ++i) S[i] = S0 ? S0[(size_t)(part * 32 + i) * 128 + j] : 0.f;
        for (int t = 0; t < T; ++t) {
            const size_t tok = (size_t)(base + t);
            if (tid < 384) { const int seg = tid >> 7; const int src = seg == 0 ? 512 : (seg == 1 ? 0 : 1024);
                kq[tid] = QKV[tok * 1536 + src + h * 128 + j]; }
            else if (tid == 384) kq[384] = GB[tok * 8 + h];
            else if (tid == 385) kq[385] = GB[tok * 8 + 4 + h];
            __syncthreads();
            const float decay = __expf(kq[384]), beta = kq[385];
            float pk = 0.f;
#pragma unroll
            for (int i = 0; i < 32; ++i) { S[i] *= decay; pk += S[i] * kq[part * 32 + i]; }
            red_kv[part * 128 + j] = pk;
            __syncthreads();
            const float kvm = (red_kv[j] + red_kv[128 + j]) + (red_kv[256 + j] + red_kv[384 + j]);
            const float dl = beta * (kq[256 + j] - kvm);
            float po = 0.f;
#pragma unroll
            for (int i = 0; i < 32; ++i) { S[i] += kq[part * 32 + i] * dl; po += S[i] * kq[128 + part * 32 + i]; }
            red_o[part * 128 + j] = po;
            __syncthreads();
            if (part == 0) OB[tok * 512 + h * 128 + j] = (red_o[j] + red_o[128 + j]) + (red_o[256 + j] + red_o[384 + j]);
        }
#pragma unroll
        for (int i = 0; i < 32; ++i) Sout[(size_t)(part * 32 + i) * 128 + j] = S[i];
        __syncthreads();
    }
}

DEV void phase_even_c(const Params& p, const bf16_t* P, const float* OB, bf16_t* MIX, int gw, int ngw, int lane) {
    const float* gn = p.in[18]; const float* wb = p.in[19];
    for (int tok = gw; tok < NT; tok += ngw) {
        int t, base; const float* buf = nullptr;
        if (tok < NP) { t = tok % SEQ; base = tok - t; } else { t = (tok - NP) % DSQ; base = tok - t; buf = p.in[4] + (size_t)((tok - NP) / DSQ) * 2 * 512; }
        const int c0 = lane * 8;
        {
            float o[8]; float ss = 0.f;
#pragma unroll
            for (int e = 0; e < 8; ++e) { o[e] = OB[(size_t)tok * 512 + c0 + e]; ss += o[e] * o[e]; }
            ss += __shfl_xor(ss, 1); ss += __shfl_xor(ss, 2); ss += __shfl_xor(ss, 4); ss += __shfl_xor(ss, 8);
            const float r = rsqrtf(ss * (1.f / 128.f) + 1e-6f);
            const u32x4 zr = *(const u32x4*)(P + (size_t)tok * EV_N + 1536 + c0);
            const float z[8] = {bflo(zr.x), bfhi(zr.x), bflo(zr.y), bfhi(zr.y), bflo(zr.z), bfhi(zr.z), bflo(zr.w), bfhi(zr.w)};
            float w[8];
#pragma unroll
            for (int e = 0; e < 8; ++e) w[e] = o[e] * r * gn[(c0 + e) & 127] * siluf_(z[e]);
            u32x4 st; st.x = pk2(w[0], w[1]); st.y = pk2(w[2], w[3]); st.z = pk2(w[4], w[5]); st.w = pk2(w[6], w[7]);
            *(u32x4*)(MIX + (size_t)tok * D + c0) = st;
        }
        {
            float y[8], cxl[8];
#pragma unroll
            for (int e = 0; e < 8; ++e) { y[e] = 0.f; cxl[e] = 0.f; }
            for (int j = 0; j < 3; ++j) {
                const int m = t - 2 + j; float cx[8];
                if (m >= 0) { const u32x4 hr = *(const u32x4*)(P + (size_t)(base + m) * EV_N + 2048 + c0); const u32x4 cr = *(const u32x4*)(P + (size_t)(base + m) * EV_N + 3072 + c0);
                    cx[0] = bflo(hr.x) * bflo(cr.x); cx[1] = bfhi(hr.x) * bfhi(cr.x); cx[2] = bflo(hr.y) * bflo(cr.y); cx[3] = bfhi(hr.y) * bfhi(cr.y);
                    cx[4] = bflo(hr.z) * bflo(cr.z); cx[5] = bfhi(hr.z) * bfhi(cr.z); cx[6] = bflo(hr.w) * bflo(cr.w); cx[7] = bfhi(hr.w) * bfhi(cr.w); }
                else if (buf) {
#pragma unroll
                    for (int e = 0; e < 8; ++e) cx[e] = buf[(size_t)(2 + m) * 512 + c0 + e]; }
                else {
#pragma unroll
                    for (int e = 0; e < 8; ++e) cx[e] = 0.f; }
#pragma unroll
                for (int e = 0; e < 8; ++e) { y[e] += wb[j * 512 + c0 + e] * cx[e]; cxl[e] = cx[e]; }
            }
            const u32x4 br = *(const u32x4*)(P + (size_t)tok * EV_N + 2560 + c0);
            const float gb[8] = {bflo(br.x), bfhi(br.x), bflo(br.y), bfhi(br.y), bflo(br.z), bfhi(br.z), bflo(br.w), bfhi(br.w)};
            u32x4 st; st.x = pk2(gb[0] * y[0], gb[1] * y[1]); st.y = pk2(gb[2] * y[2], gb[3] * y[3]); st.z = pk2(gb[4] * y[4], gb[5] * y[5]); st.w = pk2(gb[6] * y[6], gb[7] * y[7]);
            *(u32x4*)(MIX + (size_t)tok * D + 512 + c0) = st;
            if (tok < NP) { if (t >= SEQ - 2) {
#pragma unroll
                for (int e = 0; e < 8; ++e) p.out[O_CBP + (size_t)((tok / SEQ) * 2 + (t - (SEQ - 2))) * 512 + c0 + e] = cxl[e]; } }
            else if (t >= DSQ - 2) {
#pragma unroll
                for (int e = 0; e < 8; ++e) p.out[O_CBS + (size_t)(((tok - NP) / DSQ) * 2 + (t - (DSQ - 2))) * 512 + c0 + e] = cxl[e]; }
        }
    }
}

DEV void phase_odd_a(const Params& p, const bf16_t* P, const float* EXT, float* GATES, float* UG, float* VLN, int gw, int ngw, int lane) {
    const float* ln_g = p.in[27]; const float* ln_b = p.in[28];
    for (int tok = gw; tok < NT; tok += ngw) {
        if (lane < 24) GATES[(size_t)tok * 24 + lane] = sigmoidf_(EXT[(size_t)tok * 24 + lane]);
        for (int c = lane; c < 768; c += 64) {
            const float v = bf2f(P[(size_t)tok * OD_N + 512 + c]); const int br = c >> 8, idx = c & 255;
            if (tok < NP) {
                if (br == 0) p.out[O_CMP + (size_t)tok * 256 + idx] = v;
                else if (br == 1) p.out[O_SLP + (size_t)tok * 256 + idx] = v;
                else { const int t = tok % SEQ; if (t >= SEQ - 512) p.out[O_WNP + ((size_t)(tok / SEQ) * 512 + (t - (SEQ - 512))) * 256 + idx] = v; }
            } else {
                const int s = tok - NP;
                if (br == 0) p.out[O_CMS + (size_t)s * 256 + idx] = v;
                else if (br == 1) p.out[O_SLS + (size_t)s * 256 + idx] = v;
                else p.out[O_WNS + ((size_t)(s / DSQ) * 512 + 504 + (s % DSQ)) * 256 + idx] = v;
            }
        }
        const int c0 = lane * 8;
        const u32x4 ur = *(const u32x4*)(P + (size_t)tok * OD_N + 1280 + c0); const u32x4 vr = *(const u32x4*)(P + (size_t)tok * OD_N + 1792 + c0);
        const float uu[8] = {bflo(ur.x), bfhi(ur.x), bflo(ur.y), bfhi(ur.y), bflo(ur.z), bfhi(ur.z), bflo(ur.w), bfhi(ur.w)};
        float vv[8] = {bflo(vr.x), bfhi(vr.x), bflo(vr.y), bfhi(vr.y), bflo(vr.z), bfhi(vr.z), bflo(vr.w), bfhi(vr.w)};
        float s = 0.f;
#pragma unroll
        for (int e = 0; e < 8; ++e) { UG[(size_t)tok * 512 + c0 + e] = geluf_(uu[e]); vv[e] = geluf_(vv[e]); s += vv[e]; }
        const float mu = wave_sum(s) * (1.f / 512.f); float q = 0.f;
#pragma unroll
        for (int e = 0; e < 8; ++e) { vv[e] -= mu; q += vv[e] * vv[e]; }
        const float r = rsqrtf(wave_sum(q) * (1.f / 512.f) + 1e-6f);
#pragma unroll
        for (int e = 0; e < 8; ++e) { const float o = vv[e] * r * ln_g[c0 + e] + ln_b[c0 + e]; VLN[(size_t)tok * 512 + c0 + e] = o;
            if (tok >= NP) p.out[O_DV + (size_t)(tok - NP) * 512 + c0 + e] = o; }
    }
    const size_t gt = (size_t)gw * 64 + lane, ngt = (size_t)ngw * 64;
    for (size_t i = gt; i < (size_t)128 * 504 * 256; i += ngt) { const size_t db = i / (504 * 256), r = i % (504 * 256); p.out[O_WNS + db * 512 * 256 + r] = p.in[7][db * 512 * 256 + 8 * 256 + r]; }
}

struct RowRef { const float* f; const bf16_t* h; };
DEV float rr_get(const RowRef& r, int d) { return r.f ? r.f[d] : bf2f(r.h[d]); }
DEV RowRef kv_row(const Params& p, const bf16_t* P, int seqidx, int br, int kv, int g, int pos) {
    RowRef r; r.f = nullptr; r.h = nullptr;
    const int co = 512 + br * 256 + kv * 128 + g * 64;
    if (seqidx < 4) { r.h = P + ((size_t)seqidx * SEQ + pos) * OD_N + co; return r; }
    const int db = seqidx - 4;
    if (pos >= PAST) { r.h = P + ((size_t)NP + db * DSQ + (pos - PAST)) * OD_N + co; return r; }
    if (br == 2) { r.f = p.in[7] + ((((size_t)db * 512 + (pos - (PAST - 512))) * 2 + kv) * 2 + g) * 64; return r; }
    const int page = p.page_table[db * 16 + (pos >> 7)];
    r.f = (br == 0 ? p.in[5] : p.in[6]) + ((((size_t)page * 128 + (pos & 127)) * 2 + kv) * 2 + g) * 64;
    return r;
}
DEV size_t kc_off(int seqidx, int g, int j) { return seqidx < 4 ? ((size_t)(seqidx * 2 + g) * 256 + j) * 64 : ((size_t)4 * 2 * 256 + (size_t)((seqidx - 4) * 2 + g) * 128 + j) * 64; }

DEV void phase_compress_naive(const Params& p, const bf16_t* P, float* KCF, LAS unsigned char* lds, int gw, int ngw, int lane, int wave) {
    LAS float* hid = (LAS float*)lds + wave * 128;
    const float* pe = p.in[22]; const float* w1 = p.in[23]; const float* w2 = p.in[24];
    const int n_p = 4 * 2 * 255 * 2, n_s = 128 * 2 * 127 * 2;
    for (int it = gw; it < n_p + n_s; it += ngw) {
        int seqidx, g, j, kv;
        if (it < n_p) { kv = it & 1; int r = it >> 1; j = r % 255; r /= 255; g = r & 1; seqidx = r >> 1; }
        else { int r = it - n_p; kv = r & 1; r >>= 1; j = r % 127; r /= 127; g = r & 1; seqidx = 4 + (r >> 1); }
        float a0 = 0.f, a1 = 0.f;
        for (int s = 0; s < 32; ++s) {
            const RowRef rr = kv_row(p, P, seqidx, 0, kv, g, 16 * j + s);
            for (int d = 0; d < 64; ++d) {
                const float x = rr_get(rr, d) + pe[(size_t)(kv * 32 + s) * 64 + d];
                const float* wr_ = w1 + ((size_t)(kv * 32 + s) * 64 + d) * 128;
                a0 += x * wr_[lane]; a1 += x * wr_[lane + 64];
            }
        }
        hid[lane] = siluf_(a0); hid[lane + 64] = siluf_(a1);
        asm volatile("s_waitcnt lgkmcnt(0)" ::: "memory");
        float o = 0.f;
        for (int h = 0; h < 128; ++h) o += hid[h] * w2[(size_t)kv * 8192 + h * 64 + lane];
        KCF[(size_t)kv * KC_ELEMS + kc_off(seqidx, g, j) + lane] = o;
        asm volatile("s_waitcnt lgkmcnt(0)" ::: "memory");
    }
}

DEV void phase_attn_naive(const Params& p, const bf16_t* P, const float* KCF, const float* GATES, bf16_t* MIX, LAS unsigned char* lds, int gw, int ngw, int lane, int wave) {
    LAS float* qs = (LAS float*)lds + wave * 1216;
    LAS float* pbuf = qs + 64;
    LAS float* pc = pbuf + 1024;
    LAS int* blk = (LAS int*)pc;
    const float NEG = -1e30f;
    for (int it = gw; it < 4 * 2 * SEQ + 128 * 2 * DSQ; it += ngw) {
        int seqidx, g, ti, qpos, tok, nc, ns, wstart;
        if (it < 4 * 2 * SEQ) { ti = it % SEQ; const int r = it / SEQ; g = r & 1; seqidx = r >> 1; qpos = ti; tok = seqidx * SEQ + ti; nc = 255; ns = 64; wstart = 0; }
        else { const int r0 = it - 4 * 2 * SEQ; ti = r0 % DSQ; const int r = r0 / DSQ; g = r & 1; seqidx = 4 + (r >> 1); qpos = PAST + ti; tok = NP + (seqidx - 4) * DSQ + ti; nc = 127; ns = 33; wstart = PAST - 512; }
        const int cur = qpos >> 6;
        float imp = 0.f; float oc[4];
        for (int r = 0; r < 4; ++r) {
            const int h = g * 4 + r; const float slope = exp2f(-(float)(h + 1));
            qs[lane] = bf2f(P[(size_t)tok * OD_N + h * 64 + lane]) * 0.125f;
            asm volatile("s_waitcnt lgkmcnt(0)" ::: "memory");
            float sc[4]; float mx = NEG;
            for (int jj = 0; jj < 4; ++jj) { const int j = jj * 64 + lane; const bool ok = j < nc && 16 * j + 31 <= qpos; float s = NEG;
                if (ok) { const float* kr = KCF + kc_off(seqidx, g, j); s = 0.f; for (int d = 0; d < 64; ++d) s += qs[d] * kr[d]; s -= slope * (float)(qpos - (16 * j + 31)); }
                sc[jj] = s; mx = fmaxf(mx, s); }
            for (int o = 1; o < 64; o <<= 1) mx = fmaxf(mx, __shfl_xor(mx, o));
            float sum = 0.f;
            for (int jj = 0; jj < 4; ++jj) { sc[jj] = sc[jj] > -1e29f ? __expf(sc[jj] - mx) : 0.f; sum += sc[jj]; }
            sum = fmaxf(wave_sum(sum), 1e-30f);
            for (int jj = 0; jj < 4; ++jj) pbuf[jj * 64 + lane] = sc[jj] / sum;
            asm volatile("s_waitcnt lgkmcnt(0)" ::: "memory");
            float o = 0.f;
            for (int j = 0; j < nc; ++j) o += pbuf[j] * KCF[KC_ELEMS + kc_off(seqidx, g, j) + lane];
            oc[r] = o;
            for (int j = 4 * lane - 1; j <= 4 * lane + 3; ++j) if (j >= 0 && j < nc) {
                const int lo = max(16 * j, 64 * lane), hi = min(16 * j + 32, 64 * lane + 64); if (hi > lo) imp += pbuf[j] * ((float)(hi - lo) * (1.f / 32.f)); }
            asm volatile("s_waitcnt lgkmcnt(0)" ::: "memory");
        }
        const bool valid = lane < ns && lane <= cur; const bool forced = lane == 0 || lane == cur || lane == cur - 1;
        const float score = valid ? (forced ? 1e4f : imp) : NEG;
        int rank = 0;
        for (int s2 = 0; s2 < ns; ++s2) { const float o = __shfl(score, s2); rank += (o > score || (o == score && s2 < lane)) ? 1 : 0; }
        const unsigned long long selmask = __ballot(valid && rank < 16);
        if (lane == 0) { int n = 0; for (int s2 = 0; s2 < 64; ++s2) if ((selmask >> s2) & 1ull) blk[n++] = s2; for (; n < 16; ++n) blk[n] = -1; }
        asm volatile("s_waitcnt lgkmcnt(0)" ::: "memory");
        const int nsel = __popcll(selmask);
        for (int r = 0; r < 4; ++r) {
            const int h = g * 4 + r; const float slope = exp2f(-(float)(h + 1));
            qs[lane] = bf2f(P[(size_t)tok * OD_N + h * 64 + lane]) * 0.125f;
            asm volatile("s_waitcnt lgkmcnt(0)" ::: "memory");
            float res[2];
            for (int brn = 1; brn <= 2; ++brn) {
                const int wlo = max(wstart, qpos - 511);
                const int nkeys = brn == 1 ? nsel * 64 : (qpos - wlo + 1);
                float mx = NEG;
                for (int i0 = 0; i0 < nkeys; i0 += 64) { const int i = i0 + lane; float s = NEG;
                    if (i < nkeys) { const int pos = brn == 1 ? blk[i >> 6] * 64 + (i & 63) : wlo + i;
                        if (pos <= qpos) { const RowRef kr = kv_row(p, P, seqidx, brn, 0, g, pos); s = 0.f; for (int d = 0; d < 64; ++d) s += qs[d] * rr_get(kr, d); s -= slope * (float)(qpos - pos); } }
                    if (i < 1024) pbuf[i] = s; mx = fmaxf(mx, s); }
                for (int o = 1; o < 64; o <<= 1) mx = fmaxf(mx, __shfl_xor(mx, o));
                asm volatile("s_waitcnt lgkmcnt(0)" ::: "memory");
                float sum = 0.f;
                for (int i0 = 0; i0 < nkeys; i0 += 64) { const int i = i0 + lane; if (i < nkeys) { const float s = pbuf[i]; const float e = s > -1e29f ? __expf(s - mx) : 0.f; pbuf[i] = e; sum += e; } }
                sum = fmaxf(wave_sum(sum), 1e-30f);
                asm volatile("s_waitcnt lgkmcnt(0)" ::: "memory");
                float o = 0.f;
                for (int i = 0; i < nkeys; ++i) { const float e = pbuf[i]; if (e != 0.f) { const int pos = brn == 1 ? blk[i >> 6] * 64 + (i & 63) : wlo + i; const RowRef vr = kv_row(p, P, seqidx, brn, 1, g, pos); o += e * rr_get(vr, lane); } }
                res[brn - 1] = o / sum;
                asm volatile("s_waitcnt lgkmcnt(0)" ::: "memory");
            }
            const float* gt = GATES + (size_t)tok * 24 + h * 3;
            MIX[(size_t)tok * D + h * 64 + lane] = (bf16_t)f2bf(gt[0] * oc[r] + gt[1] * res[0] + gt[2] * res[1]);
        }
    }
}

DEV void phase_chunkmlp_naive(const Params& p, const float* UG, const float* VLN, bf16_t* MIX, int gw, int ngw, int lane) {
    const float* wsd = p.in[25]; const float* bsd = p.in[26];
    const size_t gt = (size_t)gw * 64 + lane, ngt = (size_t)ngw * 64;
    for (size_t i = gt; i < (size_t)NT * 512; i += ngt) {
        const int tok = (int)(i >> 9), ch = (int)(i & 511), g = ch >> 6;
        const int tc = tok < NP ? (tok % SEQ) & 127 : (tok - NP) % DSQ;
        float m = bsd[g * 128 + tc];
        const float* wr_ = wsd + ((size_t)g * 128 + tc) * 128;
        for (int s = 0; s <= tc; ++s) m += wr_[s] * VLN[(size_t)(tok - tc + s) * 512 + ch];
        MIX[(size_t)tok * D + 512 + ch] = (bf16_t)f2bf(UG[i] * m);
    }
}

__global__ void __launch_bounds__(NTHR, 2) fwd_kernel(Params p) {
    extern __shared__ __attribute__((aligned(16))) unsigned char lds_raw[];
    LAS unsigned char* lds = (LAS unsigned char*)lds_raw;
    cg::grid_group grid = cg::this_grid();
    const int tid = threadIdx.x, lane = tid & 63, wave = __builtin_amdgcn_readfirstlane(tid >> 6);
    const int G = gridDim.x, gw = blockIdx.x * 8 + wave, ngw = G * 8;
    unsigned char* ws = p.ws;
    float* X = (float*)(ws + WS_X); bf16_t* H = (bf16_t*)(ws + WS_H); bf16_t* ACT = (bf16_t*)(ws + WS_ACT); float* Y = (float*)(ws + WS_Y);
    bf16_t* P = (bf16_t*)(ws + WS_P); float* EXT = (float*)(ws + WS_EXT); bf16_t* MIX = (bf16_t*)(ws + WS_MIX); float* OB = (float*)(ws + WS_OB);
    float* QKV = (float*)(ws + WS_QKV); float* GB = (float*)(ws + WS_GB); float* GATES = (float*)(ws + WS_GATES); float* UG = (float*)(ws + WS_UG); float* VLN = (float*)(ws + WS_VLN);
    float* KCF = (float*)(ws + WS_KCF);
    const float* norm_g = p.in[9];
#define GSYNC() grid.sync()
#define FFN(mat) do { gemm_phase(lds, H, (const bf16_t*)(ws + WS_WGU) + (size_t)(mat) * 5632 * 1024, NT, 5632, 1024, EpiSwiglu{ACT}); GSYNC(); \
                      gemm_phase(lds, ACT, (const bf16_t*)(ws + WS_WD) + (size_t)(mat) * 1024 * FF, NT, 1024, FF, EpiF32{Y, D}); GSYNC(); } while (0)

#if DEBUG_FILL
    for (size_t i = (size_t)gw * 64 + lane; i < O_END; i += (size_t)ngw * 64) p.out[i] = 0.f;
#endif
    phase_prep(p, lds, gw, ngw, lane, wave);
    { RowNormArgs a{}; a.x_src_p = p.in[0]; a.x_src_s = p.in[1]; a.g_pre = norm_g + 0 * D; a.h_dst = H; phase_rownorm(a, lds, gw, ngw, lane); }
    GSYNC();
    FFN(0);
    { RowNormArgs a{}; a.x_src_p = p.in[0]; a.x_src_s = p.in[1]; a.Y = Y; a.g_post = norm_g + 1 * D; a.scale = 0.5f; a.x_dst = X; a.g_pre = norm_g + 2 * D; a.h_dst = H;
      a.w_ext = p.in[13]; a.ext_ld = EV_SRC; a.ext_c0 = 2048; a.n_ext = 8; a.ext_dst = EXT; phase_rownorm(a, lds, gw, ngw, lane); }
    GSYNC();
    gemm_phase(lds, H, (const bf16_t*)(ws + WS_WEIN), NT, EV_N, 1024, EpiBf16{P, EV_N});
    GSYNC();
    phase_even_a(p, P, EXT, QKV, GB, gw, ngw, lane);
    GSYNC();
    delta_recurrence(p, QKV, GB, OB, lds, blockIdx.x, G, 0, 16 + 512);
    GSYNC();
    phase_even_c(p, P, OB, MIX, gw, ngw, lane);
    GSYNC();
    gemm_phase(lds, MIX, (const bf16_t*)(ws + WS_WEOUT), NT, 1024, 1024, EpiF32{Y, D});
    GSYNC();
    { RowNormArgs a{}; a.x_src_p = X; a.x_src_s = X + (size_t)NP * D; a.Y = Y; a.g_post = norm_g + 3 * D; a.scale = 1.f; a.x_dst = X; a.g_pre = norm_g + 4 * D; a.h_dst = H; phase_rownorm(a, lds, gw, ngw, lane); }
    GSYNC();
    FFN(1);
    { RowNormArgs a{}; a.x_src_p = X; a.x_src_s = X + (size_t)NP * D; a.Y = Y; a.g_post = norm_g + 5 * D; a.scale = 0.5f; a.x_dst = X; a.g_pre = norm_g + 6 * D; a.h_dst = H; phase_rownorm(a, lds, gw, ngw, lane); }
    GSYNC();
    FFN(2);
    { RowNormArgs a{}; a.x_src_p = X; a.x_src_s = X + (size_t)NP * D; a.Y = Y; a.g_post = norm_g + 7 * D; a.scale = 0.5f; a.x_dst = X; a.g_pre = norm_g + 8 * D; a.h_dst = H;
      a.w_ext = p.in[20]; a.ext_ld = OD_SRC; a.ext_c0 = 512; a.n_ext = 24; a.ext_dst = EXT; phase_rownorm(a, lds, gw, ngw, lane); }
    GSYNC();
    gemm_phase(lds, H, (const bf16_t*)(ws + WS_WOIN), NT, OD_N, 1024, EpiBf16{P, OD_N});
    GSYNC();
    phase_odd_a(p, P, EXT, GATES, UG, VLN, gw, ngw, lane);
    phase_compress_naive(p, P, KCF, lds, gw, ngw, lane, wave);
    GSYNC();
    phase_attn_naive(p, P, KCF, GATES, MIX, lds, gw, ngw, lane, wave);
    phase_chunkmlp_naive(p, UG, VLN, MIX, gw, ngw, lane);
    GSYNC();
    gemm_phase(lds, MIX, (const bf16_t*)(ws + WS_WOOUT), NT, 1024, 1024, EpiF32{Y, D});
    GSYNC();
    { RowNormArgs a{}; a.x_src_p = X; a.x_src_s = X + (size_t)NP * D; a.Y = Y; a.g_post = norm_g + 9 * D; a.scale = 1.f; a.x_dst = X; a.g_pre = norm_g + 10 * D; a.h_dst = H; phase_rownorm(a, lds, gw, ngw, lane); }
    GSYNC();
    FFN(3);
    { RowNormArgs a{}; a.x_src_p = X; a.x_src_s = X + (size_t)NP * D; a.Y = Y; a.g_post = norm_g + 11 * D; a.scale = 0.5f; a.out_p = p.out + O_YP; a.out_s = p.out + O_YS; phase_rownorm(a, lds, gw, ngw, lane); }
}

extern "C" void kernel_launch(void* const* d_in, const int* in_sizes, int n_in, void* d_out, int out_size, void* d_ws, size_t ws_size, hipStream_t stream) {
    constexpr int LDS_BYTES = 147456;
    static int grid = 0;
    if (grid == 0) {
        int dev = 0, cus = 0, per_cu = 0;
        hipGetDevice(&dev);
        hipDeviceGetAttribute(&cus, hipDeviceAttributeMultiprocessorCount, dev);
        hipFuncSetAttribute((const void*)fwd_kernel, hipFuncAttributeMaxDynamicSharedMemorySize, LDS_BYTES);
        hipOccupancyMaxActiveBlocksPerMultiprocessor(&per_cu, (const void*)fwd_kernel, NTHR, LDS_BYTES);
        if (per_cu < 1) { fprintf(stderr, "occupancy query says %d blocks/CU\n", per_cu); per_cu = 1; }
        grid = cus;
        if (ws_size < WS_END) { fprintf(stderr, "workspace too small: %zu < %zu\n", ws_size, (size_t)WS_END); grid = -1; }
        if (n_in != 29) { fprintf(stderr, "expected 29 inputs, got %d\n", n_in); grid = -1; }
    }
    if (grid < 0) return;
    Params p{};
    for (int i = 0; i < 29; ++i) p.in[i] = (const float*)d_in[i];
    p.page_table = (const int*)d_in[8];
    p.out = (float*)d_out; p.ws = (unsigned char*)d_ws;
    void* args[] = {&p};
    hipError_t e = hipLaunchCooperativeKernel((const void*)fwd_kernel, dim3(grid), dim3(NTHR), args, LDS_BYTES, stream);
    if (e != hipSuccess) fprintf(stderr, "cooperative launch failed: %s (grid %d)\n", hipGetErrorString(e), grid);
}
```

```cpp
#include <hip/hip_runtime.h>
#include <hip/hip_cooperative_groups.h>
#include <cstdio>
#include <cstdint>
namespace cg = cooperative_groups;
#define DEBUG_FILL 0

typedef unsigned short bf16_t;
typedef short bf16x8 __attribute__((ext_vector_type(8)));
typedef float f32x4 __attribute__((ext_vector_type(4)));
typedef unsigned u32x4 __attribute__((ext_vector_type(4)));
typedef unsigned u32x2 __attribute__((ext_vector_type(2)));
#define DEV __device__ __forceinline__
#define LAS __attribute__((address_space(3)))

constexpr int D = 1024, NP = 16384, NS = 1024, NT = NP + NS, SEQ = 4096, NB = 4, DB = 128, DSQ = 8, PAST = 2048;
constexpr int FF = 2816;
constexpr int EV_N = 3584, EV_SRC = 3592, OD_N = 2304, OD_SRC = 2328;
constexpr int NTHR = 512;

constexpr size_t O_YP = 0, O_YS = O_YP + (size_t)NP * D, O_DP = O_YS + (size_t)NS * D, O_DS = O_DP + 4 * 4 * 128 * 128,
                 O_CAP = O_DS + (size_t)128 * 4 * 128 * 128, O_CAS = O_CAP + 4 * 3 * 1536, O_CBP = O_CAS + 128 * 3 * 1536,
                 O_CBS = O_CBP + 4 * 2 * 512, O_CMP = O_CBS + 128 * 2 * 512, O_CMS = O_CMP + (size_t)NP * 256,
                 O_SLP = O_CMS + (size_t)NS * 256, O_SLS = O_SLP + (size_t)NP * 256, O_WNP = O_SLS + (size_t)NS * 256,
                 O_WNS = O_WNP + 4 * 512 * 256, O_DV = O_WNS + (size_t)128 * 512 * 256, O_END = O_DV + (size_t)NS * 512;

constexpr size_t al256(size_t x) { return (x + 255) & ~(size_t)255; }
constexpr size_t WS_WGU = 0;
constexpr size_t WS_WD = WS_WGU + (size_t)4 * 5632 * 1024 * 2;
constexpr size_t WS_WEIN = WS_WD + (size_t)4 * 1024 * 2816 * 2;
constexpr size_t WS_WEOUT = WS_WEIN + (size_t)EV_N * 1024 * 2;
constexpr size_t WS_WOIN = WS_WEOUT + (size_t)1024 * 1024 * 2;
constexpr size_t WS_WOOUT = WS_WOIN + (size_t)OD_N * 1024 * 2;
constexpr size_t WS_WC1 = WS_WOOUT + (size_t)1024 * 1024 * 2;
constexpr size_t WS_WC2 = WS_WC1 + (size_t)2 * 256 * 1024 * 2;
constexpr size_t WS_WDS = WS_WC2 + (size_t)2 * 64 * 128 * 2;
constexpr size_t WS_CBIAS = WS_WDS + (size_t)8 * 128 * 128 * 2;
constexpr size_t WS_X = al256(WS_CBIAS + 2 * 128 * 4);
constexpr size_t WS_H = WS_X + (size_t)NT * D * 4;
constexpr size_t WS_ACT = WS_H + (size_t)NT * D * 2;
constexpr size_t WS_Y = WS_ACT + (size_t)NT * FF * 2;
constexpr size_t WS_P = WS_Y + (size_t)NT * D * 4;
constexpr size_t WS_EXT = WS_P + (size_t)NT * EV_N * 2;
constexpr size_t WS_MIX = al256(WS_EXT + (size_t)NT * 24 * 4);
constexpr size_t WS_OB = WS_MIX + (size_t)NT * D * 2;
constexpr size_t WS_CW = WS_OB + (size_t)NT * 512 * 4;
constexpr size_t WS_CQ = WS_CW + (size_t)1024 * 64 * 128 * 2;
constexpr size_t WS_CKT = WS_CQ + (size_t)1024 * 64 * 128 * 2;
constexpr size_t WS_CU = WS_CKT + (size_t)1024 * 64 * 128 * 2;
constexpr size_t WS_CI = WS_CU + (size_t)1024 * 64 * 128 * 4;
constexpr size_t WS_CGL = WS_CI + (size_t)1024 * 64 * 64 * 2;
constexpr size_t WS_KC = al256(WS_CGL + 1024 * 4);
constexpr size_t KC_ELEMS = (size_t)(4 * 2 * 256 + 128 * 2 * 128) * 64;
constexpr size_t WS_VC = WS_KC + KC_ELEMS * 2;
constexpr size_t WS_QKV = al256(WS_VC + KC_ELEMS * 2);
constexpr size_t WS_GB = WS_QKV + (size_t)NT * 1536 * 4;
constexpr size_t WS_GATES = WS_GB + (size_t)NT * 8 * 4;
constexpr size_t WS_UG = al256(WS_GATES + (size_t)NT * 24 * 4);
constexpr size_t WS_VLN = WS_UG + (size_t)NT * 512 * 4;
constexpr size_t WS_KCF = WS_VLN + (size_t)NT * 512 * 4;
constexpr size_t WS_END = WS_KCF + KC_ELEMS * 2 * 4;

struct Params {
    const float* in[29];
    const int* page_table;
    float* out;
    unsigned char* ws;
};

DEV unsigned f2bf(float f) { unsigned u = __builtin_bit_cast(unsigned, f); return (u + 0x7fffu + ((u >> 16) & 1u)) >> 16; }
DEV unsigned pk2(float lo, float hi) { return f2bf(lo) | (f2bf(hi) << 16); }
DEV float bf2f(unsigned short v) { return __builtin_bit_cast(float, (unsigned)v << 16); }
DEV float bflo(unsigned v) { return __builtin_bit_cast(float, v << 16); }
DEV float bfhi(unsigned v) { return __builtin_bit_cast(float, v & 0xffff0000u); }
DEV int opaque_tid() { int t = threadIdx.x; asm volatile("" : "+v"(t)); return t; }
DEV float wave_sum(float v) {
#pragma unroll
    for (int o = 1; o < 64; o <<= 1) v += __shfl_xor(v, o);
    return v;
}
DEV float sigmoidf_(float x) { return 1.f / (1.f + __expf(-x)); }
DEV float siluf_(float x) { return x / (1.f + __expf(-x)); }
DEV float softplusf_(float x) { return x > 20.f ? x : log1pf(__expf(x)); }
DEV float geluf_(float x) { const float u = 0.7978845608028654f * (x + 0.044715f * x * x * x); return 0.5f * x * (1.f + tanhf(u)); }

DEV void transpose_item(const float* W, int ldn, int k0, int n0, bf16_t* WT, int ldk, int dst_row0, LAS float* scr, int lane) {
#pragma unroll 8
    for (int i = 0; i < 32; ++i) { const int kk = 2 * i + (lane >> 5); scr[kk * 33 + (lane & 31)] = W[(size_t)(k0 + kk) * ldn + n0 + (lane & 31)]; }
    asm volatile("s_waitcnt lgkmcnt(0)" ::: "memory");
    const int c = lane & 7;
#pragma unroll
    for (int j = 0; j < 4; ++j) { const int n = (lane >> 3) + 8 * j; const LAS float* s = scr + (8 * c) * 33 + n;
        u32x4 o; o.x = pk2(s[0 * 33], s[1 * 33]); o.y = pk2(s[2 * 33], s[3 * 33]); o.z = pk2(s[4 * 33], s[5 * 33]); o.w = pk2(s[6 * 33], s[7 * 33]);
        *(u32x4*)(WT + (size_t)(dst_row0 + n) * ldk + k0 + 8 * c) = o; }
    asm volatile("s_waitcnt lgkmcnt(0)" ::: "memory");
}

DEV void phase_prep(const Params& p, LAS unsigned char* lds, int gw, int ngw, int lane, int wave) {
    LAS float* scr = (LAS float*)(lds + wave * 16384);
    unsigned char* ws = p.ws;
    constexpr int I_G = 16 * 88;
    constexpr int I_D = 44 * 32;
    constexpr int I_EIN = 16 * 112, I_SQ = 16 * 32, I_OIN = 16 * 72, I_C1 = 4 * 16 * 4;
    constexpr int T0 = 4 * I_G, T1 = T0 + 4 * I_G, T2 = T1 + 4 * I_D, T3 = T2 + I_EIN, T4 = T3 + I_SQ, T5 = T4 + I_OIN, T6 = T5 + I_SQ, T7 = T6 + I_C1;
    for (int it = gw; it < T7; it += ngw) {
        if (it < T1) {
            const bool up = it >= T0; const int r = up ? it - T0 : it; const int mat = r / I_G, rr = r % I_G, kb = rr / 88, nb = rr % 88;
            const float* W = (up ? p.in[11] : p.in[10]) + (size_t)mat * 1024 * FF;
            bf16_t* WT = (bf16_t*)(ws + WS_WGU) + (size_t)mat * 5632 * 1024;
            const int n0 = nb * 32, pn = n0 / 128, c = n0 % 128;
            transpose_item(W, FF, kb * 64, n0, WT, 1024, pn * 256 + (up ? 128 : 0) + c, scr, lane);
        } else if (it < T2) {
            const int r = it - T1, mat = r / I_D, rr = r % I_D, kb = rr / 32, nb = rr % 32;
            transpose_item(p.in[12] + (size_t)mat * FF * 1024, 1024, kb * 64, nb * 32, (bf16_t*)(ws + WS_WD) + (size_t)mat * 1024 * FF, FF, nb * 32, scr, lane);
        } else if (it < T3) {
            const int r = it - T2, kb = r / 112, nb = r % 112, dr = nb * 32;
            transpose_item(p.in[13], EV_SRC, kb * 64, dr < 2048 ? dr : dr + 8, (bf16_t*)(ws + WS_WEIN), 1024, dr, scr, lane);
        } else if (it < T4) {
            const int r = it - T3, kb = r / 32, nb = r % 32;
            transpose_item(p.in[14], 1024, kb * 64, nb * 32, (bf16_t*)(ws + WS_WEOUT), 1024, nb * 32, scr, lane);
        } else if (it < T5) {
            const int r = it - T4, kb = r / 72, nb = r % 72, dr = nb * 32;
            transpose_item(p.in[20], OD_SRC, kb * 64, dr < 512 ? dr : dr + 24, (bf16_t*)(ws + WS_WOIN), 1024, dr, scr, lane);
        } else if (it < T6) {
            const int r = it - T5, kb = r / 32, nb = r % 32;
            transpose_item(p.in[21], 1024, kb * 64, nb * 32, (bf16_t*)(ws + WS_WOOUT), 1024, nb * 32, scr, lane);
        } else {
            const int r = it - T6, kvh = r / 64, rr = r % 64, kb = rr / 4, nb = rr % 4;
            const float* W = p.in[23] + (size_t)(kvh >> 1) * 2048 * 128 + (size_t)(kvh & 1) * 1024 * 128;
            transpose_item(W, 128, kb * 64, nb * 32, (bf16_t*)(ws + WS_WC1) + (size_t)(kvh >> 1) * 256 * 1024, 1024, (kvh & 1) * 128 + nb * 32, scr, lane);
        }
    }
    const int gt = gw * 64 + lane, ngt = ngw * 64;
    for (int i = gt; i < 2 * 64 * 128; i += ngt) {
        const int kv = i / 8192, r = i % 8192, d = r / 128, h = r % 128;
        ((bf16_t*)(ws + WS_WC2))[i] = (bf16_t)f2bf(p.in[24][(size_t)kv * 8192 + h * 64 + d]);
    }
    for (int i = gt; i < 8 * 128 * 128; i += ngt) {
        const int t = (i / 128) % 128, s = i % 128;
        ((bf16_t*)(ws + WS_WDS))[i] = (bf16_t)f2bf(s <= t ? p.in[25][i] : 0.f);
    }
    for (int o = gw; o < 256; o += ngw) {
        const int kv = o / 128, h = o % 128; float acc = 0.f;
        for (int k = lane; k < 2048; k += 64) acc += p.in[22][(size_t)kv * 2048 + k] * p.in[23][((size_t)kv * 2048 + k) * 128 + h];
        acc = wave_sum(acc);
        if (lane == 0) ((float*)(ws + WS_CBIAS))[o] = acc;
    }
}

struct RowNormArgs {
    const float* x_src_p; const float* x_src_s;
    const float* Y;
    const float* g_post; float scale;
    float* x_dst;
    const float* g_pre; bf16_t* h_dst;
    float* out_p; float* out_s;
    const float* w_ext; int ext_ld, ext_c0, n_ext;
    float* ext_dst;
};

DEV void phase_rownorm(const RowNormArgs& a, LAS unsigned char* lds, int gw, int ngw, int lane) {
    LAS float* wl = (LAS float*)lds;
    if (a.n_ext) {
        for (int i = opaque_tid(); i < 1024 * a.n_ext; i += NTHR) { const int k = i / a.n_ext, j = i % a.n_ext; wl[i] = a.w_ext[(size_t)k * a.ext_ld + a.ext_c0 + j]; }
        __syncthreads();
    }
    for (int row = gw; row < NT; row += ngw) {
        const float* xr = row < NP ? a.x_src_p + (size_t)row * D : a.x_src_s + (size_t)(row - NP) * D;
        f32x4 v[4];
#pragma unroll
        for (int j = 0; j < 4; ++j) v[j] = ((const f32x4*)xr)[lane + 64 * j];
        if (a.Y) {
            f32x4 y[4]; float s = 0.f;
#pragma unroll
            for (int j = 0; j < 4; ++j) { y[j] = ((const f32x4*)(a.Y + (size_t)row * D))[lane + 64 * j]; s += (y[j].x * y[j].x + y[j].y * y[j].y) + (y[j].z * y[j].z + y[j].w * y[j].w); }
            const float r = a.scale * rsqrtf(wave_sum(s) * (1.f / D) + 1e-6f);
#pragma unroll
            for (int j = 0; j < 4; ++j) { const f32x4 g = ((const f32x4*)a.g_post)[lane + 64 * j]; v[j] += y[j] * g * r; }
        }
        if (a.x_dst) {
#pragma unroll
            for (int j = 0; j < 4; ++j) ((f32x4*)(a.x_dst + (size_t)row * D))[lane + 64 * j] = v[j];
        }
        if (a.out_p) {
            float* o = row < NP ? a.out_p + (size_t)row * D : a.out_s + (size_t)(row - NP) * D;
#pragma unroll
            for (int j = 0; j < 4; ++j) ((f32x4*)o)[lane + 64 * j] = v[j];
        }
        if (a.h_dst) {
            float s = 0.f;
#pragma unroll
            for (int j = 0; j < 4; ++j) s += (v[j].x * v[j].x + v[j].y * v[j].y) + (v[j].z * v[j].z + v[j].w * v[j].w);
            const float r = rsqrtf(wave_sum(s) * (1.f / D) + 1e-6f);
#pragma unroll
            for (int j = 0; j < 4; ++j) { const f32x4 g = ((const f32x4*)a.g_pre)[lane + 64 * j]; v[j] = v[j] * g * r;
                u32x2 w; w.x = pk2(v[j].x, v[j].y); w.y = pk2(v[j].z, v[j].w);
                ((u32x2*)(a.h_dst + (size_t)row * D))[lane + 64 * j] = w; }
            if (a.n_ext) {
                for (int e = 0; e < a.n_ext; ++e) {
                    float acc = 0.f;
#pragma unroll
                    for (int j = 0; j < 4; ++j) { const int k = (lane + 64 * j) * 4;
                        acc += v[j].x * wl[(k + 0) * a.n_ext + e] + v[j].y * wl[(k + 1) * a.n_ext + e] + v[j].z * wl[(k + 2) * a.n_ext + e] + v[j].w * wl[(k + 3) * a.n_ext + e]; }
                    acc = wave_sum(acc);
                    if (lane == 0) a.ext_dst[(size_t)row * 24 + e] = acc;
                }
            }
        }
    }
}

constexpr int BM = 256, BK = 64, HALF = 128, NXCD = 8, WGM = 8, HT = HALF * BK;
DEV int lds_byte(int r, int c) { const int st = (r >> 4) * 2 + (c >> 5), rr = r & 15, cc = c & 31, ob = rr * 64 + cc * 2; return st * 1024 + (ob ^ (((ob >> 9) & 1) << 5)); }
DEV void stage_rc(int b, int& R, int& C) { const int st = b / 1024, sb = b % 1024, swz = sb ^ (((sb >> 9) & 1) << 5); R = (st >> 1) * 16 + swz / 64; C = (st & 1) * 32 + (swz % 64) / 2; }

struct EpiF32 {
    float* C; int ldc;
    DEV void operator()(const f32x4 (&acc)[2][2][4][2], int brow, int bcol, int wr, int wc, int fr, int fq) const {
#pragma unroll
        for (int ai = 0; ai < 2; ++ai)
#pragma unroll
            for (int bj = 0; bj < 2; ++bj)
#pragma unroll
                for (int m = 0; m < 4; ++m)
#pragma unroll
                    for (int n = 0; n < 2; ++n)
#pragma unroll
                        for (int j = 0; j < 4; ++j)
                            C[(size_t)(brow + ai * HALF + wr * 64 + m * 16 + fq * 4 + j) * ldc + (bcol + bj * HALF + wc * 32 + n * 16 + fr)] = acc[ai][bj][m][n][j];
    }
};
struct EpiBf16 {
    bf16_t* C; int ldc;
    DEV void operator()(const f32x4 (&acc)[2][2][4][2], int brow, int bcol, int wr, int wc, int fr, int fq) const {
#pragma unroll
        for (int ai = 0; ai < 2; ++ai)
#pragma unroll
            for (int bj = 0; bj < 2; ++bj)
#pragma unroll
                for (int m = 0; m < 4; ++m)
#pragma unroll
                    for (int n = 0; n < 2; ++n)
#pragma unroll
                        for (int j = 0; j < 4; ++j)
                            C[(size_t)(brow + ai * HALF + wr * 64 + m * 16 + fq * 4 + j) * ldc + (bcol + bj * HALF + wc * 32 + n * 16 + fr)] = (bf16_t)f2bf(acc[ai][bj][m][n][j]);
    }
};
struct EpiSwiglu {
    bf16_t* C;
    DEV void operator()(const f32x4 (&acc)[2][2][4][2], int brow, int bcol, int wr, int wc, int fr, int fq) const {
        const int c0 = (bcol >> 1) + wc * 32 + fr;
#pragma unroll
        for (int ai = 0; ai < 2; ++ai)
#pragma unroll
            for (int m = 0; m < 4; ++m)
#pragma unroll
                for (int n = 0; n < 2; ++n)
#pragma unroll
                    for (int j = 0; j < 4; ++j) {
                        const float g = acc[ai][0][m][n][j], u = acc[ai][1][m][n][j];
                        C[(size_t)(brow + ai * HALF + wr * 64 + m * 16 + fq * 4 + j) * FF + c0 + n * 16] = (bf16_t)f2bf(siluf_(g) * u);
                    }
    }
};

template <class Epi>
DEV void gemm_phase(LAS unsigned char* lds, const bf16_t* __restrict__ A, const bf16_t* __restrict__ Bt, int M, int N, int K, const Epi& E) {
    const int wid = __builtin_amdgcn_readfirstlane(threadIdx.x >> 6), lane = threadIdx.x & 63, wr = wid >> 2, wc = wid & 3, fr = lane & 15, fq = lane >> 4;
    unsigned voff[2];
#pragma unroll
    for (int i = 0; i < 2; ++i) { int R, C; stage_rc(threadIdx.x * 16 + i * 8192, R, C); voff[i] = (unsigned)(R * K + C) * 2u; }
    const size_t hstep = (size_t)HALF * K * 2;
    const unsigned ldsw = (unsigned)wid * 1024u;
    const int aoff = lds_byte(wr * 64 + fr, fq * 8), boff = lds_byte(wc * 32 + fr, fq * 8);
#define G_SA(b, h) (((b) * 2 + (h)) * (HT * 2))
#define G_SB(b, h) ((4 + (b) * 2 + (h)) * (HT * 2))
#define STAGE(bufoff, gbase) do { _Pragma("unroll") for (int _i = 0; _i < 2; ++_i) \
      __builtin_amdgcn_global_load_lds((const unsigned*)((const char*)(gbase) + voff[_i]), (LAS unsigned*)(lds + (bufoff) + ldsw + _i * 8192), 16, 0, 0); } while (0)
#define LDA(dst, b, h) do { _Pragma("unroll") for (int m = 0; m < 4; ++m) _Pragma("unroll") for (int k = 0; k < 2; ++k) dst[m][k] = *(const LAS bf16x8*)(lds + G_SA(b, h) + aoff + m * 2048 + k * 1024); } while (0)
#define LDB(dst, b, h) do { _Pragma("unroll") for (int n = 0; n < 2; ++n) _Pragma("unroll") for (int k = 0; k < 2; ++k) dst[n][k] = *(const LAS bf16x8*)(lds + G_SB(b, h) + boff + n * 2048 + k * 1024); } while (0)
#define MMA(ai, bj, At, Bq) do { __builtin_amdgcn_s_setprio(1); \
    _Pragma("unroll") for (int m = 0; m < 4; ++m) _Pragma("unroll") for (int n = 0; n < 2; ++n) _Pragma("unroll") for (int k = 0; k < 2; ++k) \
      acc[ai][bj][m][n] = __builtin_amdgcn_mfma_f32_16x16x32_bf16(At[m][k], Bq[n][k], acc[ai][bj][m][n], 0, 0, 0); \
    __builtin_amdgcn_s_setprio(0); } while (0)
#define WAIT_V(n) asm volatile("s_waitcnt vmcnt(" #n ")" ::: "memory")
#define WAIT_L(n) asm volatile("s_waitcnt lgkmcnt(" #n ")" ::: "memory")
#define BAR __builtin_amdgcn_s_barrier()
#define SCHED __builtin_amdgcn_sched_barrier(0)
    const int nM = M / BM, nN = N / BM, nwg = nM * nN;
    const int nt = K / BK;
    for (int L = blockIdx.x; L < nwg; L += gridDim.x) {
        int wgid = L;
        { const int q = nwg / NXCD, r = nwg % NXCD, xcd = wgid % NXCD, off = wgid / NXCD; wgid = (xcd < r ? xcd * (q + 1) : r * (q + 1) + (xcd - r) * q) + off; }
        const int nig = WGM * nN, gid = wgid / nig, fm = gid * WGM, gsz = min(nM - fm, WGM);
        const int pm = fm + ((wgid % nig) % gsz), pn = (wgid % nig) / gsz, brow = pm * BM, bcol = pn * BM;
        const char* cA = (const char*)A + (size_t)brow * K * 2; const char* cB = (const char*)Bt + (size_t)bcol * K * 2;
        f32x4 acc[2][2][4][2];
#pragma unroll
        for (int a = 0; a < 2; ++a)
#pragma unroll
            for (int b = 0; b < 2; ++b)
#pragma unroll
                for (int m = 0; m < 4; ++m)
#pragma unroll
                    for (int n = 0; n < 2; ++n) acc[a][b][m][n] = (f32x4){0.f, 0.f, 0.f, 0.f};
        bf16x8 At[4][2], B0[2][2], B1[2][2];
        STAGE(G_SB(0, 0), cB); STAGE(G_SA(0, 0), cA);
        STAGE(G_SB(0, 1), cB + hstep); STAGE(G_SA(0, 1), cA + hstep);
        if (wr == 1) BAR;
        WAIT_V(4); BAR;
        STAGE(G_SB(1, 0), cB + 128); STAGE(G_SA(1, 0), cA + 128); STAGE(G_SB(1, 1), cB + hstep + 128);
        WAIT_V(6); BAR;
        for (int t = 0; t < nt - 2; t += 2) {
            LDB(B0, 0, 0); SCHED; LDA(At, 0, 0); STAGE(G_SA(1, 1), cA + hstep + 128);
            WAIT_L(8); BAR; WAIT_L(0); MMA(0, 0, At, B0); BAR; SCHED;
            LDB(B1, 0, 1); STAGE(G_SB(0, 0), cB + 256);
            BAR; WAIT_L(0); MMA(0, 1, At, B1); BAR;
            LDA(At, 0, 1); STAGE(G_SA(0, 0), cA + 256);
            BAR; WAIT_L(0); MMA(1, 0, At, B0); BAR; SCHED;
            STAGE(G_SB(0, 1), cB + hstep + 256);
            WAIT_V(6); BAR; MMA(1, 1, At, B1); BAR;
            LDB(B0, 1, 0); SCHED; LDA(At, 1, 0); STAGE(G_SA(0, 1), cA + hstep + 256);
            WAIT_L(8); BAR; WAIT_L(0); MMA(0, 0, At, B0); BAR; SCHED;
            LDB(B1, 1, 1); STAGE(G_SB(1, 0), cB + 384);
            BAR; WAIT_L(0); MMA(0, 1, At, B1); BAR;
            LDA(At, 1, 1); STAGE(G_SA(1, 0), cA + 384);
            BAR; WAIT_L(0); MMA(1, 0, At, B0); BAR; SCHED;
            STAGE(G_SB(1, 1), cB + hstep + 384);
            WAIT_V(6); BAR; MMA(1, 1, At, B1); BAR;
            cA += 256; cB += 256;
        }
        { LDB(B0, 0, 0); LDA(At, 0, 0); STAGE(G_SA(1, 1), cA + hstep + 128);
          BAR; WAIT_L(0); MMA(0, 0, At, B0); BAR;
          LDB(B1, 0, 1); BAR; WAIT_L(0); MMA(0, 1, At, B1); BAR;
          LDA(At, 0, 1); WAIT_V(4); BAR; WAIT_L(0); MMA(1, 0, At, B0); MMA(1, 1, At, B1); BAR; }
        { LDB(B0, 1, 0); LDA(At, 1, 0); WAIT_V(2); BAR; WAIT_L(0); MMA(0, 0, At, B0); BAR;
          LDB(B1, 1, 1); WAIT_V(0); BAR; WAIT_L(0); MMA(0, 1, At, B1); BAR;
          LDA(At, 1, 1); BAR; WAIT_L(0); MMA(1, 0, At, B0); MMA(1, 1, At, B1); BAR; }
        if (wr == 0) BAR;
        E(acc, brow, bcol, wr, wc, fr, fq);
    }
    __syncthreads();
#undef G_SA
#undef G_SB
#undef STAGE
#undef LDA
#undef LDB
#undef MMA
}

DEV void phase_even_a(const Params& p, const bf16_t* P, const float* EXT, float* QKV, float* GB, int tok_lo, int gw, int ngw, int lane) {
    const float* wconv = p.in[15]; const float* a_log = p.in[16]; const float* dt_bias = p.in[17];
    for (int tok = tok_lo + gw; tok < NT; tok += ngw) {
        int t, base; const float* buf = nullptr;
        if (tok < NP) { t = tok % SEQ; base = tok - t; } else { t = (tok - NP) % DSQ; base = tok - t; buf = p.in[3] + (size_t)((tok - NP) / DSQ) * 3 * 1536; }
        for (int seg = 0; seg < 3; ++seg) {
            const int c0 = seg * 512 + lane * 8;
            float y[8];
#pragma unroll
            for (int e = 0; e < 8; ++e) y[e] = 0.f;
            for (int j = 0; j < 4; ++j) {
                const int m = t - 3 + j; float xv[8];
                if (m >= 0) { const u32x4 r = *(const u32x4*)(P + (size_t)(base + m) * EV_N + c0);
                    xv[0] = bflo(r.x); xv[1] = bfhi(r.x); xv[2] = bflo(r.y); xv[3] = bfhi(r.y); xv[4] = bflo(r.z); xv[5] = bfhi(r.z); xv[6] = bflo(r.w); xv[7] = bfhi(r.w); }
                else if (buf) {
#pragma unroll
                    for (int e = 0; e < 8; ++e) xv[e] = buf[(size_t)(3 + m) * 1536 + c0 + e]; }
                else {
#pragma unroll
                    for (int e = 0; e < 8; ++e) xv[e] = 0.f; }
#pragma unroll
                for (int e = 0; e < 8; ++e) y[e] += wconv[j * 1536 + c0 + e] * xv[e];
            }
            float ss = 0.f;
#pragma unroll
            for (int e = 0; e < 8; ++e) { y[e] = siluf_(y[e]); ss += y[e] * y[e]; }
            if (seg < 2) {
                ss += __shfl_xor(ss, 1); ss += __shfl_xor(ss, 2); ss += __shfl_xor(ss, 4); ss += __shfl_xor(ss, 8);
                const float r = rsqrtf(ss + 1e-6f) * (seg == 0 ? 0.08838834764831845f : 1.f);
#pragma unroll
                for (int e = 0; e < 8; ++e) y[e] *= r;
            }
#pragma unroll
            for (int e = 0; e < 8; ++e) QKV[(size_t)tok * 1536 + c0 + e] = y[e];
        }
        if (lane < 4) {
            const float b = EXT[(size_t)tok * 24 + lane], a = EXT[(size_t)tok * 24 + 4 + lane];
            GB[(size_t)tok * 8 + lane] = -__expf(a_log[lane]) * softplusf_(a + dt_bias[lane]);
            GB[(size_t)tok * 8 + 4 + lane] = sigmoidf_(b);
        }
    }
    const int gt = gw * 64 + lane, ngt = ngw * 64;
    for (int i = gt; i < 4 * 3 * 1536; i += ngt) { const int b = i / 4608, r = (i / 1536) % 3, c = i % 1536; p.out[O_CAP + i] = bf2f(P[(size_t)(b * SEQ + 4093 + r) * EV_N + c]); }
    for (int i = gt; i < 128 * 3 * 1536; i += ngt) { const int b = i / 4608, r = (i / 1536) % 3, c = i % 1536; p.out[O_CAS + i] = bf2f(P[(size_t)(NP + b * 8 + 5 + r) * EV_N + c]); }
}

DEV void delta_recurrence(const Params& p, const float* QKV, const float* GB, float* OB, LAS unsigned char* lds, int first_item, int item_stride, int n_items_lo, int n_items_hi) {
    LAS float* kq = (LAS float*)lds;
    LAS float* red_kv = kq + 512;
    LAS float* red_o = red_kv + 512;
    const int tid = opaque_tid(), part = tid >> 7, j = tid & 127;
    for (int item = first_item; item < n_items_hi; item += item_stride) {
        if (item < n_items_lo) continue;
        int T, base, h; const float* S0 = nullptr; float* Sout;
        if (item < 16) { const int b = item >> 2; h = item & 3; T = SEQ; base = b * SEQ; Sout = p.out + O_DP + (size_t)(b * 4 + h) * 16384; }
        else { const int db = (item - 16) >> 2; h = (item - 16) & 3; T = DSQ; base = NP + db * DSQ; S0 = p.in[2] + (size_t)(db * 4 + h) * 16384; Sout = p.out + O_DS + (size_t)(db * 4 + h) * 16384; }
        float S[32];
#pragma unroll
        for (int i = 0; i < 32; ++i) S[i] = S0 ? S0[(size_t)(part * 32 + i) * 128 + j] : 0.f;
        for (int t = 0; t < T; ++t) {
            const size_t tok = (size_t)(base + t);
            if (tid < 384) { const int seg = tid >> 7; const int src = seg == 0 ? 512 : (seg == 1 ? 0 : 1024);
                kq[tid] = QKV[tok * 1536 + src + h * 128 + j]; }
            else if (tid == 384) kq[384] = GB[tok * 8 + h];
            else if (tid == 385) kq[385] = GB[tok * 8 + 4 + h];
            __syncthreads();
            const float decay = __expf(kq[384]), beta = kq[385];
            float pk = 0.f;
#pragma unroll
            for (int i = 0; i < 32; ++i) { S[i] *= decay; pk += S[i] * kq[part * 32 + i]; }
            red_kv[part * 128 + j] = pk;
            __syncthreads();
            const float kvm = (red_kv[j] + red_kv[128 + j]) + (red_kv[256 + j] + red_kv[384 + j]);
            const float dl = beta * (kq[256 + j] - kvm);
            float po = 0.f;
#pragma unroll
            for (int i = 0; i < 32; ++i) { S[i] += kq[part * 32 + i] * dl; po += S[i] * kq[128 + part * 32 + i]; }
            red_o[part * 128 + j] = po;
            __syncthreads();
            if (part == 0) OB[tok * 512 + h * 128 + j] = (red_o[j] + red_o[128 + j]) + (red_o[256 + j] + red_o[384 + j]);
        }
#pragma unroll
        for (int i = 0; i < 32; ++i) Sout[(size_t)(part * 32 + i) * 128 + j] = S[i];
        __syncthreads();
    }
}

DEV bf16x8 lds_frag(LAS unsigned char* base, int row, int stride_b, int kbyte) { return *(const LAS bf16x8*)(base + row * stride_b + kbyte); }
DEV void phase_chunk_prep(const Params& p, const bf16_t* P, const float* EXT, unsigned char* ws, LAS unsigned char* lds) {
    constexpr int QS = 0, KS = 17408, VBT = 34816, KGT = 53248, KTT = 71680, AM = 90112, TM = 106752, GCS = 115968, BETAS = 116224;
    constexpr int RS = 272, TS = 144;
    const int tid = opaque_tid(), lane = tid & 63, wave = __builtin_amdgcn_readfirstlane(tid >> 6), fr = lane & 15, fq = lane >> 4;
    const float* wconv = p.in[15]; const float* a_log = p.in[16]; const float* dt_bias = p.in[17];
    LAS float* gcs = (LAS float*)(lds + GCS); LAS float* betas = (LAS float*)(lds + BETAS); LAS float* Am = (LAS float*)(lds + AM);
    bf16_t* CW = (bf16_t*)(ws + WS_CW); bf16_t* CQ = (bf16_t*)(ws + WS_CQ); bf16_t* CKT = (bf16_t*)(ws + WS_CKT); float* CU = (float*)(ws + WS_CU);
    bf16_t* CI = (bf16_t*)(ws + WS_CI); float* CGL = (float*)(ws + WS_CGL);
    for (int item = blockIdx.x; item < 1024; item += gridDim.x) {
        const int bh = item >> 6, n = item & 63, b = bh >> 2, h = bh & 3;
        const size_t ci = (size_t)item;
        if (wave == 0) {
            const size_t tok = (size_t)b * SEQ + n * 64 + lane;
            const float a = EXT[tok * 24 + 4 + h], bb = EXT[tok * 24 + h];
            float g = -__expf(a_log[h]) * softplusf_(a + dt_bias[h]);
#pragma unroll
            for (int o = 1; o < 64; o <<= 1) { const float t = __shfl_up(g, o); if (lane >= o) g += t; }
            gcs[lane] = g; betas[lane] = sigmoidf_(bb);
            if (lane == 63) CGL[item] = g;
        }
        __syncthreads();
        {
            const int c = tid >> 3, part = tid & 7, t = n * 64 + c;
            const float gc = gcs[c], beta = betas[c], glast = gcs[63];
            const float eg = __expf(gc), et = __expf(glast - gc);
#pragma unroll
            for (int seg = 0; seg < 3; ++seg) {
                const int ch0 = seg * 512 + h * 128 + part * 16;
                float y[16];
#pragma unroll
                for (int e = 0; e < 16; ++e) y[e] = 0.f;
#pragma unroll
                for (int j = 0; j < 4; ++j) {
                    const int m = t - 3 + j;
                    if (m >= 0) {
                        const u32x4 r0 = *(const u32x4*)(P + ((size_t)b * SEQ + m) * EV_N + ch0), r1 = *(const u32x4*)(P + ((size_t)b * SEQ + m) * EV_N + ch0 + 8);
                        const float x[16] = {bflo(r0.x), bfhi(r0.x), bflo(r0.y), bfhi(r0.y), bflo(r0.z), bfhi(r0.z), bflo(r0.w), bfhi(r0.w),
                                             bflo(r1.x), bfhi(r1.x), bflo(r1.y), bfhi(r1.y), bflo(r1.z), bfhi(r1.z), bflo(r1.w), bfhi(r1.w)};
                        const f32x4 w0 = *(const f32x4*)(wconv + j * 1536 + ch0), w1 = *(const f32x4*)(wconv + j * 1536 + ch0 + 4), w2 = *(const f32x4*)(wconv + j * 1536 + ch0 + 8), w3 = *(const f32x4*)(wconv + j * 1536 + ch0 + 12);
                        const float wv[16] = {w0.x, w0.y, w0.z, w0.w, w1.x, w1.y, w1.z, w1.w, w2.x, w2.y, w2.z, w2.w, w3.x, w3.y, w3.z, w3.w};
#pragma unroll
                        for (int e = 0; e < 16; ++e) y[e] += wv[e] * x[e];
                    }
                }
                float ss = 0.f;
#pragma unroll
                for (int e = 0; e < 16; ++e) { y[e] = siluf_(y[e]); ss += y[e] * y[e]; }
                if (seg < 2) {
                    ss += __shfl_xor(ss, 1); ss += __shfl_xor(ss, 2); ss += __shfl_xor(ss, 4);
                    const float r = rsqrtf(ss + 1e-6f) * (seg == 0 ? 0.08838834764831845f : 1.f);
#pragma unroll
                    for (int e = 0; e < 16; ++e) y[e] *= r;
                }
                if (seg == 0) {
                    u32x4 a0, a1, d0, d1;
                    a0.x = pk2(y[0], y[1]); a0.y = pk2(y[2], y[3]); a0.z = pk2(y[4], y[5]); a0.w = pk2(y[6], y[7]);
                    a1.x = pk2(y[8], y[9]); a1.y = pk2(y[10], y[11]); a1.z = pk2(y[12], y[13]); a1.w = pk2(y[14], y[15]);
                    *(LAS u32x4*)(lds + QS + c * RS + part * 32) = a0; *(LAS u32x4*)(lds + QS + c * RS + part * 32 + 16) = a1;
                    d0.x = pk2(y[0] * eg, y[1] * eg); d0.y = pk2(y[2] * eg, y[3] * eg); d0.z = pk2(y[4] * eg, y[5] * eg); d0.w = pk2(y[6] * eg, y[7] * eg);
                    d1.x = pk2(y[8] * eg, y[9] * eg); d1.y = pk2(y[10] * eg, y[11] * eg); d1.z = pk2(y[12] * eg, y[13] * eg); d1.w = pk2(y[14] * eg, y[15] * eg);
                    *(u32x4*)(CQ + (ci * 64 + c) * 128 + part * 16) = d0; *(u32x4*)(CQ + (ci * 64 + c) * 128 + part * 16 + 8) = d1;
                } else if (seg == 1) {
                    u32x4 a0, a1;
                    a0.x = pk2(y[0], y[1]); a0.y = pk2(y[2], y[3]); a0.z = pk2(y[4], y[5]); a0.w = pk2(y[6], y[7]);
                    a1.x = pk2(y[8], y[9]); a1.y = pk2(y[10], y[11]); a1.z = pk2(y[12], y[13]); a1.w = pk2(y[14], y[15]);
                    *(LAS u32x4*)(lds + KS + c * RS + part * 32) = a0; *(LAS u32x4*)(lds + KS + c * RS + part * 32 + 16) = a1;
                    const float bg = beta * eg;
#pragma unroll
                    for (int e = 0; e < 16; ++e) { *(LAS bf16_t*)(lds + KGT + (part * 16 + e) * TS + c * 2) = (bf16_t)f2bf(y[e] * bg);
                                                   *(LAS bf16_t*)(lds + KTT + (part * 16 + e) * TS + c * 2) = (bf16_t)f2bf(y[e] * et); }
                } else {
#pragma unroll
                    for (int e = 0; e < 16; ++e) *(LAS bf16_t*)(lds + VBT + (part * 16 + e) * TS + c * 2) = (bf16_t)f2bf(y[e] * beta);
                }
            }
        }
        __syncthreads();
#pragma unroll
        for (int i = 0; i < 2; ++i) { const int id = tid + i * 512, row = id >> 3, s8 = id & 7;
            *(u32x4*)(CKT + (ci * 128 + row) * 64 + s8 * 8) = *(const LAS u32x4*)(lds + KTT + row * TS + s8 * 16); }
        {
            const int rt = wave >> 1;
#pragma unroll
            for (int ti = 0; ti < 2; ++ti) {
                const int ct = (wave & 1) * 2 + ti;
                f32x4 accK = {0.f, 0.f, 0.f, 0.f}, accQ = {0.f, 0.f, 0.f, 0.f};
#pragma unroll
                for (int k4 = 0; k4 < 4; ++k4) {
                    const bf16x8 aK = lds_frag(lds + KS, rt * 16 + fr, RS, k4 * 64 + fq * 16), aQ = lds_frag(lds + QS, rt * 16 + fr, RS, k4 * 64 + fq * 16), bK = lds_frag(lds + KS, ct * 16 + fr, RS, k4 * 64 + fq * 16);
                    accK = __builtin_amdgcn_mfma_f32_16x16x32_bf16(aK, bK, accK, 0, 0, 0);
                    accQ = __builtin_amdgcn_mfma_f32_16x16x32_bf16(aQ, bK, accQ, 0, 0, 0);
                }
                const int s = ct * 16 + fr; const float gs = gcs[s];
#pragma unroll
                for (int jj = 0; jj < 4; ++jj) { const int c_ = rt * 16 + fq * 4 + jj;
                    const float dm = s <= c_ ? __expf(gcs[c_] - gs) : 0.f;
                    Am[c_ * 65 + s] = s < c_ ? betas[c_] * accK[jj] * dm : 0.f;
                    CI[(ci * 64 + c_) * 64 + s] = (bf16_t)f2bf(accQ[jj] * dm); }
            }
        }
        __syncthreads();
        {
            const int j = tid >> 3, pp = tid & 7;
            float Tr[8];
#pragma unroll
            for (int q = 0; q < 8; ++q) Tr[q] = 0.f;
#pragma unroll
            for (int i = 0; i < 64; ++i) {
                float s = 0.f;
#pragma unroll
                for (int q = 0; q < 8; ++q) if (8 * q < i) s += Am[i * 65 + pp + 8 * q] * Tr[q];
                s += __shfl_xor(s, 1); s += __shfl_xor(s, 2); s += __shfl_xor(s, 4);
                const float ti = (i == j ? 1.f : 0.f) - s;
                if (pp == (i & 7)) Tr[i >> 3] = ti;
            }
#pragma unroll
            for (int q = 0; q < 8; ++q) *(LAS bf16_t*)(lds + TM + (pp + 8 * q) * TS + j * 2) = (bf16_t)f2bf(Tr[q]);
        }
        __syncthreads();
        {
            const int rt = wave >> 1;
#pragma unroll
            for (int ti = 0; ti < 4; ++ti) {
                const int ct = (wave & 1) * 4 + ti;
                f32x4 accU = {0.f, 0.f, 0.f, 0.f}, accW = {0.f, 0.f, 0.f, 0.f};
#pragma unroll
                for (int k2 = 0; k2 < 2; ++k2) {
                    const bf16x8 a = lds_frag(lds + TM, rt * 16 + fr, TS, k2 * 64 + fq * 16), bU = lds_frag(lds + VBT, ct * 16 + fr, TS, k2 * 64 + fq * 16), bW = lds_frag(lds + KGT, ct * 16 + fr, TS, k2 * 64 + fq * 16);
                    accU = __builtin_amdgcn_mfma_f32_16x16x32_bf16(a, bU, accU, 0, 0, 0);
                    accW = __builtin_amdgcn_mfma_f32_16x16x32_bf16(a, bW, accW, 0, 0, 0);
                }
                const int col = ct * 16 + fr;
#pragma unroll
                for (int jj = 0; jj < 4; ++jj) { const int c_ = rt * 16 + fq * 4 + jj;
                    CU[(ci * 64 + c_) * 128 + col] = accU[jj]; CW[(ci * 64 + c_) * 128 + col] = (bf16_t)f2bf(accW[jj]); }
            }
        }
        __syncthreads();
    }
}

struct ScanFrag { bf16x8 wA[4], qA[4], iA[2], kA[2]; float u[4]; float gl; };
DEV void scan_load(ScanFrag& f, const bf16_t* CW, const bf16_t* CQ, const bf16_t* CKT, const float* CU, const bf16_t* CI, const float* CGL, size_t ci, int rt, int ct, int wave, int sl, int fr, int fq) {
#pragma unroll
    for (int k4 = 0; k4 < 4; ++k4) { f.wA[k4] = *(const bf16x8*)(CW + (ci * 64 + rt * 16 + fr) * 128 + k4 * 32 + fq * 8); f.qA[k4] = *(const bf16x8*)(CQ + (ci * 64 + rt * 16 + fr) * 128 + k4 * 32 + fq * 8); }
#pragma unroll
    for (int k2 = 0; k2 < 2; ++k2) { f.iA[k2] = *(const bf16x8*)(CI + (ci * 64 + rt * 16 + fr) * 64 + k2 * 32 + fq * 8); f.kA[k2] = *(const bf16x8*)(CKT + (ci * 128 + wave * 16 + fr) * 64 + k2 * 32 + fq * 8); }
#pragma unroll
    for (int jj = 0; jj < 4; ++jj) f.u[jj] = CU[(ci * 64 + rt * 16 + fq * 4 + jj) * 128 + sl * 32 + ct * 16 + fr];
    f.gl = CGL[ci];
}
DEV void phase_scan(const Params& p, unsigned char* ws, float* OB, LAS unsigned char* lds, int unit) {
    constexpr int ST = 0, VNT = 8704, SRS = 272, VRS = 144;
    const int tid = opaque_tid(), lane = tid & 63, wave = __builtin_amdgcn_readfirstlane(tid >> 6), fr = lane & 15, fq = lane >> 4;
    const int bh = unit >> 2, sl = unit & 3, b = bh >> 2, h = bh & 3, rt = wave >> 1, ct = wave & 1;
    const bf16_t* CW = (const bf16_t*)(ws + WS_CW); const bf16_t* CQ = (const bf16_t*)(ws + WS_CQ); const bf16_t* CKT = (const bf16_t*)(ws + WS_CKT); const float* CU = (const float*)(ws + WS_CU);
    const bf16_t* CI = (const bf16_t*)(ws + WS_CI); const float* CGL = (const float*)(ws + WS_CGL);
    for (int i = tid; i < (8704 + 4608) / 4; i += NTHR) ((LAS unsigned*)lds)[i] = 0u;
    f32x4 accS[2] = {{0.f, 0.f, 0.f, 0.f}, {0.f, 0.f, 0.f, 0.f}};
    ScanFrag cur, nxt;
    scan_load(cur, CW, CQ, CKT, CU, CI, CGL, (size_t)bh * 64, rt, ct, wave, sl, fr, fq);
    __syncthreads();
    for (int n = 0; n < 64; ++n) {
        if (n + 1 < 64) scan_load(nxt, CW, CQ, CKT, CU, CI, CGL, (size_t)bh * 64 + n + 1, rt, ct, wave, sl, fr, fq);
        f32x4 av = {0.f, 0.f, 0.f, 0.f}, ao = {0.f, 0.f, 0.f, 0.f};
#pragma unroll
        for (int k4 = 0; k4 < 4; ++k4) { const bf16x8 bS = lds_frag(lds + ST, ct * 16 + fr, SRS, k4 * 64 + fq * 16);
            av = __builtin_amdgcn_mfma_f32_16x16x32_bf16(cur.wA[k4], bS, av, 0, 0, 0); ao = __builtin_amdgcn_mfma_f32_16x16x32_bf16(cur.qA[k4], bS, ao, 0, 0, 0); }
        { u32x2 w; w.x = pk2(cur.u[0] - av[0], cur.u[1] - av[1]); w.y = pk2(cur.u[2] - av[2], cur.u[3] - av[3]);
          *(LAS u32x2*)(lds + VNT + (ct * 16 + fr) * VRS + (rt * 16 + fq * 4) * 2) = w; }
        __syncthreads();
#pragma unroll
        for (int k2 = 0; k2 < 2; ++k2) { const bf16x8 bV = lds_frag(lds + VNT, ct * 16 + fr, VRS, k2 * 64 + fq * 16); ao = __builtin_amdgcn_mfma_f32_16x16x32_bf16(cur.iA[k2], bV, ao, 0, 0, 0); }
#pragma unroll
        for (int jj = 0; jj < 4; ++jj) OB[((size_t)b * SEQ + n * 64 + rt * 16 + fq * 4 + jj) * 512 + h * 128 + sl * 32 + ct * 16 + fr] = ao[jj];
        const float dec = __expf(cur.gl);
#pragma unroll
        for (int c2 = 0; c2 < 2; ++c2) {
            accS[c2] *= dec;
#pragma unroll
            for (int k2 = 0; k2 < 2; ++k2) { const bf16x8 bV = lds_frag(lds + VNT, c2 * 16 + fr, VRS, k2 * 64 + fq * 16); accS[c2] = __builtin_amdgcn_mfma_f32_16x16x32_bf16(cur.kA[k2], bV, accS[c2], 0, 0, 0); }
            u32x2 w; w.x = pk2(accS[c2][0], accS[c2][1]); w.y = pk2(accS[c2][2], accS[c2][3]);
            *(LAS u32x2*)(lds + ST + (c2 * 16 + fr) * SRS + (wave * 16 + fq * 4) * 2) = w;
        }
        __syncthreads();
        cur = nxt;
    }
    float* Sout = p.out + O_DP + (size_t)bh * 16384;
#pragma unroll
    for (int c2 = 0; c2 < 2; ++c2)
#pragma unroll
        for (int jj = 0; jj < 4; ++jj) Sout[(size_t)(wave * 16 + fq * 4 + jj) * 128 + sl * 32 + c2 * 16 + fr] = accS[c2][jj];
    __syncthreads();
}

DEV void phase_even_c(const Params& p, const bf16_t* P, const float* OB, bf16_t* MIX, int gw, int ngw, int lane) {
    const float* gn = p.in[18]; const float* wb = p.in[19];
    for (int tok = gw; tok < NT; tok += ngw) {
        int t, base; const float* buf = nullptr;
        if (tok < NP) { t = tok % SEQ; base = tok - t; } else { t = (tok - NP) % DSQ; base = tok - t; buf = p.in[4] + (size_t)((tok - NP) / DSQ) * 2 * 512; }
        const int c0 = lane * 8;
        {
            float o[8]; float ss = 0.f;
#pragma unroll
            for (int e = 0; e < 8; ++e) { o[e] = OB[(size_t)tok * 512 + c0 + e]; ss += o[e] * o[e]; }
            ss += __shfl_xor(ss, 1); ss += __shfl_xor(ss, 2); ss += __shfl_xor(ss, 4); ss += __shfl_xor(ss, 8);
            const float r = rsqrtf(ss * (1.f / 128.f) + 1e-6f);
            const u32x4 zr = *(const u32x4*)(P + (size_t)tok * EV_N + 1536 + c0);
            const float z[8] = {bflo(zr.x), bfhi(zr.x), bflo(zr.y), bfhi(zr.y), bflo(zr.z), bfhi(zr.z), bflo(zr.w), bfhi(zr.w)};
            float w[8];
#pragma unroll
            for (int e = 0; e < 8; ++e) w[e] = o[e] * r * gn[(c0 + e) & 127] * siluf_(z[e]);
            u32x4 st; st.x = pk2(w[0], w[1]); st.y = pk2(w[2], w[3]); st.z = pk2(w[4], w[5]); st.w = pk2(w[6], w[7]);
            *(u32x4*)(MIX + (size_t)tok * D + c0) = st;
        }
        {
            float y[8], cxl[8];
#pragma unroll
            for (int e = 0; e < 8; ++e) { y[e] = 0.f; cxl[e] = 0.f; }
            for (int j = 0; j < 3; ++j) {
                const int m = t - 2 + j; float cx[8];
                if (m >= 0) { const u32x4 hr = *(const u32x4*)(P + (size_t)(base + m) * EV_N + 2048 + c0); const u32x4 cr = *(const u32x4*)(P + (size_t)(base + m) * EV_N + 3072 + c0);
                    cx[0] = bflo(hr.x) * bflo(cr.x); cx[1] = bfhi(hr.x) * bfhi(cr.x); cx[2] = bflo(hr.y) * bflo(cr.y); cx[3] = bfhi(hr.y) * bfhi(cr.y);
                    cx[4] = bflo(hr.z) * bflo(cr.z); cx[5] = bfhi(hr.z) * bfhi(cr.z); cx[6] = bflo(hr.w) * bflo(cr.w); cx[7] = bfhi(hr.w) * bfhi(cr.w); }
                else if (buf) {
#pragma unroll
                    for (int e = 0; e < 8; ++e) cx[e] = buf[(size_t)(2 + m) * 512 + c0 + e]; }
                else {
#pragma unroll
                    for (int e = 0; e < 8; ++e) cx[e] = 0.f; }
#pragma unroll
                for (int e = 0; e < 8; ++e) { y[e] += wb[j * 512 + c0 + e] * cx[e]; cxl[e] = cx[e]; }
            }
            const u32x4 br = *(const u32x4*)(P + (size_t)tok * EV_N + 2560 + c0);
            const float gb[8] = {bflo(br.x), bfhi(br.x), bflo(br.y), bfhi(br.y), bflo(br.z), bfhi(br.z), bflo(br.w), bfhi(br.w)};
            u32x4 st; st.x = pk2(gb[0] * y[0], gb[1] * y[1]); st.y = pk2(gb[2] * y[2], gb[3] * y[3]); st.z = pk2(gb[4] * y[4], gb[5] * y[5]); st.w = pk2(gb[6] * y[6], gb[7] * y[7]);
            *(u32x4*)(MIX + (size_t)tok * D + 512 + c0) = st;
            if (tok < NP) { if (t >= SEQ - 2) {
#pragma unroll
                for (int e = 0; e < 8; ++e) p.out[O_CBP + (size_t)((tok / SEQ) * 2 + (t - (SEQ - 2))) * 512 + c0 + e] = cxl[e]; } }
            else if (t >= DSQ - 2) {
#pragma unroll
                for (int e = 0; e < 8; ++e) p.out[O_CBS + (size_t)(((tok - NP) / DSQ) * 2 + (t - (DSQ - 2))) * 512 + c0 + e] = cxl[e]; }
        }
    }
}

DEV void phase_odd_a(const Params& p, const bf16_t* P, const float* EXT, float* GATES, float* UG, float* VLN, int gw, int ngw, int lane) {
    const float* ln_g = p.in[27]; const float* ln_b = p.in[28];
    for (int tok = gw; tok < NT; tok += ngw) {
        if (lane < 24) GATES[(size_t)tok * 24 + lane] = sigmoidf_(EXT[(size_t)tok * 24 + lane]);
        for (int c = lane; c < 768; c += 64) {
            const float v = bf2f(P[(size_t)tok * OD_N + 512 + c]); const int br = c >> 8, idx = c & 255;
            if (tok < NP) {
                if (br == 0) p.out[O_CMP + (size_t)tok * 256 + idx] = v;
                else if (br == 1) p.out[O_SLP + (size_t)tok * 256 + idx] = v;
                else { const int t = tok % SEQ; if (t >= SEQ - 512) p.out[O_WNP + ((size_t)(tok / SEQ) * 512 + (t - (SEQ - 512))) * 256 + idx] = v; }
            } else {
                const int s = tok - NP;
                if (br == 0) p.out[O_CMS + (size_t)s * 256 + idx] = v;
                else if (br == 1) p.out[O_SLS + (size_t)s * 256 + idx] = v;
                else p.out[O_WNS + ((size_t)(s / DSQ) * 512 + 504 + (s % DSQ)) * 256 + idx] = v;
            }
        }
        const int c0 = lane * 8;
        const u32x4 ur = *(const u32x4*)(P + (size_t)tok * OD_N + 1280 + c0); const u32x4 vr = *(const u32x4*)(P + (size_t)tok * OD_N + 1792 + c0);
        const float uu[8] = {bflo(ur.x), bfhi(ur.x), bflo(ur.y), bfhi(ur.y), bflo(ur.z), bfhi(ur.z), bflo(ur.w), bfhi(ur.w)};
        float vv[8] = {bflo(vr.x), bfhi(vr.x), bflo(vr.y), bfhi(vr.y), bflo(vr.z), bfhi(vr.z), bflo(vr.w), bfhi(vr.w)};
        float s = 0.f;
#pragma unroll
        for (int e = 0; e < 8; ++e) { UG[(size_t)tok * 512 + c0 + e] = geluf_(uu[e]); vv[e] = geluf_(vv[e]); s += vv[e]; }
        const float mu = wave_sum(s) * (1.f / 512.f); float q = 0.f;
#pragma unroll
        for (int e = 0; e < 8; ++e) { vv[e] -= mu; q += vv[e] * vv[e]; }
        const float r = rsqrtf(wave_sum(q) * (1.f / 512.f) + 1e-6f);
#pragma unroll
        for (int e = 0; e < 8; ++e) { const float o = vv[e] * r * ln_g[c0 + e] + ln_b[c0 + e]; VLN[(size_t)tok * 512 + c0 + e] = o;
            if (tok >= NP) p.out[O_DV + (size_t)(tok - NP) * 512 + c0 + e] = o; }
    }
    const size_t gt = (size_t)gw * 64 + lane, ngt = (size_t)ngw * 64;
    for (size_t i = gt; i < (size_t)128 * 504 * 256; i += ngt) { const size_t db = i / (504 * 256), r = i % (504 * 256); p.out[O_WNS + db * 512 * 256 + r] = p.in[7][db * 512 * 256 + 8 * 256 + r]; }
}

struct RowRef { const float* f; const bf16_t* h; };
DEV float rr_get(const RowRef& r, int d) { return r.f ? r.f[d] : bf2f(r.h[d]); }
DEV RowRef kv_row(const Params& p, const bf16_t* P, int seqidx, int br, int kv, int g, int pos) {
    RowRef r; r.f = nullptr; r.h = nullptr;
    const int co = 512 + br * 256 + kv * 128 + g * 64;
    if (seqidx < 4) { r.h = P + ((size_t)seqidx * SEQ + pos) * OD_N + co; return r; }
    const int db = seqidx - 4;
    if (pos >= PAST) { r.h = P + ((size_t)NP + db * DSQ + (pos - PAST)) * OD_N + co; return r; }
    if (br == 2) { r.f = p.in[7] + ((((size_t)db * 512 + (pos - (PAST - 512))) * 2 + kv) * 2 + g) * 64; return r; }
    const int page = p.page_table[db * 16 + (pos >> 7)];
    r.f = (br == 0 ? p.in[5] : p.in[6]) + ((((size_t)page * 128 + (pos & 127)) * 2 + kv) * 2 + g) * 64;
    return r;
}
DEV size_t kc_off(int seqidx, int g, int j) { return seqidx < 4 ? ((size_t)(seqidx * 2 + g) * 256 + j) * 64 : ((size_t)4 * 2 * 256 + (size_t)((seqidx - 4) * 2 + g) * 128 + j) * 64; }

DEV void phase_compress_naive(const Params& p, const bf16_t* P, float* KCF, LAS unsigned char* lds, int gw, int ngw, int lane, int wave) {
    LAS float* hid = (LAS float*)lds + wave * 128;
    const float* pe = p.in[22]; const float* w1 = p.in[23]; const float* w2 = p.in[24];
    const int n_p = 4 * 2 * 255 * 2, n_s = 128 * 2 * 127 * 2;
    for (int it = gw; it < n_p + n_s; it += ngw) {
        int seqidx, g, j, kv;
        if (it < n_p) { kv = it & 1; int r = it >> 1; j = r % 255; r /= 255; g = r & 1; seqidx = r >> 1; }
        else { int r = it - n_p; kv = r & 1; r >>= 1; j = r % 127; r /= 127; g = r & 1; seqidx = 4 + (r >> 1); }
        float a0 = 0.f, a1 = 0.f;
        for (int s = 0; s < 32; ++s) {
            const RowRef rr = kv_row(p, P, seqidx, 0, kv, g, 16 * j + s);
            for (int d = 0; d < 64; ++d) {
                const float x = rr_get(rr, d) + pe[(size_t)(kv * 32 + s) * 64 + d];
                const float* wr_ = w1 + ((size_t)(kv * 32 + s) * 64 + d) * 128;
                a0 += x * wr_[lane]; a1 += x * wr_[lane + 64];
            }
        }
        hid[lane] = siluf_(a0); hid[lane + 64] = siluf_(a1);
        asm volatile("s_waitcnt lgkmcnt(0)" ::: "memory");
        float o = 0.f;
        for (int h = 0; h < 128; ++h) o += hid[h] * w2[(size_t)kv * 8192 + h * 64 + lane];
        KCF[(size_t)kv * KC_ELEMS + kc_off(seqidx, g, j) + lane] = o;
        asm volatile("s_waitcnt lgkmcnt(0)" ::: "memory");
    }
}

DEV void phase_attn_naive(const Params& p, const bf16_t* P, const float* KCF, const float* GATES, bf16_t* MIX, LAS unsigned char* lds, int gw, int ngw, int lane, int wave) {
    LAS float* qs = (LAS float*)lds + wave * 1216;
    LAS float* pbuf = qs + 64;
    LAS float* pc = pbuf + 1024;
    LAS int* blk = (LAS int*)pc;
    const float NEG = -1e30f;
    for (int it = gw; it < 4 * 2 * SEQ + 128 * 2 * DSQ; it += ngw) {
        int seqidx, g, ti, qpos, tok, nc, ns, wstart;
        if (it < 4 * 2 * SEQ) { ti = it % SEQ; const int r = it / SEQ; g = r & 1; seqidx = r >> 1; qpos = ti; tok = seqidx * SEQ + ti; nc = 255; ns = 64; wstart = 0; }
        else { const int r0 = it - 4 * 2 * SEQ; ti = r0 % DSQ; const int r = r0 / DSQ; g = r & 1; seqidx = 4 + (r >> 1); qpos = PAST + ti; tok = NP + (seqidx - 4) * DSQ + ti; nc = 127; ns = 33; wstart = PAST - 512; }
        const int cur = qpos >> 6;
        float imp = 0.f; float oc[4];
        for (int r = 0; r < 4; ++r) {
            const int h = g * 4 + r; const float slope = exp2f(-(float)(h + 1));
            qs[lane] = bf2f(P[(size_t)tok * OD_N + h * 64 + lane]) * 0.125f;
            asm volatile("s_waitcnt lgkmcnt(0)" ::: "memory");
            float sc[4]; float mx = NEG;
            for (int jj = 0; jj < 4; ++jj) { const int j = jj * 64 + lane; const bool ok = j < nc && 16 * j + 31 <= qpos; float s = NEG;
                if (ok) { const float* kr = KCF + kc_off(seqidx, g, j); s = 0.f; for (int d = 0; d < 64; ++d) s += qs[d] * kr[d]; s -= slope * (float)(qpos - (16 * j + 31)); }
                sc[jj] = s; mx = fmaxf(mx, s); }
            for (int o = 1; o < 64; o <<= 1) mx = fmaxf(mx, __shfl_xor(mx, o));
            float sum = 0.f;
            for (int jj = 0; jj < 4; ++jj) { sc[jj] = sc[jj] > -1e29f ? __expf(sc[jj] - mx) : 0.f; sum += sc[jj]; }
            sum = fmaxf(wave_sum(sum), 1e-30f);
            for (int jj = 0; jj < 4; ++jj) pbuf[jj * 64 + lane] = sc[jj] / sum;
            asm volatile("s_waitcnt lgkmcnt(0)" ::: "memory");
            float o = 0.f;
            for (int j = 0; j < nc; ++j) o += pbuf[j] * KCF[KC_ELEMS + kc_off(seqidx, g, j) + lane];
            oc[r] = o;
            for (int j = 4 * lane - 1; j <= 4 * lane + 3; ++j) if (j >= 0 && j < nc) {
                const int lo = max(16 * j, 64 * lane), hi = min(16 * j + 32, 64 * lane + 64); if (hi > lo) imp += pbuf[j] * ((float)(hi - lo) * (1.f / 32.f)); }
            asm volatile("s_waitcnt lgkmcnt(0)" ::: "memory");
        }
        const bool valid = lane < ns && lane <= cur; const bool forced = lane == 0 || lane == cur || lane == cur - 1;
        const float score = valid ? (forced ? 1e4f : imp) : NEG;
        int rank = 0;
        for (int s2 = 0; s2 < ns; ++s2) { const float o = __shfl(score, s2); rank += (o > score || (o == score && s2 < lane)) ? 1 : 0; }
        const unsigned long long selmask = __ballot(valid && rank < 16);
        if (lane == 0) { int n = 0; for (int s2 = 0; s2 < 64; ++s2) if ((selmask >> s2) & 1ull) blk[n++] = s2; for (; n < 16; ++n) blk[n] = -1; }
        asm volatile("s_waitcnt lgkmcnt(0)" ::: "memory");
        const int nsel = __popcll(selmask);
        for (int r = 0; r < 4; ++r) {
            const int h = g * 4 + r; const float slope = exp2f(-(float)(h + 1));
            qs[lane] = bf2f(P[(size_t)tok * OD_N + h * 64 + lane]) * 0.125f;
            asm volatile("s_waitcnt lgkmcnt(0)" ::: "memory");
            float res[2];
            for (int brn = 1; brn <= 2; ++brn) {
                const int wlo = max(wstart, qpos - 511);
                const int nkeys = brn == 1 ? nsel * 64 : (qpos - wlo + 1);
                float mx = NEG;
                for (int i0 = 0; i0 < nkeys; i0 += 64) { const int i = i0 + lane; float s = NEG;
                    if (i < nkeys) { const int pos = brn == 1 ? blk[i >> 6] * 64 + (i & 63) : wlo + i;
                        if (pos <= qpos) { const RowRef kr = kv_row(p, P, seqidx, brn, 0, g, pos); s = 0.f; for (int d = 0; d < 64; ++d) s += qs[d] * rr_get(kr, d); s -= slope * (float)(qpos - pos); } }
                    if (i < 1024) pbuf[i] = s; mx = fmaxf(mx, s); }
                for (int o = 1; o < 64; o <<= 1) mx = fmaxf(mx, __shfl_xor(mx, o));
                asm volatile("s_waitcnt lgkmcnt(0)" ::: "memory");
                float sum = 0.f;
                for (int i0 = 0; i0 < nkeys; i0 += 64) { const int i = i0 + lane; if (i < nkeys) { const float s = pbuf[i]; const float e = s > -1e29f ? __expf(s - mx) : 0.f; pbuf[i] = e; sum += e; } }
                sum = fmaxf(wave_sum(sum), 1e-30f);
                asm volatile("s_waitcnt lgkmcnt(0)" ::: "memory");
                float o = 0.f;
                for (int i = 0; i < nkeys; ++i) { const float e = pbuf[i]; if (e != 0.f) { const int pos = brn == 1 ? blk[i >> 6] * 64 + (i & 63) : wlo + i; const RowRef vr = kv_row(p, P, seqidx, brn, 1, g, pos); o += e * rr_get(vr, lane); } }
                res[brn - 1] = o / sum;
                asm volatile("s_waitcnt lgkmcnt(0)" ::: "memory");
            }
            const float* gt = GATES + (size_t)tok * 24 + h * 3;
            MIX[(size_t)tok * D + h * 64 + lane] = (bf16_t)f2bf(gt[0] * oc[r] + gt[1] * res[0] + gt[2] * res[1]);
        }
    }
}

DEV void phase_compress(const Params& p, const bf16_t* P, unsigned char* ws, LAS unsigned char* lds) {
    constexpr int CA0 = 0, CA1 = 17920, PB = 35840, HID = 68608, ARS = 272;
    const int tid = opaque_tid(), lane = tid & 63, wave = __builtin_amdgcn_readfirstlane(tid >> 6), fr = lane & 15, fq = lane >> 4;
    const bf16_t* W1t = (const bf16_t*)(ws + WS_WC1); const bf16_t* W2t = (const bf16_t*)(ws + WS_WC2); const float* cb = (const float*)(ws + WS_CBIAS);
    const int srow = tid >> 3, piece = tid & 7, sl = piece >> 2, d0 = (piece & 3) * 16;
    for (int item = blockIdx.x; item < 64 + 1024; item += gridDim.x) {
        int kv, g, nb, seqidx, nh;
        if (item < 64) { kv = item & 1; g = (item >> 1) & 1; nb = (item >> 2) & 3; seqidx = item >> 4; nh = 256; }
        else { const int i2 = item - 64; kv = i2 & 1; g = (i2 >> 1) & 1; nb = (i2 >> 2) & 1; seqidx = 4 + (i2 >> 3); nh = 128; }
        const int nc = nh - 1;
        auto fetchA = [&](int c8, int row, u32x4& o0, u32x4& o1) {
            const int n = nb * 64 + row;
            if (n >= nh) { o0 = (u32x4){0u, 0u, 0u, 0u}; o1 = o0; return; }
            const int pos = 16 * n + 2 * c8 + sl;
            if (seqidx < 4) { const bf16_t* src_ = P + ((size_t)seqidx * SEQ + pos) * OD_N + 512 + kv * 128 + g * 64 + d0; o0 = *(const u32x4*)src_; o1 = *(const u32x4*)(src_ + 8); }
            else { const int page = p.page_table[(seqidx - 4) * 16 + (pos >> 7)];
                const float* src_ = p.in[5] + ((((size_t)page * 128 + (pos & 127)) * 2 + kv) * 2 + g) * 64 + d0;
                const f32x4 a = *(const f32x4*)src_, b = *(const f32x4*)(src_ + 4), c = *(const f32x4*)(src_ + 8), d = *(const f32x4*)(src_ + 12);
                o0.x = pk2(a.x, a.y); o0.y = pk2(a.z, a.w); o0.z = pk2(b.x, b.y); o0.w = pk2(b.z, b.w); o1.x = pk2(c.x, c.y); o1.y = pk2(c.z, c.w); o1.z = pk2(d.x, d.y); o1.w = pk2(d.z, d.w); }
        };
        f32x4 acc[4][2];
#pragma unroll
        for (int rt = 0; rt < 4; ++rt)
#pragma unroll
            for (int ct = 0; ct < 2; ++ct) acc[rt][ct] = (f32x4){0.f, 0.f, 0.f, 0.f};
        const int colbase = (wave < 4 ? 32 * wave : 128 + 32 * (wave - 4)), shift = wave < 4 ? 0 : 1;
        u32x4 r0, r1, e0, e1;
        fetchA(0, srow, r0, r1);
        if (tid < 8) fetchA(0, 64, e0, e1);
        for (int c8 = 0; c8 < 8; ++c8) {
            LAS unsigned char* buf = lds + ((c8 & 1) ? CA1 : CA0);
            *(LAS u32x4*)(buf + srow * ARS + (sl * 64 + d0) * 2) = r0; *(LAS u32x4*)(buf + srow * ARS + (sl * 64 + d0) * 2 + 16) = r1;
            if (tid < 8) { *(LAS u32x4*)(buf + 64 * ARS + (sl * 64 + d0) * 2) = e0; *(LAS u32x4*)(buf + 64 * ARS + (sl * 64 + d0) * 2 + 16) = e1; }
            __syncthreads();
            if (c8 + 1 < 8) { fetchA(c8 + 1, srow, r0, r1); if (tid < 8) fetchA(c8 + 1, 64, e0, e1); }
#pragma unroll
            for (int k4 = 0; k4 < 4; ++k4) {
                bf16x8 bfr[2];
#pragma unroll
                for (int ct = 0; ct < 2; ++ct) bfr[ct] = *(const bf16x8*)(W1t + ((size_t)kv * 256 + colbase + ct * 16 + fr) * 1024 + c8 * 128 + k4 * 32 + fq * 8);
#pragma unroll
                for (int rt = 0; rt < 4; ++rt) { const bf16x8 a = lds_frag(buf, rt * 16 + fr + shift, ARS, k4 * 64 + fq * 16);
#pragma unroll
                    for (int ct = 0; ct < 2; ++ct) acc[rt][ct] = __builtin_amdgcn_mfma_f32_16x16x32_bf16(a, bfr[ct], acc[rt][ct], 0, 0, 0); }
            }
        }
        __syncthreads();
        LAS float* PBm = (LAS float*)(lds + PB);
        if (wave >= 4) {
#pragma unroll
            for (int rt = 0; rt < 4; ++rt)
#pragma unroll
                for (int ct = 0; ct < 2; ++ct)
#pragma unroll
                    for (int jj = 0; jj < 4; ++jj) PBm[(rt * 16 + fq * 4 + jj) * 128 + 32 * (wave - 4) + ct * 16 + fr] = acc[rt][ct][jj];
        }
        __syncthreads();
        if (wave < 4) {
#pragma unroll
            for (int rt = 0; rt < 4; ++rt)
#pragma unroll
                for (int ct = 0; ct < 2; ++ct) { const int hc = 32 * wave + ct * 16 + fr; const float bia = cb[kv * 128 + hc];
#pragma unroll
                    for (int jj = 0; jj < 4; ++jj) { const int i = rt * 16 + fq * 4 + jj;
                        *(LAS bf16_t*)(lds + HID + i * ARS + hc * 2) = (bf16_t)f2bf(siluf_(acc[rt][ct][jj] + PBm[i * 128 + hc] + bia)); } }
        }
        __syncthreads();
        {
            const int rt = wave >> 1;
            bf16_t* OUT = (bf16_t*)(ws + (kv == 0 ? WS_KC : WS_VC));
#pragma unroll
            for (int ti = 0; ti < 2; ++ti) { const int ct2 = (wave & 1) * 2 + ti; f32x4 a2 = {0.f, 0.f, 0.f, 0.f};
#pragma unroll
                for (int k4 = 0; k4 < 4; ++k4) { const bf16x8 a = lds_frag(lds + HID, rt * 16 + fr, ARS, k4 * 64 + fq * 16);
                    const bf16x8 b = *(const bf16x8*)(W2t + ((size_t)kv * 64 + ct2 * 16 + fr) * 128 + k4 * 32 + fq * 8);
                    a2 = __builtin_amdgcn_mfma_f32_16x16x32_bf16(a, b, a2, 0, 0, 0); }
#pragma unroll
                for (int jj = 0; jj < 4; ++jj) { const int j = nb * 64 + rt * 16 + fq * 4 + jj; if (j < nc) OUT[kc_off(seqidx, g, j) + ct2 * 16 + fr] = (bf16_t)f2bf(a2[jj]); } }
        }
        __syncthreads();
    }
}

struct KVRegs { u32x4 k, v; };
DEV u32x4 load8(const RowRef& r, int seg) {
    if (r.h) return *(const u32x4*)(r.h + seg * 8);
    if (r.f) { const f32x4 a = *(const f32x4*)(r.f + seg * 8), b = *(const f32x4*)(r.f + seg * 8 + 4); u32x4 o; o.x = pk2(a.x, a.y); o.y = pk2(a.z, a.w); o.z = pk2(b.x, b.y); o.w = pk2(b.z, b.w); return o; }
    return (u32x4){0u, 0u, 0u, 0u};
}
constexpr int AT_KT = 0, AT_VT = 9216, AT_PW = 18432, AT_PSUM = 36864, AT_SELM = 69632, AT_PC = 69888, AT_RS = 144;
DEV void tile_store(LAS unsigned char* lds, const KVRegs& r, int key, int seg) {
    *(LAS u32x4*)(lds + AT_KT + key * AT_RS + seg * 16) = r.k;
    const unsigned w[4] = {r.v.x, r.v.y, r.v.z, r.v.w};
#pragma unroll
    for (int e = 0; e < 4; ++e) { *(LAS bf16_t*)(lds + AT_VT + (seg * 8 + 2 * e) * AT_RS + key * 2) = (bf16_t)(w[e] & 0xffffu); *(LAS bf16_t*)(lds + AT_VT + (seg * 8 + 2 * e + 1) * AT_RS + key * 2) = (bf16_t)(w[e] >> 16); }
}
DEV void attn_scores(LAS unsigned char* lds, const bf16x8 (&Qf)[2], f32x4 (&s)[4], int fr, int fq) {
#pragma unroll
    for (int ct = 0; ct < 4; ++ct) { f32x4 acc = {0.f, 0.f, 0.f, 0.f};
#pragma unroll
        for (int k2 = 0; k2 < 2; ++k2) acc = __builtin_amdgcn_mfma_f32_16x16x32_bf16(Qf[k2], lds_frag(lds + AT_KT, ct * 16 + fr, AT_RS, k2 * 64 + fq * 16), acc, 0, 0, 0);
        s[ct] = acc; }
}
DEV void attn_softmax_pv(LAS unsigned char* lds, LAS unsigned char* pw, const f32x4 (&s)[4], f32x4 (&O)[4], float (&m)[4], float (&l)[4], int fr, int fq) {
#pragma unroll
    for (int jj = 0; jj < 4; ++jj) {
        float v = fmaxf(fmaxf(s[0][jj], s[1][jj]), fmaxf(s[2][jj], s[3][jj]));
        v = fmaxf(v, __shfl_xor(v, 1)); v = fmaxf(v, __shfl_xor(v, 2)); v = fmaxf(v, __shfl_xor(v, 4)); v = fmaxf(v, __shfl_xor(v, 8));
        const float mn = fmaxf(m[jj], v), alpha = __expf(m[jj] - mn); m[jj] = mn;
        float ps = 0.f;
#pragma unroll
        for (int ct = 0; ct < 4; ++ct) { const float pv = s[ct][jj] > -1e29f ? __expf(s[ct][jj] - mn) : 0.f; ps += pv;
            *(LAS bf16_t*)(pw + (fq * 4 + jj) * AT_RS + (ct * 16 + fr) * 2) = (bf16_t)f2bf(pv); }
        l[jj] = l[jj] * alpha + ps;
#pragma unroll
        for (int ct = 0; ct < 4; ++ct) O[ct][jj] *= alpha;
    }
    asm volatile("s_waitcnt lgkmcnt(0)" ::: "memory");
    bf16x8 Pf[2];
#pragma unroll
    for (int k2 = 0; k2 < 2; ++k2) Pf[k2] = lds_frag(pw, fr, AT_RS, k2 * 64 + fq * 16);
#pragma unroll
    for (int ct = 0; ct < 4; ++ct)
#pragma unroll
        for (int k2 = 0; k2 < 2; ++k2) O[ct] = __builtin_amdgcn_mfma_f32_16x16x32_bf16(Pf[k2], lds_frag(lds + AT_VT, ct * 16 + fr, AT_RS, k2 * 64 + fq * 16), O[ct], 0, 0, 0);
}
DEV float row_sum16(float v) { v += __shfl_xor(v, 1); v += __shfl_xor(v, 2); v += __shfl_xor(v, 4); v += __shfl_xor(v, 8); return v; }

DEV void phase_attn(const Params& p, const bf16_t* P, const bf16_t* KC, const bf16_t* VC, const float* GATES, bf16_t* MIX, LAS unsigned char* lds) {
    const int tid = opaque_tid(), lane = tid & 63, wave = __builtin_amdgcn_readfirstlane(tid >> 6), fr = lane & 15, fq = lane >> 4;
    const int r = wave & 3, qsub = wave >> 2, key = tid >> 3, seg = tid & 7;
    LAS unsigned char* pw = lds + AT_PW + wave * 2304;
    LAS float* PSUM = (LAS float*)(lds + AT_PSUM);
    LAS unsigned long long* SELM = (LAS unsigned long long*)(lds + AT_SELM);
    const float NEG = -1e30f;
    for (int item = blockIdx.x; item < 1024 + 256; item += gridDim.x) {
        int seqidx, g, t0, nc, ns, wstart; bool prompt;
        if (item < 1024) { prompt = true; const int qt = item & 127; g = (item >> 7) & 1; seqidx = item >> 8; t0 = qt * 32; nc = 255; ns = 64; wstart = 0; }
        else { prompt = false; const int i2 = item - 1024; g = i2 & 1; seqidx = 4 + (i2 >> 1); t0 = PAST; nc = 127; ns = 33; wstart = PAST - 512; }
        const int h = g * 4 + r; const float slope = exp2f(-(float)(h + 1));
        const int qmin = t0, qmax = prompt ? t0 + 31 : t0 + 7;
        int qpos[4]; int tokr[4]; bool act[4];
#pragma unroll
        for (int jj = 0; jj < 4; ++jj) { const int ti = fq * 4 + jj;
            if (prompt) { qpos[jj] = t0 + qsub * 16 + ti; tokr[jj] = seqidx * SEQ + qpos[jj]; act[jj] = true; }
            else { const int tc = min(ti, 7); qpos[jj] = PAST + tc; tokr[jj] = NP + (seqidx - 4) * DSQ + tc; act[jj] = qsub == 0 && ti < 8; } }
        bf16x8 Qf[2];
        { const size_t tq = prompt ? (size_t)seqidx * SEQ + t0 + qsub * 16 + fr : (size_t)NP + (seqidx - 4) * DSQ + min(fr, 7);
#pragma unroll
          for (int k2 = 0; k2 < 2; ++k2) { const u32x4 q = *(const u32x4*)(P + tq * OD_N + h * 64 + k2 * 32 + fq * 8);
              u32x4 o; o.x = pk2(bflo(q.x) * 0.125f, bfhi(q.x) * 0.125f); o.y = pk2(bflo(q.y) * 0.125f, bfhi(q.y) * 0.125f); o.z = pk2(bflo(q.z) * 0.125f, bfhi(q.z) * 0.125f); o.w = pk2(bflo(q.w) * 0.125f, bfhi(q.w) * 0.125f);
              Qf[k2] = __builtin_bit_cast(bf16x8, o); } }
        for (int i = tid; i < 8192; i += NTHR) PSUM[i] = 0.f;
        f32x4 outv[4];
#pragma unroll
        for (int ct = 0; ct < 4; ++ct) outv[ct] = (f32x4){0.f, 0.f, 0.f, 0.f};
        f32x4 O[4]; float m[4], l[4];
        KVRegs R;
        const int ntc = prompt ? min(4, ((qmax - 31) >> 4) / 64 + 1) : 2;
#pragma unroll
        for (int ct = 0; ct < 4; ++ct) O[ct] = (f32x4){0.f, 0.f, 0.f, 0.f};
#pragma unroll
        for (int jj = 0; jj < 4; ++jj) { m[jj] = NEG; l[jj] = 0.f; }
        { const int j = key; RowRef kr, vr; kr.f = nullptr; vr.f = nullptr; kr.h = j < nc ? KC + kc_off(seqidx, g, j) : nullptr; vr.h = j < nc ? VC + kc_off(seqidx, g, j) : nullptr;
          R.k = load8(kr, seg); R.v = load8(vr, seg); }
        for (int tile = 0; tile < ntc; ++tile) {
            tile_store(lds, R, key, seg);
            __syncthreads();
            { const int j = (tile + 1 < ntc ? tile + 1 : 0) * 64 + key; RowRef kr, vr; kr.f = nullptr; vr.f = nullptr; kr.h = j < nc ? KC + kc_off(seqidx, g, j) : nullptr; vr.h = j < nc ? VC + kc_off(seqidx, g, j) : nullptr;
              R.k = load8(kr, seg); if (tile + 1 < ntc) R.v = load8(vr, seg); }
            f32x4 s[4];
            attn_scores(lds, Qf, s, fr, fq);
#pragma unroll
            for (int ct = 0; ct < 4; ++ct) { const int j = tile * 64 + ct * 16 + fr, en = 16 * j + 31;
#pragma unroll
                for (int jj = 0; jj < 4; ++jj) s[ct][jj] = (j < nc && en <= qpos[jj]) ? s[ct][jj] - slope * (float)(qpos[jj] - en) : NEG; }
            attn_softmax_pv(lds, pw, s, O, m, l, fr, fq);
            __syncthreads();
        }
        {
            float inv[4];
#pragma unroll
            for (int jj = 0; jj < 4; ++jj) { inv[jj] = 1.f / fmaxf(row_sum16(l[jj]), 1e-30f); const float gt = GATES[(size_t)tokr[jj] * 24 + h * 3 + 0] * inv[jj];
#pragma unroll
                for (int ct = 0; ct < 4; ++ct) outv[ct][jj] += gt * O[ct][jj]; }
            LAS float* PC = (LAS float*)(lds + AT_PC);
            for (int tile = 0; tile < ntc; ++tile) {
                *(LAS u32x4*)(lds + AT_KT + key * AT_RS + seg * 16) = R.k;
                __syncthreads();
                if (tile + 1 < ntc) { const int j = (tile + 1) * 64 + key; RowRef kr; kr.f = nullptr; kr.h = j < nc ? KC + kc_off(seqidx, g, j) : nullptr; R.k = load8(kr, seg); }
                f32x4 s[4];
                attn_scores(lds, Qf, s, fr, fq);
#pragma unroll
                for (int ct = 0; ct < 4; ++ct) { const int j = tile * 64 + ct * 16 + fr, en = 16 * j + 31;
#pragma unroll
                    for (int jj = 0; jj < 4; ++jj) { const bool ok = j < nc && en <= qpos[jj];
                        PC[(wave * 16 + fq * 4 + jj) * 64 + ct * 16 + fr] = ok ? __expf(s[ct][jj] - slope * (float)(qpos[jj] - en) - m[jj]) * inv[jj] : 0.f; } }
                __syncthreads();
                { const int q2 = tid >> 8, t2 = (tid >> 4) & 15, k0 = (tid & 15) * 4;
                  f32x4 a = *(const LAS f32x4*)(PC + ((q2 * 4 + 0) * 16 + t2) * 64 + k0);
                  a += *(const LAS f32x4*)(PC + ((q2 * 4 + 1) * 16 + t2) * 64 + k0); a += *(const LAS f32x4*)(PC + ((q2 * 4 + 2) * 16 + t2) * 64 + k0); a += *(const LAS f32x4*)(PC + ((q2 * 4 + 3) * 16 + t2) * 64 + k0);
                  *(LAS f32x4*)(PSUM + (q2 * 16 + t2) * 256 + tile * 64 + k0) = a; }
            }
            __syncthreads();
        }
        for (int i = 0; i < 4; ++i) {
            const int ql = wave * 4 + i, qs_ = ql >> 4, t_ = ql & 15; const bool qact = prompt || ql < 8;
            const int qp = prompt ? t0 + ql : PAST + min(ql, 7); const int cur = qp >> 6;
            float imp = 0.f;
#pragma unroll
            for (int dj = -1; dj <= 3; ++dj) { const int j = 4 * lane + dj; if (j >= 0 && j < nc) { const int lo = max(16 * j, 64 * lane), hi = min(16 * j + 32, 64 * lane + 64); imp += PSUM[(qs_ * 16 + t_) * 256 + j] * ((float)(hi - lo) * (1.f / 32.f)); } }
            const bool valid = lane < ns && lane <= cur; const bool forced = lane == 0 || lane == cur || lane == cur - 1;
            const float score = valid ? (forced ? 1e4f : imp) : NEG;
            int rank = 0;
            for (int s2 = 0; s2 < ns; ++s2) { const float o = __shfl(score, s2); rank += (o > score || (o == score && s2 < lane)) ? 1 : 0; }
            const unsigned long long msk = __ballot(valid && rank < 16);
            if (lane == 0) SELM[ql] = qact ? msk : 0ull;
        }
        __syncthreads();
        unsigned long long selrow[4], umask;
        { unsigned long long u = lane < 32 ? SELM[lane] : 0ull;
#pragma unroll
          for (int o = 1; o < 64; o <<= 1) u |= __shfl_xor(u, o);
          umask = u;
#pragma unroll
          for (int jj = 0; jj < 4; ++jj) selrow[jj] = SELM[qsub * 16 + fq * 4 + jj]; }
#pragma unroll
        for (int brn = 1; brn <= 2; ++brn) {
#pragma unroll
            for (int ct = 0; ct < 4; ++ct) O[ct] = (f32x4){0.f, 0.f, 0.f, 0.f};
#pragma unroll
            for (int jj = 0; jj < 4; ++jj) { m[jj] = NEG; l[jj] = 0.f; }
            unsigned long long rem;
            if (brn == 1) rem = umask;
            else { const int lo = max(wstart, qmin - 511) >> 6, hi = qmax >> 6; rem = (hi >= 63 ? ~0ull : ((1ull << (hi + 1)) - 1ull)) & ~((1ull << lo) - 1ull); }
            rem = __builtin_amdgcn_readfirstlane((unsigned)rem) | ((unsigned long long)__builtin_amdgcn_readfirstlane((unsigned)(rem >> 32)) << 32);
            if (rem) { const int kb = __builtin_ctzll(rem); const int pos = kb * 64 + key; const RowRef kr = kv_row(p, P, seqidx, brn, 0, g, pos), vr = kv_row(p, P, seqidx, brn, 1, g, pos);
                const bool inr = prompt || pos < PAST + DSQ; R.k = inr ? load8(kr, seg) : (u32x4){0u, 0u, 0u, 0u}; R.v = inr ? load8(vr, seg) : (u32x4){0u, 0u, 0u, 0u}; }
            while (rem) {
                const int kb = __builtin_ctzll(rem); rem &= rem - 1ull;
                tile_store(lds, R, key, seg);
                __syncthreads();
                if (rem) { const int kb2 = __builtin_ctzll(rem); const int pos = kb2 * 64 + key; const RowRef kr = kv_row(p, P, seqidx, brn, 0, g, pos), vr = kv_row(p, P, seqidx, brn, 1, g, pos);
                    const bool inr = prompt || pos < PAST + DSQ; R.k = inr ? load8(kr, seg) : (u32x4){0u, 0u, 0u, 0u}; R.v = inr ? load8(vr, seg) : (u32x4){0u, 0u, 0u, 0u}; }
                f32x4 s[4];
                attn_scores(lds, Qf, s, fr, fq);
#pragma unroll
                for (int ct = 0; ct < 4; ++ct) { const int pos = kb * 64 + ct * 16 + fr;
#pragma unroll
                    for (int jj = 0; jj < 4; ++jj) { const int dist = qpos[jj] - pos;
                        const bool ok = brn == 1 ? (((selrow[jj] >> kb) & 1ull) != 0ull && dist >= 0) : (dist >= 0 && dist < 512 && pos >= wstart);
                        s[ct][jj] = ok ? s[ct][jj] - slope * (float)dist : NEG; } }
                attn_softmax_pv(lds, pw, s, O, m, l, fr, fq);
                __syncthreads();
            }
#pragma unroll
            for (int jj = 0; jj < 4; ++jj) { const float gt = GATES[(size_t)tokr[jj] * 24 + h * 3 + brn] / fmaxf(row_sum16(l[jj]), 1e-30f);
#pragma unroll
                for (int ct = 0; ct < 4; ++ct) outv[ct][jj] += gt * O[ct][jj]; }
        }
#pragma unroll
        for (int jj = 0; jj < 4; ++jj) if (act[jj])
#pragma unroll
            for (int ct = 0; ct < 4; ++ct) MIX[(size_t)tokr[jj] * D + h * 64 + ct * 16 + fr] = (bf16_t)f2bf(outv[ct][jj]);
        __syncthreads();
    }
}

DEV void phase_chunkmlp(const Params& p, unsigned char* ws, const float* UG, const float* VLN, bf16_t* MIX, LAS unsigned char* lds) {
    constexpr int VRS = 272;
    const int tid = opaque_tid(), lane = tid & 63, wave = __builtin_amdgcn_readfirstlane(tid >> 6), fr = lane & 15, fq = lane >> 4;
    const bf16_t* WDS = (const bf16_t*)(ws + WS_WDS); const float* bsd = p.in[26];
    for (int item = blockIdx.x; item < 1024; item += gridDim.x) {
        const int g = item & 7, n = (item >> 3) & 31, b = item >> 8;
        const size_t tok0 = (size_t)b * SEQ + n * 128;
        { const int s = tid >> 2, part = tid & 3;
          const float* src_ = VLN + (tok0 + s) * 512 + g * 64 + part * 16;
          const f32x4 a = *(const f32x4*)src_, bq = *(const f32x4*)(src_ + 4), c = *(const f32x4*)(src_ + 8), d = *(const f32x4*)(src_ + 12);
          const float v[16] = {a.x, a.y, a.z, a.w, bq.x, bq.y, bq.z, bq.w, c.x, c.y, c.z, c.w, d.x, d.y, d.z, d.w};
#pragma unroll
          for (int e = 0; e < 16; ++e) *(LAS bf16_t*)(lds + (part * 16 + e) * VRS + s * 2) = (bf16_t)f2bf(v[e]); }
        __syncthreads();
        f32x4 acc[4];
#pragma unroll
        for (int ct = 0; ct < 4; ++ct) acc[ct] = (f32x4){0.f, 0.f, 0.f, 0.f};
        const int nks = (16 * wave + 15) / 32 + 1;
#pragma unroll
        for (int k4 = 0; k4 < 4; ++k4) if (k4 < nks) {
            const bf16x8 a = *(const bf16x8*)(WDS + ((size_t)g * 128 + 16 * wave + fr) * 128 + k4 * 32 + fq * 8);
#pragma unroll
            for (int ct = 0; ct < 4; ++ct) acc[ct] = __builtin_amdgcn_mfma_f32_16x16x32_bf16(a, lds_frag(lds, ct * 16 + fr, VRS, k4 * 64 + fq * 16), acc[ct], 0, 0, 0);
        }
#pragma unroll
        for (int jj = 0; jj < 4; ++jj) { const int t = 16 * wave + fq * 4 + jj; const float bb = bsd[g * 128 + t];
#pragma unroll
            for (int ct = 0; ct < 4; ++ct) { const int ch = g * 64 + ct * 16 + fr;
                MIX[(tok0 + t) * D + 512 + ch] = (bf16_t)f2bf(UG[(tok0 + t) * 512 + ch] * (acc[ct][jj] + bb)); } }
        __syncthreads();
    }
}

DEV void phase_chunkmlp_naive(const Params& p, const float* UG, const float* VLN, bf16_t* MIX, int tok_lo, int gw, int ngw, int lane) {
    const float* wsd = p.in[25]; const float* bsd = p.in[26];
    const size_t gt = (size_t)gw * 64 + lane, ngt = (size_t)ngw * 64;
    for (size_t i = (size_t)tok_lo * 512 + gt; i < (size_t)NT * 512; i += ngt) {
        const int tok = (int)(i >> 9), ch = (int)(i & 511), g = ch >> 6;
        const int tc = tok < NP ? (tok % SEQ) & 127 : (tok - NP) % DSQ;
        float m = bsd[g * 128 + tc];
        const float* wr_ = wsd + ((size_t)g * 128 + tc) * 128;
        for (int s = 0; s <= tc; ++s) m += wr_[s] * VLN[(size_t)(tok - tc + s) * 512 + ch];
        MIX[(size_t)tok * D + 512 + ch] = (bf16_t)f2bf(UG[i] * m);
    }
}

__global__ void __launch_bounds__(NTHR, 2) fwd_kernel(Params p) {
    extern __shared__ __attribute__((aligned(16))) unsigned char lds_raw[];
    LAS unsigned char* lds = (LAS unsigned char*)lds_raw;
    cg::grid_group grid = cg::this_grid();
    const int G = gridDim.x;
#define PH_IDS const int tid_ = opaque_tid(), lane = tid_ & 63, wave = __builtin_amdgcn_readfirstlane(tid_ >> 6), gw = blockIdx.x * 8 + wave, ngw = G * 8; (void)lane; (void)gw; (void)ngw
    unsigned char* ws = p.ws;
    float* X = (float*)(ws + WS_X); bf16_t* H = (bf16_t*)(ws + WS_H); bf16_t* ACT = (bf16_t*)(ws + WS_ACT); float* Y = (float*)(ws + WS_Y);
    bf16_t* P = (bf16_t*)(ws + WS_P); float* EXT = (float*)(ws + WS_EXT); bf16_t* MIX = (bf16_t*)(ws + WS_MIX); float* OB = (float*)(ws + WS_OB);
    float* QKV = (float*)(ws + WS_QKV); float* GB = (float*)(ws + WS_GB); float* GATES = (float*)(ws + WS_GATES); float* UG = (float*)(ws + WS_UG); float* VLN = (float*)(ws + WS_VLN);
    float* KCF = (float*)(ws + WS_KCF);
    const float* norm_g = p.in[9];
#define GSYNC() grid.sync()
#define FFN(mat) do { gemm_phase(lds, H, (const bf16_t*)(ws + WS_WGU) + (size_t)(mat) * 5632 * 1024, NT, 5632, 1024, EpiSwiglu{ACT}); GSYNC(); \
                      gemm_phase(lds, ACT, (const bf16_t*)(ws + WS_WD) + (size_t)(mat) * 1024 * FF, NT, 1024, FF, EpiF32{Y, D}); GSYNC(); } while (0)

#if DEBUG_FILL
    { PH_IDS; for (size_t i = (size_t)gw * 64 + lane; i < O_END; i += (size_t)ngw * 64) p.out[i] = 0.f; }
#endif
    { PH_IDS; phase_prep(p, lds, gw, ngw, lane, wave); }
    { PH_IDS; RowNormArgs a{}; a.x_src_p = p.in[0]; a.x_src_s = p.in[1]; a.g_pre = norm_g + 0 * D; a.h_dst = H; phase_rownorm(a, lds, gw, ngw, lane); }
    GSYNC();
    FFN(0);
    { PH_IDS; RowNormArgs a{}; a.x_src_p = p.in[0]; a.x_src_s = p.in[1]; a.Y = Y; a.g_post = norm_g + 1 * D; a.scale = 0.5f; a.x_dst = X; a.g_pre = norm_g + 2 * D; a.h_dst = H;
      a.w_ext = p.in[13]; a.ext_ld = EV_SRC; a.ext_c0 = 2048; a.n_ext = 8; a.ext_dst = EXT; phase_rownorm(a, lds, gw, ngw, lane); }
    GSYNC();
    gemm_phase(lds, H, (const bf16_t*)(ws + WS_WEIN), NT, EV_N, 1024, EpiBf16{P, EV_N});
    GSYNC();
    { PH_IDS; phase_even_a(p, P, EXT, QKV, GB, NP, gw, ngw, lane); }
    phase_chunk_prep(p, P, EXT, ws, lds);
    GSYNC();
    if (blockIdx.x < 64) phase_scan(p, ws, OB, lds, blockIdx.x);
    else delta_recurrence(p, QKV, GB, OB, lds, 16 + (int)blockIdx.x - 64, G - 64, 16, 16 + 512);
    GSYNC();
    { PH_IDS; phase_even_c(p, P, OB, MIX, gw, ngw, lane); }
    GSYNC();
    gemm_phase(lds, MIX, (const bf16_t*)(ws + WS_WEOUT), NT, 1024, 1024, EpiF32{Y, D});
    GSYNC();
    { PH_IDS; RowNormArgs a{}; a.x_src_p = X; a.x_src_s = X + (size_t)NP * D; a.Y = Y; a.g_post = norm_g + 3 * D; a.scale = 1.f; a.x_dst = X; a.g_pre = norm_g + 4 * D; a.h_dst = H; phase_rownorm(a, lds, gw, ngw, lane); }
    GSYNC();
    FFN(1);
    { PH_IDS; RowNormArgs a{}; a.x_src_p = X; a.x_src_s = X + (size_t)NP * D; a.Y = Y; a.g_post = norm_g + 5 * D; a.scale = 0.5f; a.x_dst = X; a.g_pre = norm_g + 6 * D; a.h_dst = H; phase_rownorm(a, lds, gw, ngw, lane); }
    GSYNC();
    FFN(2);
    { PH_IDS; RowNormArgs a{}; a.x_src_p = X; a.x_src_s = X + (size_t)NP * D; a.Y = Y; a.g_post = norm_g + 7 * D; a.scale = 0.5f; a.x_dst = X; a.g_pre = norm_g + 8 * D; a.h_dst = H;
      a.w_ext = p.in[20]; a.ext_ld = OD_SRC; a.ext_c0 = 512; a.n_ext = 24; a.ext_dst = EXT; phase_rownorm(a, lds, gw, ngw, lane); }
    GSYNC();
    gemm_phase(lds, H, (const bf16_t*)(ws + WS_WOIN), NT, OD_N, 1024, EpiBf16{P, OD_N});
    GSYNC();
    { PH_IDS; phase_odd_a(p, P, EXT, GATES, UG, VLN, gw, ngw, lane); }
    phase_compress(p, P, ws, lds);
    GSYNC();
    phase_attn(p, P, (const bf16_t*)(ws + WS_KC), (const bf16_t*)(ws + WS_VC), GATES, MIX, lds);
    phase_chunkmlp(p, ws, UG, VLN, MIX, lds);
    { PH_IDS; phase_chunkmlp_naive(p, UG, VLN, MIX, NP, gw, ngw, lane); }
    GSYNC();
    gemm_phase(lds, MIX, (const bf16_t*)(ws + WS_WOOUT), NT, 1024, 1024, EpiF32{Y, D});
    GSYNC();
    { PH_IDS; RowNormArgs a{}; a.x_src_p = X; a.x_src_s = X + (size_t)NP * D; a.Y = Y; a.g_post = norm_g + 9 * D; a.scale = 1.f; a.x_dst = X; a.g_pre = norm_g + 10 * D; a.h_dst = H; phase_rownorm(a, lds, gw, ngw, lane); }
    GSYNC();
    FFN(3);
    { PH_IDS; RowNormArgs a{}; a.x_src_p = X; a.x_src_s = X + (size_t)NP * D; a.Y = Y; a.g_post = norm_g + 11 * D; a.scale = 0.5f; a.out_p = p.out + O_YP; a.out_s = p.out + O_YS; phase_rownorm(a, lds, gw, ngw, lane); }
}

extern "C" void kernel_launch(void* const* d_in, const int* in_sizes, int n_in, void* d_out, int out_size, void* d_ws, size_t ws_size, hipStream_t stream) {
    constexpr int LDS_BYTES = 147456;
    static int grid = 0;
    if (grid == 0) {
        int dev = 0, cus = 0, per_cu = 0;
        hipGetDevice(&dev);
        hipDeviceGetAttribute(&cus, hipDeviceAttributeMultiprocessorCount, dev);
        hipFuncSetAttribute((const void*)fwd_kernel, hipFuncAttributeMaxDynamicSharedMemorySize, LDS_BYTES);
        hipOccupancyMaxActiveBlocksPerMultiprocessor(&per_cu, (const void*)fwd_kernel, NTHR, LDS_BYTES);
        if (per_cu < 1) { fprintf(stderr, "occupancy query says %d blocks/CU\n", per_cu); per_cu = 1; }
        grid = cus;
        if (ws_size < WS_END) { fprintf(stderr, "workspace too small: %zu < %zu\n", ws_size, (size_t)WS_END); grid = -1; }
        if (n_in != 29) { fprintf(stderr, "expected 29 inputs, got %d\n", n_in); grid = -1; }
    }
    if (grid < 0) return;
    Params p{};
    for (int i = 0; i < 29; ++i) p.in[i] = (const float*)d_in[i];
    p.page_table = (const int*)d_in[8];
    p.out = (float*)d_out; p.ws = (unsigned char*)d_ws;
    void* args[] = {&p};
    hipError_t e = hipLaunchCooperativeKernel((const void*)fwd_kernel, dim3(grid), dim3(NTHR), args, LDS_BYTES, stream);
    if (e != hipSuccess) fprintf(stderr, "cooperative launch failed: %s (grid %d)\n", hipGetErrorString(e), grid);
}
```

```cpp
#include <hip/hip_runtime.h>
#include <hip/hip_cooperative_groups.h>
#include <cstdio>
#include <cstdint>
namespace cg = cooperative_groups;
#define DEBUG_FILL 0
#ifndef PROFILE
#define PROFILE 0
#endif
#ifndef GEMM_SP2
#define GEMM_SP2 1
#endif
#define PV_A 0
#define PV_B 3
#ifndef ATT_ABL
#define ATT_ABL 0
#endif

typedef unsigned short bf16_t;
typedef short bf16x8 __attribute__((ext_vector_type(8)));
typedef float f32x4 __attribute__((ext_vector_type(4)));
typedef unsigned u32x4 __attribute__((ext_vector_type(4)));
typedef unsigned u32x2 __attribute__((ext_vector_type(2)));
#define DEV __device__ __forceinline__
#define LAS __attribute__((address_space(3)))

constexpr int D = 1024, NP = 16384, NS = 1024, NT = NP + NS, SEQ = 4096, NB = 4, DB = 128, DSQ = 8, PAST = 2048;
constexpr int FF = 2816;
constexpr int EV_N = 3584, EV_SRC = 3592, OD_N = 2304, OD_SRC = 2328;
constexpr int NTHR = 512;

constexpr size_t O_YP = 0, O_YS = O_YP + (size_t)NP * D, O_DP = O_YS + (size_t)NS * D, O_DS = O_DP + 4 * 4 * 128 * 128,
                 O_CAP = O_DS + (size_t)128 * 4 * 128 * 128, O_CAS = O_CAP + 4 * 3 * 1536, O_CBP = O_CAS + 128 * 3 * 1536,
                 O_CBS = O_CBP + 4 * 2 * 512, O_CMP = O_CBS + 128 * 2 * 512, O_CMS = O_CMP + (size_t)NP * 256,
                 O_SLP = O_CMS + (size_t)NS * 256, O_SLS = O_SLP + (size_t)NP * 256, O_WNP = O_SLS + (size_t)NS * 256,
                 O_WNS = O_WNP + 4 * 512 * 256, O_DV = O_WNS + (size_t)128 * 512 * 256, O_END = O_DV + (size_t)NS * 512;

constexpr size_t al256(size_t x) { return (x + 255) & ~(size_t)255; }
constexpr size_t WS_WGU = 0;
constexpr size_t WS_WD = WS_WGU + (size_t)4 * 5632 * 1024 * 2;
constexpr size_t WS_WEIN = WS_WD + (size_t)4 * 1024 * 2816 * 2;
constexpr size_t WS_WEOUT = WS_WEIN + (size_t)(EV_N + 256) * 1024 * 2;
constexpr size_t WS_WOIN = WS_WEOUT + (size_t)1024 * 1024 * 2;
constexpr size_t WS_WOOUT = WS_WOIN + (size_t)(OD_N + 256) * 1024 * 2;
constexpr size_t WS_WC1 = WS_WOOUT + (size_t)1024 * 1024 * 2;
constexpr size_t WS_WC2 = WS_WC1 + (size_t)2 * 256 * 1024 * 2;
constexpr size_t WS_WDS = WS_WC2 + (size_t)2 * 64 * 128 * 2;
constexpr size_t WS_CBIAS = WS_WDS + (size_t)8 * 128 * 128 * 2;
constexpr size_t WS_X = al256(WS_CBIAS + 2 * 128 * 4);
constexpr size_t WS_H = WS_X + (size_t)NT * D * 4;
constexpr size_t WS_ACT = WS_H + (size_t)NT * D * 2;
constexpr size_t WS_Y = WS_ACT + (size_t)NT * FF * 2;
constexpr size_t WS_P = WS_Y + (size_t)NT * D * 4;
constexpr size_t WS_EXT = WS_P + (size_t)NT * EV_N * 2;
constexpr size_t WS_MIX = al256(WS_EXT + (size_t)NT * 24 * 4);
constexpr size_t WS_OB = WS_MIX + (size_t)NT * D * 2;
constexpr size_t WS_CW = WS_OB + (size_t)NT * 512 * 4;
constexpr size_t WS_CQ = WS_CW + (size_t)1024 * 64 * 128 * 2;
constexpr size_t WS_CKT = WS_CQ + (size_t)1024 * 64 * 128 * 2;
constexpr size_t WS_CU = WS_CKT + (size_t)1024 * 64 * 128 * 2;
constexpr size_t WS_CI = WS_CU + (size_t)1024 * 64 * 128 * 4;
constexpr size_t WS_CGL = WS_CI + (size_t)1024 * 64 * 64 * 2;
constexpr size_t WS_KC = al256(WS_CGL + 1024 * 4);
constexpr size_t KC_ELEMS = (size_t)(4 * 2 * 256 + 128 * 2 * 128) * 64;
constexpr size_t WS_VC = WS_KC + KC_ELEMS * 2;
constexpr size_t WS_QKV = al256(WS_VC + KC_ELEMS * 2);
constexpr size_t WS_GB = WS_QKV + (size_t)NT * 1536 * 4;
constexpr size_t WS_GATES = WS_GB + (size_t)NT * 8 * 4;
constexpr size_t WS_UG = al256(WS_GATES + (size_t)NT * 24 * 4);
constexpr size_t WS_VLN = WS_UG + (size_t)NT * 512 * 4;
constexpr size_t WS_KCF = WS_VLN + (size_t)NT * 512 * 4;
constexpr size_t WS_VTP = al256(WS_KCF + KC_ELEMS * 2 * 4);
constexpr size_t WS_YT = WS_VTP + (size_t)2 * 4 * 2 * 64 * 4096 * 2;
constexpr size_t WS_RSTD = WS_YT + (size_t)11 * NS * D * 4;
constexpr size_t WS_BAR = al256(WS_RSTD + (size_t)NT * 4);
constexpr size_t WS_END = WS_BAR + 16384;

struct Params {
    const float* in[29];
    const int* page_table;
    float* out;
    unsigned char* ws;
};

DEV unsigned f2bf(float f) { return (unsigned)__builtin_bit_cast(unsigned short, (__bf16)f); }
typedef __bf16 hwbf16x2 __attribute__((ext_vector_type(2)));
typedef float f32x2_ __attribute__((ext_vector_type(2)));
DEV unsigned pk2(float lo, float hi) { const f32x2_ v = {lo, hi}; return __builtin_bit_cast(unsigned, __builtin_convertvector(v, hwbf16x2)); }
DEV float bf2f(unsigned short v) { return __builtin_bit_cast(float, (unsigned)v << 16); }
DEV float bflo(unsigned v) { return __builtin_bit_cast(float, v << 16); }
DEV float bfhi(unsigned v) { return __builtin_bit_cast(float, v & 0xffff0000u); }
DEV int opaque_tid() { int t = threadIdx.x; asm volatile("" : "+v"(t)); return t; }
constexpr int PTAB_OFF = 147456 - 1024 + 64;
DEV unsigned long long ptab_get(int i) { const unsigned long long v = ((LAS unsigned long long*)(unsigned)PTAB_OFF)[i];
    return (unsigned long long)(unsigned)__builtin_amdgcn_readfirstlane((unsigned)v) | ((unsigned long long)(unsigned)__builtin_amdgcn_readfirstlane((unsigned)(v >> 32)) << 32); }
#define GAS __attribute__((address_space(1)))
DEV const float* pin(int i) { return (const float*)(GAS const float*)ptab_get(i); }
DEV const int* ppt() { return (const int*)(GAS const int*)ptab_get(8); }
DEV float* pout() { return (float*)(GAS float*)ptab_get(29); }
DEV unsigned char* pws() { return (unsigned char*)(GAS unsigned char*)ptab_get(30); }
DEV void lds_barrier() { asm volatile("s_waitcnt lgkmcnt(0)" ::: "memory"); __builtin_amdgcn_s_barrier(); asm volatile("" ::: "memory"); }
template <int CTRL> DEV float dpp_f(float v) { return __builtin_bit_cast(float, __builtin_amdgcn_update_dpp(0, __builtin_bit_cast(int, v), CTRL, 0xf, 0xf, true)); }
template <int CTRL> DEV unsigned dpp_u(unsigned v) { return (unsigned)__builtin_amdgcn_update_dpp(0, (int)v, CTRL, 0xf, 0xf, true); }
constexpr int DPP_XOR1 = 0xB1, DPP_XOR2 = 0x4E, DPP_HMIRROR = 0x141, DPP_MIRROR = 0x140;
DEV float sum8_(float v) { v += dpp_f<DPP_XOR1>(v); v += dpp_f<DPP_XOR2>(v); v += dpp_f<DPP_HMIRROR>(v); return v; }
DEV float sum16_(float v) { v = sum8_(v); v += dpp_f<DPP_MIRROR>(v); return v; }
DEV void swap16_(float v, float& a, float& b) { a = v; b = v; asm volatile("v_nop\n\tv_nop\n\tv_permlane16_swap_b32 %0, %1" : "+v"(a), "+v"(b)); }
DEV void swap32_(float v, float& a, float& b) { a = v; b = v; asm volatile("v_nop\n\tv_nop\n\tv_permlane32_swap_b32 %0, %1" : "+v"(a), "+v"(b)); }
DEV float xrow_sum(float v) { float a, b; swap16_(v, a, b); v = a + b; swap32_(v, a, b); return a + b; }
DEV float xrow_max(float v) { float a, b; swap16_(v, a, b); v = fmaxf(a, b); swap32_(v, a, b); return fmaxf(a, b); }
DEV float wave_sum(float v) { return xrow_sum(sum16_(v)); }
DEV float sigmoidf_(float x) { return __builtin_amdgcn_rcpf(1.f + __expf(-x)); }
DEV float siluf_(float x) { return x * __builtin_amdgcn_rcpf(1.f + __expf(-x)); }
DEV float softplusf_(float x) { return x > 20.f ? x : log1pf(__expf(x)); }
DEV float geluf_(float x) { const float u = 0.7978845608028654f * (x + 0.044715f * x * x * x); return x * __builtin_amdgcn_rcpf(1.f + __expf(-2.f * u)); }

DEV void transpose_item(const float* W, int ldn, int k0, int n0, bf16_t* WT, int ldk, int dst_row0, LAS float* scr, int lane, const float* gk = nullptr) {
    const float gv = gk ? gk[k0 + lane] : 1.f;
#pragma unroll 8
    for (int i = 0; i < 32; ++i) { const int kk = 2 * i + (lane >> 5); scr[kk * 33 + (lane & 31)] = W[(size_t)(k0 + kk) * ldn + n0 + (lane & 31)] * __shfl(gv, kk); }
    asm volatile("s_waitcnt lgkmcnt(0)" ::: "memory");
    const int c = lane & 7;
#pragma unroll
    for (int j = 0; j < 4; ++j) { const int n = (lane >> 3) + 8 * j; const LAS float* s = scr + (8 * c) * 33 + n;
        u32x4 o; o.x = pk2(s[0 * 33], s[1 * 33]); o.y = pk2(s[2 * 33], s[3 * 33]); o.z = pk2(s[4 * 33], s[5 * 33]); o.w = pk2(s[6 * 33], s[7 * 33]);
        *(u32x4*)(WT + (size_t)(dst_row0 + n) * ldk + k0 + 8 * c) = o; }
    asm volatile("s_waitcnt lgkmcnt(0)" ::: "memory");
}

DEV void phase_prep(const Params& p, LAS unsigned char* lds, int gw, int ngw, int lane, int wave) {
    LAS float* scr = (LAS float*)(lds + wave * 16384);
    unsigned char* ws = pws();
    constexpr int I_G = 16 * 88;
    constexpr int I_D = 44 * 32;
    constexpr int I_EIN = 16 * 112, I_SQ = 16 * 32, I_OIN = 16 * 72, I_C1 = 4 * 16 * 4;
    constexpr int T0 = 4 * I_G, T1 = T0 + 4 * I_G, T2 = T1 + 4 * I_D, T3 = T2 + I_EIN, T4 = T3 + I_SQ, T5 = T4 + I_OIN, T6 = T5 + I_SQ, T7 = T6 + I_C1;
    for (int it = gw; it < T7 + 32; it += ngw) {
        if (it >= T7) {
            const int r = it - T7, kb = r & 15;
            if (r < 16) transpose_item(pin(13), EV_SRC, kb * 64, 2048, (bf16_t*)(ws + WS_WEIN), 1024, EV_N, scr, lane, pin(9) + 2 * D);
            else transpose_item(pin(20), OD_SRC, kb * 64, 512, (bf16_t*)(ws + WS_WOIN), 1024, OD_N, scr, lane, pin(9) + 8 * D);
            continue;
        }
        if (it < T1) {
            const bool up = it >= T0; const int r = up ? it - T0 : it; const int mat = r / I_G, rr = r % I_G, kb = rr / 88, nb = rr % 88;
            const float* W = (up ? pin(11) : pin(10)) + (size_t)mat * 1024 * FF;
            bf16_t* WT = (bf16_t*)(ws + WS_WGU) + (size_t)mat * 5632 * 1024;
            const int n0 = nb * 32, pn = n0 / 128, c = n0 % 128;
            transpose_item(W, FF, kb * 64, n0, WT, 1024, pn * 256 + (up ? 128 : 0) + c, scr, lane, pin(9) + ((mat >> 1) * 6 + ((mat & 1) ? 4 : 0)) * D);
        } else if (it < T2) {
            const int r = it - T1, mat = r / I_D, rr = r % I_D, kb = rr / 32, nb = rr % 32;
            transpose_item(pin(12) + (size_t)mat * FF * 1024, 1024, kb * 64, nb * 32, (bf16_t*)(ws + WS_WD) + (size_t)mat * 1024 * FF, FF, nb * 32, scr, lane);
        } else if (it < T3) {
            const int r = it - T2, kb = r / 112, nb = r % 112, dr = nb * 32;
            transpose_item(pin(13), EV_SRC, kb * 64, dr < 2048 ? dr : dr + 8, (bf16_t*)(ws + WS_WEIN), 1024, dr, scr, lane, pin(9) + 2 * D);
        } else if (it < T4) {
            const int r = it - T3, kb = r / 32, nb = r % 32;
            transpose_item(pin(14), 1024, kb * 64, nb * 32, (bf16_t*)(ws + WS_WEOUT), 1024, nb * 32, scr, lane);
        } else if (it < T5) {
            const int r = it - T4, kb = r / 72, nb = r % 72, dr = nb * 32;
            transpose_item(pin(20), OD_SRC, kb * 64, dr < 512 ? dr : dr + 24, (bf16_t*)(ws + WS_WOIN), 1024, dr, scr, lane, pin(9) + 8 * D);
        } else if (it < T6) {
            const int r = it - T5, kb = r / 32, nb = r % 32;
            transpose_item(pin(21), 1024, kb * 64, nb * 32, (bf16_t*)(ws + WS_WOOUT), 1024, nb * 32, scr, lane);
        } else {
            const int r = it - T6, kvh = r / 64, rr = r % 64, kb = rr / 4, nb = rr % 4;
            const float* W = pin(23) + (size_t)(kvh >> 1) * 2048 * 128 + (size_t)(kvh & 1) * 1024 * 128;
            transpose_item(W, 128, kb * 64, nb * 32, (bf16_t*)(ws + WS_WC1) + (size_t)(kvh >> 1) * 256 * 1024, 1024, (kvh & 1) * 128 + nb * 32, scr, lane);
        }
    }
    const int gt = gw * 64 + lane, ngt = ngw * 64;
    for (int i = gt; i < 2 * 64 * 128; i += ngt) {
        const int kv = i / 8192, r = i % 8192, d = r / 128, h = r % 128;
        ((bf16_t*)(ws + WS_WC2))[i] = (bf16_t)f2bf(pin(24)[(size_t)kv * 8192 + h * 64 + d]);
    }
    for (int i = gt; i < 8 * 128 * 128; i += ngt) {
        const int t = (i / 128) % 128, s = i % 128;
        ((bf16_t*)(ws + WS_WDS))[i] = (bf16_t)f2bf(s <= t ? pin(25)[i] : 0.f);
    }
    for (int o = gw; o < 256; o += ngw) {
        const int kv = o / 128, h = o % 128; float acc = 0.f;
        for (int k = lane; k < 2048; k += 64) acc += pin(22)[(size_t)kv * 2048 + k] * pin(23)[((size_t)kv * 2048 + k) * 128 + h];
        acc = wave_sum(acc);
        if (lane == 0) ((float*)(ws + WS_CBIAS))[o] = acc;
    }
}

struct RowNormArgs {
    const float* x_in_p; const float* x_in_s;
    const float* Ysrc;
    const bf16_t* Yt; int ntp;
    const float* g_post; float scale;
    bf16_t* xb;
    float* rstd;
    float* out_p; float* out_s;
    bool write_x;
};
DEV void phase_rownorm(const RowNormArgs& a, int gw, int ngw, int lane) {
    f32x4 gpost[4];
#pragma unroll
    for (int j = 0; j < 4; ++j) gpost[j] = a.Ysrc ? ((const f32x4*)a.g_post)[lane + 64 * j] : (f32x4){0.f, 0.f, 0.f, 0.f};
    for (int row = gw; row < NT; row += ngw) {
        f32x4 v[4];
        if (a.x_in_p) { const float* xr = row < NP ? a.x_in_p + (size_t)row * D : a.x_in_s + (size_t)(row - NP) * D;
#pragma unroll
            for (int j = 0; j < 4; ++j) v[j] = ((const f32x4*)xr)[lane + 64 * j]; }
        else {
#pragma unroll
            for (int j = 0; j < 4; ++j) { const u32x2 w = ((const u32x2*)(a.xb + (size_t)row * D))[lane + 64 * j]; v[j] = (f32x4){bflo(w.x), bfhi(w.x), bflo(w.y), bfhi(w.y)}; } }
        if (a.Ysrc) {
            f32x4 y[4]; float s = 0.f;
#pragma unroll
            for (int j = 0; j < 4; ++j) {
                if (row < NP) { const u32x2 w = ((const u32x2*)((const bf16_t*)a.Ysrc + (size_t)row * D))[lane + 64 * j]; y[j] = (f32x4){bflo(w.x), bfhi(w.x), bflo(w.y), bfhi(w.y)}; }
                else { y[j] = (f32x4){0.f, 0.f, 0.f, 0.f};
                    for (int q = 0; q < a.ntp; ++q) { const u32x2 w = ((const u32x2*)(a.Yt + ((size_t)q * NS + (row - NP)) * D))[lane + 64 * j]; y[j] += (f32x4){bflo(w.x), bfhi(w.x), bflo(w.y), bfhi(w.y)}; } }
                s += (y[j].x * y[j].x + y[j].y * y[j].y) + (y[j].z * y[j].z + y[j].w * y[j].w); }
            const float r = a.scale * rsqrtf(wave_sum(s) * (1.f / D) + 1e-6f);
#pragma unroll
            for (int j = 0; j < 4; ++j) v[j] += y[j] * gpost[j] * r;
        }
        if (a.out_p) {
            float* o = row < NP ? a.out_p + (size_t)row * D : a.out_s + (size_t)(row - NP) * D;
#pragma unroll
            for (int j = 0; j < 4; ++j) __builtin_nontemporal_store(v[j], (f32x4*)o + lane + 64 * j);
        }
        if (a.write_x) {
#pragma unroll
            for (int j = 0; j < 4; ++j) { u32x2 w; w.x = pk2(v[j].x, v[j].y); w.y = pk2(v[j].z, v[j].w); ((u32x2*)(a.xb + (size_t)row * D))[lane + 64 * j] = w; }
        }
        if (a.rstd) {
            float s = 0.f;
#pragma unroll
            for (int j = 0; j < 4; ++j) s += (v[j].x * v[j].x + v[j].y * v[j].y) + (v[j].z * v[j].z + v[j].w * v[j].w);
            const float r = rsqrtf(wave_sum(s) * (1.f / D) + 1e-6f);
            if (lane == 0) a.rstd[row] = r;
        }
    }
}

constexpr int BM = 256, BK = 64, HALF = 128, NXCD = 8, WGM = 8, HT = HALF * BK;
DEV int lds_byte(int r, int c) { const int st = (r >> 4) * 2 + (c >> 5), rr = r & 15, cc = c & 31, ob = rr * 64 + cc * 2; return st * 1024 + (ob ^ (((ob >> 9) & 1) << 5)); }
DEV void stage_rc(int b, int& R, int& C) { const int st = b / 1024, sb = b % 1024, swz = sb ^ (((sb >> 9) & 1) << 5); R = (st >> 1) * 16 + swz / 64; C = (st & 1) * 32 + (swz % 64) / 2; }

struct EpiF32 {
    static constexpr bool ROWSCALE = false;
    float* C0; int ldc; size_t part_stride;
    DEV void operator()(const f32x4 (&acc)[2][2][4][2], int brow, int bcol, int wr, int wc, int fr, int fq, int part, const float (&rs)[8]) const {
        float* C = C0 + (size_t)part * part_stride;
#pragma unroll
        for (int ai = 0; ai < 2; ++ai)
#pragma unroll
            for (int m = 0; m < 4; ++m) { float* rowp = C + (size_t)(brow + ai * HALF + wr * 64 + m * 16 + fr) * ldc + bcol + wc * 32 + fq * 4;
#pragma unroll
                for (int bj = 0; bj < 2; ++bj)
#pragma unroll
                    for (int n = 0; n < 2; ++n) *(f32x4*)(rowp + bj * HALF + n * 16) = acc[ai][bj][m][n]; }
    }
};
struct EpiBf16 {
    static constexpr bool ROWSCALE = false;
    bf16_t* C0; int ldc; size_t part_stride;
    DEV void operator()(const f32x4 (&acc)[2][2][4][2], int brow, int bcol, int wr, int wc, int fr, int fq, int part, const float (&rs)[8]) const {
        bf16_t* C = C0 + (size_t)part * part_stride;
#pragma unroll
        for (int ai = 0; ai < 2; ++ai)
#pragma unroll
            for (int m = 0; m < 4; ++m) { bf16_t* rowp = C + (size_t)(brow + ai * HALF + wr * 64 + m * 16 + fr) * ldc + bcol + wc * 32 + fq * 4;
#pragma unroll
                for (int bj = 0; bj < 2; ++bj)
#pragma unroll
                    for (int n = 0; n < 2; ++n) { const f32x4 v = acc[ai][bj][m][n]; u32x2 w; w.x = pk2(v[0], v[1]); w.y = pk2(v[2], v[3]); *(u32x2*)(rowp + bj * HALF + n * 16) = w; } }
    }
};
struct EpiInProj {
    static constexpr bool ROWSCALE = true;
    bf16_t* C; int ldc; int n_main; float* ext; int n_ext; const float* rstd;
    DEV void operator()(const f32x4 (&acc)[2][2][4][2], int brow, int bcol, int wr, int wc, int fr, int fq, int part, const float (&rs)[8]) const {
        if (bcol < n_main) {
#pragma unroll
            for (int ai = 0; ai < 2; ++ai)
#pragma unroll
                for (int m = 0; m < 4; ++m) { const int row = brow + ai * HALF + wr * 64 + m * 16 + fr; const float r = rs[ai * 4 + m]; bf16_t* rowp = C + (size_t)row * ldc + bcol + wc * 32 + fq * 4;
#pragma unroll
                    for (int bj = 0; bj < 2; ++bj)
#pragma unroll
                        for (int n = 0; n < 2; ++n) { const f32x4 v = acc[ai][bj][m][n] * r; u32x2 w; w.x = pk2(v[0], v[1]); w.y = pk2(v[2], v[3]); *(u32x2*)(rowp + bj * HALF + n * 16) = w; } }
            return; }
        if (wc == 0) {
#pragma unroll
            for (int n = 0; n < 2; ++n) { const int c = n * 16 + fq * 4;
                if (c < n_ext) {
#pragma unroll
                    for (int ai = 0; ai < 2; ++ai)
#pragma unroll
                        for (int m = 0; m < 4; ++m) { const int row = brow + ai * HALF + wr * 64 + m * 16 + fr; *(f32x4*)(ext + (size_t)row * 24 + c) = acc[ai][0][m][n] * rs[ai * 4 + m]; }
                } }
        }
    }
};
struct EpiSwiglu {
    static constexpr bool ROWSCALE = true;
    bf16_t* C; const float* rstd;
    DEV void operator()(const f32x4 (&acc)[2][2][4][2], int brow, int bcol, int wr, int wc, int fr, int fq, int part, const float (&rs)[8]) const {
#pragma unroll
        for (int ai = 0; ai < 2; ++ai)
#pragma unroll
            for (int m = 0; m < 4; ++m) { const int row = brow + ai * HALF + wr * 64 + m * 16 + fr; const float r = rs[ai * 4 + m]; bf16_t* rowp = C + (size_t)row * FF + (bcol >> 1) + wc * 32 + fq * 4;
#pragma unroll
                for (int n = 0; n < 2; ++n) { const f32x4 g = acc[ai][0][m][n] * r, u = acc[ai][1][m][n] * r;
                    u32x2 w; w.x = pk2(siluf_(g[0]) * u[0], siluf_(g[1]) * u[1]); w.y = pk2(siluf_(g[2]) * u[2], siluf_(g[3]) * u[3]); *(u32x2*)(rowp + n * 16) = w; } }
    }
};

template <class Epi>
DEV void gemm_phase(LAS unsigned char* lds, const bf16_t* __restrict__ A, const bf16_t* __restrict__ Bt, int M, int N, int K, const Epi& E, int row0 = 0, int nparts = 1) {
    const int tidg = opaque_tid();
    const int wid = __builtin_amdgcn_readfirstlane(tidg >> 6), lane = tidg & 63, wr = wid >> 2, wc = wid & 3, fr = lane & 15, fq = lane >> 4;
    unsigned voff[2];
#pragma unroll
    for (int i = 0; i < 2; ++i) { int R, C; stage_rc(tidg * 16 + i * 8192, R, C); voff[i] = (unsigned)(R * K + C) * 2u; }
    const size_t hstep = (size_t)HALF * K * 2;
    const unsigned ldsw = (unsigned)wid * 1024u;
    const int aoff = lds_byte(wr * 64 + fr, fq * 8), boff = lds_byte(wc * 32 + fr, fq * 8);
#define G_SA(b, h) (((b) * 2 + (h)) * (HT * 2))
#define G_SB(b, h) ((4 + (b) * 2 + (h)) * (HT * 2))
#define STAGE(bufoff, gbase) do { _Pragma("unroll") for (int _i = 0; _i < 2; ++_i) \
      __builtin_amdgcn_global_load_lds((const unsigned*)((const char*)(gbase) + voff[_i]), (LAS unsigned*)(lds + (bufoff) + ldsw + _i * 8192), 16, 0, 0); } while (0)
#define LDA(dst, b, h) do { _Pragma("unroll") for (int m = 0; m < 4; ++m) _Pragma("unroll") for (int k = 0; k < 2; ++k) dst[m][k] = *(const LAS bf16x8*)(lds + G_SA(b, h) + aoff + m * 2048 + k * 1024); } while (0)
#define LDB(dst, b, h) do { _Pragma("unroll") for (int n = 0; n < 2; ++n) _Pragma("unroll") for (int k = 0; k < 2; ++k) dst[n][k] = *(const LAS bf16x8*)(lds + G_SB(b, h) + boff + n * 2048 + k * 1024); } while (0)
#define MMA(ai, bj, At, Bq) do { __builtin_amdgcn_s_setprio(1); \
    _Pragma("unroll") for (int m = 0; m < 4; ++m) _Pragma("unroll") for (int n = 0; n < 2; ++n) _Pragma("unroll") for (int k = 0; k < 2; ++k) \
      acc[ai][bj][m][n] = __builtin_amdgcn_mfma_f32_16x16x32_bf16(Bq[n][k], At[m][k], acc[ai][bj][m][n], 0, 0, 0); \
    __builtin_amdgcn_s_setprio(0); } while (0)
#define WAIT_V(n) asm volatile("s_waitcnt vmcnt(" #n ")" ::: "memory")
#define WAIT_L(n) asm volatile("s_waitcnt lgkmcnt(" #n ")" ::: "memory")
#define BAR __builtin_amdgcn_s_barrier()
#define SCHED __builtin_amdgcn_sched_barrier(0)
    const int nM = M / BM, nN = N / BM, nwg = nM * nN, nunits = nwg * nparts;
    const int nt = K / BK / nparts;
    auto decode = [&](int L, int& brow, int& bcol, int& part, const char*& uA, const char*& uB) {
        part = L % nparts;
        int wgid = L / nparts;
        { const int q = nwg / NXCD, r = nwg % NXCD, xcd = wgid % NXCD, off = wgid / NXCD; wgid = (xcd < r ? xcd * (q + 1) : r * (q + 1) + (xcd - r) * q) + off; }
        const int nig = WGM * nN, gid = wgid / nig, fm = gid * WGM, gsz = min(nM - fm, WGM);
        const int pm = fm + ((wgid % nig) % gsz), pn = (wgid % nig) / gsz; brow = row0 + pm * BM; bcol = pn * BM;
        uA = (const char*)A + ((size_t)brow * K + (size_t)part * nt * BK) * 2; uB = (const char*)Bt + ((size_t)bcol * K + (size_t)part * nt * BK) * 2;
    };
    int L = blockIdx.x;
    if (L < nunits) {
        int brow, bcol, part; const char* cA; const char* cB;
        decode(L, brow, bcol, part, cA, cB);
        f32x4 acc[2][2][4][2];
#pragma unroll
        for (int a = 0; a < 2; ++a)
#pragma unroll
            for (int b = 0; b < 2; ++b)
#pragma unroll
                for (int m = 0; m < 4; ++m)
#pragma unroll
                    for (int n = 0; n < 2; ++n) acc[a][b][m][n] = (f32x4){0.f, 0.f, 0.f, 0.f};
        bf16x8 At[4][2], B0[2][2], B1[2][2];
        float rs[8];
        if constexpr (Epi::ROWSCALE) {
#pragma unroll
            for (int i = 0; i < 8; ++i) rs[i] = E.rstd[brow + (i >> 2) * HALF + wr * 64 + (i & 3) * 16 + fr];
        }
#if GEMM_SP2
        STAGE(G_SB(0, 0), cB); STAGE(G_SB(0, 1), cB + hstep); STAGE(G_SA(0, 0), cA); STAGE(G_SA(0, 1), cA + hstep);
        if (wr == 1) BAR;
        WAIT_V(2); BAR;
        STAGE(G_SB(1, 0), cB + 128); STAGE(G_SA(1, 0), cA + 128); STAGE(G_SB(1, 1), cB + hstep + 128);
        WAIT_V(6); BAR;
#else
        STAGE(G_SB(0, 0), cB); STAGE(G_SA(0, 0), cA);
        STAGE(G_SB(0, 1), cB + hstep); STAGE(G_SA(0, 1), cA + hstep);
        if (wr == 1) BAR;
        WAIT_V(4); BAR;
        STAGE(G_SB(1, 0), cB + 128); STAGE(G_SA(1, 0), cA + 128); STAGE(G_SB(1, 1), cB + hstep + 128);
        WAIT_V(6); BAR;
#endif
        for (;;) {
            const int Ln = L + (int)gridDim.x; const bool has_next = Ln < nunits;
            int nbrow = brow, nbcol = bcol, npart = part; const char* nA = cA; const char* nB = cB;
            if (has_next) decode(Ln, nbrow, nbcol, npart, nA, nB);
            for (int t = 0; t < nt; t += 2) {
                const bool last = (t == nt - 2);
                const char* a1 = cA + (size_t)(t + 1) * 128;
                const char* a2 = last ? nA : cA + (size_t)(t + 2) * 128; const char* b2 = last ? nB : cB + (size_t)(t + 2) * 128;
                const char* a3 = a2 + 128; const char* b3 = b2 + 128;
#if GEMM_SP2
                LDB(B0, 0, 0); LDB(B1, 0, 1); SCHED; LDA(At, 0, 0); STAGE(G_SA(1, 1), a1 + hstep);
                WAIT_V(8); WAIT_L(0); BAR; MMA(0, 0, At, B0); MMA(0, 1, At, B1); BAR; SCHED;
                LDA(At, 0, 1); STAGE(G_SB(0, 0), b2); STAGE(G_SB(0, 1), b2 + hstep); STAGE(G_SA(0, 0), a2);
                WAIT_V(8); WAIT_L(0); BAR; MMA(1, 0, At, B0); MMA(1, 1, At, B1); BAR; SCHED;
                LDB(B0, 1, 0); LDB(B1, 1, 1); SCHED; LDA(At, 1, 0); STAGE(G_SA(0, 1), a2 + hstep);
                WAIT_V(8); WAIT_L(0); BAR; MMA(0, 0, At, B0); MMA(0, 1, At, B1); BAR; SCHED;
                LDA(At, 1, 1); STAGE(G_SB(1, 0), b3); STAGE(G_SB(1, 1), b3 + hstep); STAGE(G_SA(1, 0), a3);
                WAIT_V(8); WAIT_L(0); BAR; MMA(1, 0, At, B0); MMA(1, 1, At, B1); BAR; SCHED;
#else
                LDB(B0, 0, 0); SCHED; LDA(At, 0, 0); STAGE(G_SA(1, 1), a1 + hstep);
                WAIT_L(8); BAR; WAIT_L(0); MMA(0, 0, At, B0); BAR; SCHED;
                LDB(B1, 0, 1); STAGE(G_SB(0, 0), b2);
                BAR; WAIT_L(0); MMA(0, 1, At, B1); BAR;
                LDA(At, 0, 1); STAGE(G_SA(0, 0), a2);
                BAR; WAIT_L(0); MMA(1, 0, At, B0); BAR; SCHED;
                STAGE(G_SB(0, 1), b2 + hstep);
                WAIT_V(6); BAR; MMA(1, 1, At, B1); BAR;
                LDB(B0, 1, 0); SCHED; LDA(At, 1, 0); STAGE(G_SA(0, 1), a2 + hstep);
                WAIT_L(8); BAR; WAIT_L(0); MMA(0, 0, At, B0); BAR; SCHED;
                LDB(B1, 1, 1); STAGE(G_SB(1, 0), b3);
                BAR; WAIT_L(0); MMA(0, 1, At, B1); BAR;
                LDA(At, 1, 1); STAGE(G_SA(1, 0), a3);
                BAR; WAIT_L(0); MMA(1, 0, At, B0); BAR; SCHED;
                STAGE(G_SB(1, 1), b3 + hstep);
                WAIT_V(6); BAR; MMA(1, 1, At, B1); BAR;
#endif
            }
            E(acc, brow, bcol, wr, wc, fr, fq, part, rs);
            if (!has_next) break;
#pragma unroll
            for (int a = 0; a < 2; ++a)
#pragma unroll
                for (int b = 0; b < 2; ++b)
#pragma unroll
                    for (int m = 0; m < 4; ++m)
#pragma unroll
                        for (int n = 0; n < 2; ++n) acc[a][b][m][n] = (f32x4){0.f, 0.f, 0.f, 0.f};
            L = Ln; brow = nbrow; bcol = nbcol; part = npart; cA = nA; cB = nB;
            if constexpr (Epi::ROWSCALE) {
#pragma unroll
                for (int i = 0; i < 8; ++i) rs[i] = E.rstd[brow + (i >> 2) * HALF + wr * 64 + (i & 3) * 16 + fr];
            }
        }
        WAIT_V(0);
        if (wr == 0) BAR;
        BAR;
    }
    __syncthreads();
#undef G_SA
#undef G_SB
#undef STAGE
#undef LDA
#undef LDB
#undef MMA
}

DEV void phase_even_a(const Params& p, const bf16_t* P, const float* EXT, float* QKV, float* GB, int tok_lo, int gw, int ngw, int lane) {
    const float* wconv = pin(15); const float* a_log = pin(16); const float* dt_bias = pin(17);
    for (int tok = tok_lo + gw; tok < NT; tok += ngw) {
        int t, base; const float* buf = nullptr;
        if (tok < NP) { t = tok % SEQ; base = tok - t; } else { t = (tok - NP) % DSQ; base = tok - t; buf = pin(3) + (size_t)((tok - NP) / DSQ) * 3 * 1536; }
        for (int seg = 0; seg < 3; ++seg) {
            const int c0 = seg * 512 + lane * 8;
            float y[8];
#pragma unroll
            for (int e = 0; e < 8; ++e) y[e] = 0.f;
            for (int j = 0; j < 4; ++j) {
                const int m = t - 3 + j; float xv[8];
                if (m >= 0) { const u32x4 r = *(const u32x4*)(P + (size_t)(base + m) * EV_N + c0);
                    xv[0] = bflo(r.x); xv[1] = bfhi(r.x); xv[2] = bflo(r.y); xv[3] = bfhi(r.y); xv[4] = bflo(r.z); xv[5] = bfhi(r.z); xv[6] = bflo(r.w); xv[7] = bfhi(r.w); }
                else if (buf) {
#pragma unroll
                    for (int e = 0; e < 8; ++e) xv[e] = buf[(size_t)(3 + m) * 1536 + c0 + e]; }
                else {
#pragma unroll
                    for (int e = 0; e < 8; ++e) xv[e] = 0.f; }
#pragma unroll
                for (int e = 0; e < 8; ++e) y[e] += wconv[j * 1536 + c0 + e] * xv[e];
            }
            float ss = 0.f;
#pragma unroll
            for (int e = 0; e < 8; ++e) { y[e] = siluf_(y[e]); ss += y[e] * y[e]; }
            if (seg < 2) {
                ss = sum16_(ss);
                const float r = rsqrtf(ss + 1e-6f) * (seg == 0 ? 0.08838834764831845f : 1.f);
#pragma unroll
                for (int e = 0; e < 8; ++e) y[e] *= r;
            }
#pragma unroll
            for (int e = 0; e < 8; ++e) QKV[(size_t)tok * 1536 + c0 + e] = y[e];
        }
        if (lane < 4) {
            const float b = EXT[(size_t)tok * 24 + lane], a = EXT[(size_t)tok * 24 + 4 + lane];
            GB[(size_t)tok * 8 + lane] = -__expf(a_log[lane]) * softplusf_(a + dt_bias[lane]);
            GB[(size_t)tok * 8 + 4 + lane] = sigmoidf_(b);
        }
    }
    const int gt = gw * 64 + lane, ngt = ngw * 64;
    for (int i = gt; i < 4 * 3 * 1536; i += ngt) { const int b = i / 4608, r = (i / 1536) % 3, c = i % 1536; pout()[O_CAP + i] = bf2f(P[(size_t)(b * SEQ + 4093 + r) * EV_N + c]); }
    for (int i = gt; i < 128 * 3 * 1536; i += ngt) { const int b = i / 4608, r = (i / 1536) % 3, c = i % 1536; pout()[O_CAS + i] = bf2f(P[(size_t)(NP + b * 8 + 5 + r) * EV_N + c]); }
}

DEV void delta_recurrence(const Params& p, const float* QKV, const float* GB, float* OB, LAS unsigned char* lds, int first_item, int item_stride, int n_items_lo, int n_items_hi) {
    LAS float* kqT = (LAS float*)lds;
    LAS float* red_kv = kqT + 8 * 512;
    LAS float* red_o = red_kv + 512;
    const int tid = opaque_tid(), part = tid >> 7, j = tid & 127;
    for (int item = first_item; item < n_items_hi; item += item_stride) {
        if (item < n_items_lo) continue;
        const int db = (item - 16) >> 2, h = (item - 16) & 3, base = NP + db * DSQ;
        const float* S0 = pin(2) + (size_t)(db * 4 + h) * 16384; float* Sout = pout() + O_DS + (size_t)(db * 4 + h) * 16384;
        float S[32];
#pragma unroll
        for (int i = 0; i < 32; ++i) S[i] = __builtin_nontemporal_load(S0 + (size_t)(part * 32 + i) * 128 + j);
        if (tid < 384) { const int seg = tid >> 7; const int src = seg == 0 ? 512 : (seg == 1 ? 0 : 1024);
            float x[DSQ];
#pragma unroll
            for (int t = 0; t < DSQ; ++t) x[t] = QKV[(size_t)(base + t) * 1536 + src + h * 128 + j];
#pragma unroll
            for (int t = 0; t < DSQ; ++t) kqT[t * 512 + tid] = x[t]; }
        else if (tid < 384 + 2 * DSQ) { const int t = (tid - 384) >> 1, w = (tid - 384) & 1; kqT[t * 512 + 384 + w] = GB[(size_t)(base + t) * 8 + w * 4 + h]; }
        __syncthreads();
        for (int t = 0; t < DSQ; ++t) {
            const size_t tok = (size_t)(base + t);
            LAS float* kq = kqT + t * 512;
            const float decay = __expf(kq[384]), beta = kq[385];
            float pk = 0.f;
#pragma unroll
            for (int i = 0; i < 32; ++i) { S[i] *= decay; pk += S[i] * kq[part * 32 + i]; }
            red_kv[part * 128 + j] = pk;
            lds_barrier();
            const float kvm = (red_kv[j] + red_kv[128 + j]) + (red_kv[256 + j] + red_kv[384 + j]);
            const float dl = beta * (kq[256 + j] - kvm);
            float po = 0.f;
#pragma unroll
            for (int i = 0; i < 32; ++i) { S[i] += kq[part * 32 + i] * dl; po += S[i] * kq[128 + part * 32 + i]; }
            red_o[part * 128 + j] = po;
            lds_barrier();
            if (part == 0) OB[tok * 512 + h * 128 + j] = (red_o[j] + red_o[128 + j]) + (red_o[256 + j] + red_o[384 + j]);
        }
#pragma unroll
        for (int i = 0; i < 32; ++i) __builtin_nontemporal_store(S[i], Sout + (size_t)(part * 32 + i) * 128 + j);
        __syncthreads();
    }
}

DEV bf16x8 lds_frag(LAS unsigned char* base, int row, int stride_b, int kbyte) { return *(const LAS bf16x8*)(base + row * stride_b + kbyte); }
DEV void phase_chunk_prep(const Params& p, const bf16_t* P, const float* EXT, unsigned char* ws, LAS unsigned char* lds) {
    constexpr int QS = 0, KS = 17408, VBT = 34816, KGT = 53248, KTT = 71680, AM = 90112, TM = 106752, GCS = 115968, BETAS = 116224, WCS = 116736;
    constexpr int RS = 272, TS = 144;
    const int tid = opaque_tid(), lane = tid & 63, wave = __builtin_amdgcn_readfirstlane(tid >> 6), fr = lane & 15, fq = lane >> 4;
    const float* wconv = pin(15); const float* a_log = pin(16); const float* dt_bias = pin(17);
    LAS float* gcs = (LAS float*)(lds + GCS); LAS float* betas = (LAS float*)(lds + BETAS); LAS float* Am = (LAS float*)(lds + AM);
    bf16_t* CW = (bf16_t*)(ws + WS_CW); bf16_t* CQ = (bf16_t*)(ws + WS_CQ); bf16_t* CKT = (bf16_t*)(ws + WS_CKT); float* CU = (float*)(ws + WS_CU);
    bf16_t* CI = (bf16_t*)(ws + WS_CI); float* CGL = (float*)(ws + WS_CGL);
    int h_staged = -1;
    for (int item = blockIdx.x; item < 1024; item += gridDim.x) {
        const int bh = item >> 6, n = item & 63, b = bh >> 2, h = bh & 3;
        const size_t ci = (size_t)item;
        if (h != h_staged) {
            for (int i = tid; i < 1536; i += NTHR) { const int sg = i >> 9, j = (i >> 7) & 3, ch = i & 127; ((LAS float*)(lds + WCS))[i] = wconv[j * 1536 + sg * 512 + h * 128 + ch]; }
            h_staged = h; }
        if (wave == 0) {
            const size_t tok = (size_t)b * SEQ + n * 64 + lane;
            const float a = EXT[tok * 24 + 4 + h], bb = EXT[tok * 24 + h];
            float g = -__expf(a_log[h]) * softplusf_(a + dt_bias[h]);
#pragma unroll
            for (int o = 1; o < 64; o <<= 1) { const float t = __shfl_up(g, o); if (lane >= o) g += t; }
            gcs[lane] = g; betas[lane] = sigmoidf_(bb);
            if (lane == 63) CGL[item] = g;
        }
        lds_barrier();
        {
            const int c = tid >> 3, part = tid & 7, t = n * 64 + c;
            const int csw = (((c >> 3) ^ part) << 4) + (c & 7) * 2;
            const float gc = gcs[c], beta = betas[c], glast = gcs[63];
            const float eg = __expf(gc), et = __expf(glast - gc);
#pragma unroll
            for (int seg = 0; seg < 3; ++seg) {
                const int ch0 = seg * 512 + h * 128 + part * 16;
                float y[16];
#pragma unroll
                for (int e = 0; e < 16; ++e) y[e] = 0.f;
#pragma unroll
                for (int j = 0; j < 4; ++j) {
                    const int m = t - 3 + j;
                    if (m >= 0) {
                        const u32x4 r0 = *(const u32x4*)(P + ((size_t)b * SEQ + m) * EV_N + ch0), r1 = *(const u32x4*)(P + ((size_t)b * SEQ + m) * EV_N + ch0 + 8);
                        const float x[16] = {bflo(r0.x), bfhi(r0.x), bflo(r0.y), bfhi(r0.y), bflo(r0.z), bfhi(r0.z), bflo(r0.w), bfhi(r0.w),
                                             bflo(r1.x), bfhi(r1.x), bflo(r1.y), bfhi(r1.y), bflo(r1.z), bfhi(r1.z), bflo(r1.w), bfhi(r1.w)};
                        const LAS float* wl = (const LAS float*)(lds + WCS) + (seg * 4 + j) * 128 + part * 16;
                        const f32x4 w0 = *(const LAS f32x4*)wl, w1 = *(const LAS f32x4*)(wl + 4), w2 = *(const LAS f32x4*)(wl + 8), w3 = *(const LAS f32x4*)(wl + 12);
                        const float wv[16] = {w0.x, w0.y, w0.z, w0.w, w1.x, w1.y, w1.z, w1.w, w2.x, w2.y, w2.z, w2.w, w3.x, w3.y, w3.z, w3.w};
#pragma unroll
                        for (int e = 0; e < 16; ++e) y[e] += wv[e] * x[e];
                    }
                }
                float ss = 0.f;
#pragma unroll
                for (int e = 0; e < 16; ++e) { y[e] = siluf_(y[e]); ss += y[e] * y[e]; }
                if (seg < 2) {
                    ss = sum8_(ss);
                    const float r = rsqrtf(ss + 1e-6f) * (seg == 0 ? 0.08838834764831845f : 1.f);
#pragma unroll
                    for (int e = 0; e < 16; ++e) y[e] *= r;
                }
                if (seg == 0) {
                    u32x4 a0, a1, d0, d1;
                    a0.x = pk2(y[0], y[1]); a0.y = pk2(y[2], y[3]); a0.z = pk2(y[4], y[5]); a0.w = pk2(y[6], y[7]);
                    a1.x = pk2(y[8], y[9]); a1.y = pk2(y[10], y[11]); a1.z = pk2(y[12], y[13]); a1.w = pk2(y[14], y[15]);
                    *(LAS u32x4*)(lds + QS + c * RS + part * 32) = a0; *(LAS u32x4*)(lds + QS + c * RS + part * 32 + 16) = a1;
                    d0.x = pk2(y[0] * eg, y[1] * eg); d0.y = pk2(y[2] * eg, y[3] * eg); d0.z = pk2(y[4] * eg, y[5] * eg); d0.w = pk2(y[6] * eg, y[7] * eg);
                    d1.x = pk2(y[8] * eg, y[9] * eg); d1.y = pk2(y[10] * eg, y[11] * eg); d1.z = pk2(y[12] * eg, y[13] * eg); d1.w = pk2(y[14] * eg, y[15] * eg);
                    { bf16_t* fb = CQ + ((((ci * 4 + (c >> 4)) * 4 + (part >> 1)) * 64 + (part & 1) * 32 + (c & 15)) << 3); *(u32x4*)fb = d0; *(u32x4*)(fb + 128) = d1; }
                } else if (seg == 1) {
                    u32x4 a0, a1;
                    a0.x = pk2(y[0], y[1]); a0.y = pk2(y[2], y[3]); a0.z = pk2(y[4], y[5]); a0.w = pk2(y[6], y[7]);
                    a1.x = pk2(y[8], y[9]); a1.y = pk2(y[10], y[11]); a1.z = pk2(y[12], y[13]); a1.w = pk2(y[14], y[15]);
                    *(LAS u32x4*)(lds + KS + c * RS + part * 32) = a0; *(LAS u32x4*)(lds + KS + c * RS + part * 32 + 16) = a1;
                    const float bg = beta * eg;
#pragma unroll
                    for (int e = 0; e < 16; ++e) { *(LAS bf16_t*)(lds + KGT + (part * 16 + e) * TS + csw) = (bf16_t)f2bf(y[e] * bg);
                                                   *(LAS bf16_t*)(lds + KTT + (part * 16 + e) * TS + csw) = (bf16_t)f2bf(y[e] * et); }
                } else {
#pragma unroll
                    for (int e = 0; e < 16; ++e) *(LAS bf16_t*)(lds + VBT + (part * 16 + e) * TS + csw) = (bf16_t)f2bf(y[e] * beta);
                }
            }
        }
        lds_barrier();
#pragma unroll
        for (int i = 0; i < 2; ++i) { const int id = tid + i * 512, row = id >> 3, s8 = id & 7;
            *(u32x4*)(CKT + ((((ci * 8 + (row >> 4)) * 2 + (s8 >> 2)) * 64 + (s8 & 3) * 16 + (row & 15)) << 3)) = *(const LAS u32x4*)(lds + KTT + row * TS + ((s8 ^ ((row >> 4) & 7)) << 4)); }
        {
            const int rt = wave >> 1;
#pragma unroll
            for (int ti = 0; ti < 2; ++ti) {
                const int ct = (wave & 1) * 2 + ti;
                f32x4 accK = {0.f, 0.f, 0.f, 0.f}, accQ = {0.f, 0.f, 0.f, 0.f};
#pragma unroll
                for (int k4 = 0; k4 < 4; ++k4) {
                    const bf16x8 aK = lds_frag(lds + KS, rt * 16 + fr, RS, k4 * 64 + fq * 16), aQ = lds_frag(lds + QS, rt * 16 + fr, RS, k4 * 64 + fq * 16), bK = lds_frag(lds + KS, ct * 16 + fr, RS, k4 * 64 + fq * 16);
                    accK = __builtin_amdgcn_mfma_f32_16x16x32_bf16(aK, bK, accK, 0, 0, 0);
                    accQ = __builtin_amdgcn_mfma_f32_16x16x32_bf16(bK, aQ, accQ, 0, 0, 0);
                }
                const int s = ct * 16 + fr; const float gs = gcs[s];
#pragma unroll
                for (int jj = 0; jj < 4; ++jj) { const int c_ = rt * 16 + fq * 4 + jj;
                    const float dm = s <= c_ ? __expf(gcs[c_] - gs) : 0.f;
                    Am[c_ * 65 + s] = s < c_ ? betas[c_] * accK[jj] * dm : 0.f; }
                { const int cq = rt * 16 + fr; const float gq = gcs[cq]; float iv[4];
#pragma unroll
                  for (int jj = 0; jj < 4; ++jj) { const int sq = ct * 16 + fq * 4 + jj; iv[jj] = sq <= cq ? accQ[jj] * __expf(gq - gcs[sq]) : 0.f; }
                  u32x2 w; w.x = pk2(iv[0], iv[1]); w.y = pk2(iv[2], iv[3]);
                  *(u32x2*)(CI + ((((ci * 4 + rt) * 2 + (ct >> 1)) * 64 + ((ct & 1) * 2 + (fq >> 1)) * 16 + fr) << 3) + (fq & 1) * 4) = w; }
            }
        }
        lds_barrier();
        {
            const int j = tid >> 3, pp = tid & 7;
            float Tr[8];
#pragma unroll
            for (int q = 0; q < 8; ++q) Tr[q] = 0.f;
#pragma unroll
            for (int i = 0; i < 64; ++i) {
                float s = 0.f;
#pragma unroll
                for (int q = 0; q < 8; ++q) if (8 * q < i) s += Am[i * 65 + pp + 8 * q] * Tr[q];
                s = sum8_(s);
                const float ti = (i == j ? 1.f : 0.f) - s;
                if (pp == (i & 7)) Tr[i >> 3] = ti;
            }
#pragma unroll
            for (int q = 0; q < 8; ++q) *(LAS bf16_t*)(lds + TM + (pp + 8 * q) * TS + j * 2) = (bf16_t)f2bf(Tr[q]);
        }
        lds_barrier();
        {
            const int rt = wave >> 1;
#pragma unroll
            for (int ti = 0; ti < 4; ++ti) {
                const int ct = (wave & 1) * 4 + ti;
                f32x4 accU = {0.f, 0.f, 0.f, 0.f}, accW = {0.f, 0.f, 0.f, 0.f};
#pragma unroll
                for (int k2 = 0; k2 < 2; ++k2) {
                    const bf16x8 a = lds_frag(lds + TM, rt * 16 + fr, TS, k2 * 64 + fq * 16), bU = lds_frag(lds + VBT, ct * 16 + fr, TS, ((k2 * 4 + fq) ^ ct) << 4), bW = lds_frag(lds + KGT, ct * 16 + fr, TS, ((k2 * 4 + fq) ^ ct) << 4);
                    accU = __builtin_amdgcn_mfma_f32_16x16x32_bf16(a, bU, accU, 0, 0, 0);
                    accW = __builtin_amdgcn_mfma_f32_16x16x32_bf16(bW, a, accW, 0, 0, 0);
                }
                *(f32x4*)(CU + ((((ci * 4 + rt) * 8 + ct) * 64 + lane) << 2)) = accU;
                { u32x2 w; w.x = pk2(accW[0], accW[1]); w.y = pk2(accW[2], accW[3]);
                  *(u32x2*)(CW + ((((ci * 4 + rt) * 4 + (ct >> 1)) * 64 + ((ct & 1) * 2 + (fq >> 1)) * 16 + fr) << 3) + (fq & 1) * 4) = w; }
            }
        }
        lds_barrier();
    }
}

struct ScanFrag { bf16x8 wA[4], qA[4], iA[2], kA[2]; f32x4 u[2]; float gl; };
DEV void scan_load(ScanFrag& f, const bf16_t* CW, const bf16_t* CQ, const bf16_t* CKT, const float* CU, const bf16_t* CI, const float* CGL, size_t ci, bool act, int wave, int sl, int lane) {
    if (act) {
#pragma unroll
        for (int k4 = 0; k4 < 4; ++k4) { f.wA[k4] = *(const bf16x8*)(CW + ((((ci * 4 + wave) * 4 + k4) * 64 + lane) << 3)); f.qA[k4] = *(const bf16x8*)(CQ + ((((ci * 4 + wave) * 4 + k4) * 64 + lane) << 3)); }
#pragma unroll
        for (int k2 = 0; k2 < 2; ++k2) f.iA[k2] = *(const bf16x8*)(CI + ((((ci * 4 + wave) * 2 + k2) * 64 + lane) << 3));
#pragma unroll
        for (int ct = 0; ct < 2; ++ct) f.u[ct] = *(const f32x4*)(CU + ((((ci * 4 + wave) * 8 + sl * 2 + ct) * 64 + lane) << 2));
    }
#pragma unroll
    for (int k2 = 0; k2 < 2; ++k2) f.kA[k2] = *(const bf16x8*)(CKT + ((((ci * 8 + wave) * 2 + k2) * 64 + lane) << 3));
    f.gl = CGL[ci];
}
DEV void phase_scan(const Params& p, unsigned char* ws, float* OB, LAS unsigned char* lds, int unit) {
    constexpr int ST = 0, VNT = 8704, SRS = 272, VRS = 144;
    const int tid = opaque_tid(), lane = tid & 63, wave = __builtin_amdgcn_readfirstlane(tid >> 6), fr = lane & 15, fq = lane >> 4;
    const int bh = (unit & 7) + 8 * (unit >> 5), sl = (unit >> 3) & 3, b = bh >> 2, h = bh & 3; const bool act = wave < 4;
    const bf16_t* CW = (const bf16_t*)(ws + WS_CW); const bf16_t* CQ = (const bf16_t*)(ws + WS_CQ); const bf16_t* CKT = (const bf16_t*)(ws + WS_CKT); const float* CU = (const float*)(ws + WS_CU);
    const bf16_t* CI = (const bf16_t*)(ws + WS_CI); const float* CGL = (const float*)(ws + WS_CGL);
    for (int i = tid; i < (8704 + 4608) / 4; i += NTHR) ((LAS unsigned*)lds)[i] = 0u;
    f32x4 accS[2] = {{0.f, 0.f, 0.f, 0.f}, {0.f, 0.f, 0.f, 0.f}};
    ScanFrag F0, F1, F2;
    scan_load(F0, CW, CQ, CKT, CU, CI, CGL, (size_t)bh * 64, act, wave, sl, lane);
    scan_load(F1, CW, CQ, CKT, CU, CI, CGL, (size_t)bh * 64 + 1, act, wave, sl, lane);
    __syncthreads();
    auto compute = [&](const ScanFrag& cur, int n) {
        f32x4 ao[2] = {{0.f, 0.f, 0.f, 0.f}, {0.f, 0.f, 0.f, 0.f}};
        if (act) {
            f32x4 av[2] = {{0.f, 0.f, 0.f, 0.f}, {0.f, 0.f, 0.f, 0.f}};
#pragma unroll
            for (int k4 = 0; k4 < 4; ++k4)
#pragma unroll
                for (int ct = 0; ct < 2; ++ct) { const bf16x8 bS = lds_frag(lds + ST, ct * 16 + fr, SRS, k4 * 64 + fq * 16);
                    av[ct] = __builtin_amdgcn_mfma_f32_16x16x32_bf16(cur.wA[k4], bS, av[ct], 0, 0, 0); ao[ct] = __builtin_amdgcn_mfma_f32_16x16x32_bf16(cur.qA[k4], bS, ao[ct], 0, 0, 0); }
#pragma unroll
            for (int ct = 0; ct < 2; ++ct) { u32x2 w; w.x = pk2(cur.u[ct][0] - av[ct][0], cur.u[ct][1] - av[ct][1]); w.y = pk2(cur.u[ct][2] - av[ct][2], cur.u[ct][3] - av[ct][3]);
                *(LAS u32x2*)(lds + VNT + (ct * 16 + fr) * VRS + (wave * 16 + fq * 4) * 2) = w; }
        }
        lds_barrier();
        if (act) {
#pragma unroll
            for (int ct = 0; ct < 2; ++ct) {
#pragma unroll
                for (int k2 = 0; k2 < 2; ++k2) { const bf16x8 bV = lds_frag(lds + VNT, ct * 16 + fr, VRS, k2 * 64 + fq * 16); ao[ct] = __builtin_amdgcn_mfma_f32_16x16x32_bf16(cur.iA[k2], bV, ao[ct], 0, 0, 0); }
#pragma unroll
                for (int jj = 0; jj < 4; ++jj) OB[((size_t)b * SEQ + n * 64 + wave * 16 + fq * 4 + jj) * 512 + h * 128 + sl * 32 + ct * 16 + fr] = ao[ct][jj];
            }
        }
        const float dec = __expf(cur.gl);
#pragma unroll
        for (int c2 = 0; c2 < 2; ++c2) {
            accS[c2] *= dec;
#pragma unroll
            for (int k2 = 0; k2 < 2; ++k2) { const bf16x8 bV = lds_frag(lds + VNT, c2 * 16 + fr, VRS, k2 * 64 + fq * 16); accS[c2] = __builtin_amdgcn_mfma_f32_16x16x32_bf16(cur.kA[k2], bV, accS[c2], 0, 0, 0); }
            u32x2 w; w.x = pk2(accS[c2][0], accS[c2][1]); w.y = pk2(accS[c2][2], accS[c2][3]);
            *(LAS u32x2*)(lds + ST + (c2 * 16 + fr) * SRS + (wave * 16 + fq * 4) * 2) = w;
        }
        lds_barrier();
    };
#define SCAN_STEP(n, CUR, NX2) do { if ((n) + 2 < 64) scan_load(NX2, CW, CQ, CKT, CU, CI, CGL, (size_t)bh * 64 + (n) + 2, act, wave, sl, lane); compute(CUR, (n)); } while (0)
    for (int n = 0; n < 63; n += 3) { SCAN_STEP(n, F0, F2); SCAN_STEP(n + 1, F1, F0); SCAN_STEP(n + 2, F2, F1); }
    SCAN_STEP(63, F0, F2);
#undef SCAN_STEP
    float* Sout = pout() + O_DP + (size_t)bh * 16384;
#pragma unroll
    for (int c2 = 0; c2 < 2; ++c2)
#pragma unroll
        for (int jj = 0; jj < 4; ++jj) Sout[(size_t)(wave * 16 + fq * 4 + jj) * 128 + sl * 32 + c2 * 16 + fr] = accS[c2][jj];
    __syncthreads();
}

DEV void phase_even_c(const Params& p, const bf16_t* P, const float* OB, bf16_t* MIX, int gw, int ngw, int lane) {
    const float* gn = pin(18); const float* wb = pin(19);
    float gnv[8], wbv[3][8];
#pragma unroll
    for (int e = 0; e < 8; ++e) { gnv[e] = gn[(lane * 8 + e) & 127];
#pragma unroll
        for (int j = 0; j < 3; ++j) wbv[j][e] = wb[j * 512 + lane * 8 + e]; }
    for (int tok = gw; tok < NT; tok += ngw) {
        int t, base; const float* buf = nullptr;
        if (tok < NP) { t = tok % SEQ; base = tok - t; } else { t = (tok - NP) % DSQ; base = tok - t; buf = pin(4) + (size_t)((tok - NP) / DSQ) * 2 * 512; }
        const int c0 = lane * 8;
        const f32x4 oa = __builtin_nontemporal_load((const f32x4*)(OB + (size_t)tok * 512 + c0)), ob = __builtin_nontemporal_load((const f32x4*)(OB + (size_t)tok * 512 + c0 + 4));
        const u32x4 zr = *(const u32x4*)(P + (size_t)tok * EV_N + 1536 + c0);
        const u32x4 br = *(const u32x4*)(P + (size_t)tok * EV_N + 2560 + c0);
        u32x4 hrs[3], crs[3];
#pragma unroll
        for (int j = 0; j < 3; ++j) { const int m = t - 2 + j;
            if (m >= 0) { hrs[j] = *(const u32x4*)(P + (size_t)(base + m) * EV_N + 2048 + c0); crs[j] = *(const u32x4*)(P + (size_t)(base + m) * EV_N + 3072 + c0); }
            else { hrs[j] = (u32x4){0u, 0u, 0u, 0u}; crs[j] = hrs[j]; } }
        {
            float o[8] = {oa.x, oa.y, oa.z, oa.w, ob.x, ob.y, ob.z, ob.w}; float ss = 0.f;
#pragma unroll
            for (int e = 0; e < 8; ++e) ss += o[e] * o[e];
            ss = sum16_(ss);
            const float r = rsqrtf(ss * (1.f / 128.f) + 1e-6f);
            const float z[8] = {bflo(zr.x), bfhi(zr.x), bflo(zr.y), bfhi(zr.y), bflo(zr.z), bfhi(zr.z), bflo(zr.w), bfhi(zr.w)};
            float w[8];
#pragma unroll
            for (int e = 0; e < 8; ++e) w[e] = o[e] * r * gnv[e] * siluf_(z[e]);
            u32x4 st; st.x = pk2(w[0], w[1]); st.y = pk2(w[2], w[3]); st.z = pk2(w[4], w[5]); st.w = pk2(w[6], w[7]);
            *(u32x4*)(MIX + (size_t)tok * D + c0) = st;
        }
        {
            float y[8], cxl[8];
#pragma unroll
            for (int e = 0; e < 8; ++e) { y[e] = 0.f; cxl[e] = 0.f; }
#pragma unroll
            for (int j = 0; j < 3; ++j) {
                const int m = t - 2 + j; float cx[8];
                if (m >= 0) { const u32x4 hr = hrs[j]; const u32x4 cr = crs[j];
                    cx[0] = bflo(hr.x) * bflo(cr.x); cx[1] = bfhi(hr.x) * bfhi(cr.x); cx[2] = bflo(hr.y) * bflo(cr.y); cx[3] = bfhi(hr.y) * bfhi(cr.y);
                    cx[4] = bflo(hr.z) * bflo(cr.z); cx[5] = bfhi(hr.z) * bfhi(cr.z); cx[6] = bflo(hr.w) * bflo(cr.w); cx[7] = bfhi(hr.w) * bfhi(cr.w); }
                else if (buf) {
#pragma unroll
                    for (int e = 0; e < 8; ++e) cx[e] = buf[(size_t)(2 + m) * 512 + c0 + e]; }
                else {
#pragma unroll
                    for (int e = 0; e < 8; ++e) cx[e] = 0.f; }
#pragma unroll
                for (int e = 0; e < 8; ++e) { y[e] += wbv[j][e] * cx[e]; cxl[e] = cx[e]; }
            }
            const float gb[8] = {bflo(br.x), bfhi(br.x), bflo(br.y), bfhi(br.y), bflo(br.z), bfhi(br.z), bflo(br.w), bfhi(br.w)};
            u32x4 st; st.x = pk2(gb[0] * y[0], gb[1] * y[1]); st.y = pk2(gb[2] * y[2], gb[3] * y[3]); st.z = pk2(gb[4] * y[4], gb[5] * y[5]); st.w = pk2(gb[6] * y[6], gb[7] * y[7]);
            *(u32x4*)(MIX + (size_t)tok * D + 512 + c0) = st;
            if (tok < NP) { if (t >= SEQ - 2) {
#pragma unroll
                for (int e = 0; e < 8; ++e) pout()[O_CBP + (size_t)((tok / SEQ) * 2 + (t - (SEQ - 2))) * 512 + c0 + e] = cxl[e]; } }
            else if (t >= DSQ - 2) {
#pragma unroll
                for (int e = 0; e < 8; ++e) pout()[O_CBS + (size_t)(((tok - NP) / DSQ) * 2 + (t - (DSQ - 2))) * 512 + c0 + e] = cxl[e]; }
        }
    }
}

DEV void phase_odd_a(const Params& p, const bf16_t* P, const float* EXT, float* GATES, bf16_t* UG, bf16_t* VLN, int gw, int ngw, int lane, int tok_end) {
    const float* ln_g = pin(27); const float* ln_b = pin(28);
    float* out = pout();
    const f32x4 g0 = *(const f32x4*)(ln_g + lane * 8), g1 = *(const f32x4*)(ln_g + lane * 8 + 4), b0 = *(const f32x4*)(ln_b + lane * 8), b1 = *(const f32x4*)(ln_b + lane * 8 + 4);
    for (int tok = gw; tok < tok_end; tok += ngw) {
        const int c0 = lane * 8;
        const float ext = lane < 24 ? EXT[(size_t)tok * 24 + lane] : 0.f;
        u32x4 ka = {0u, 0u, 0u, 0u}, kb_ = ka;
        if (lane < 48) { ka = *(const u32x4*)(P + (size_t)tok * OD_N + 512 + lane * 16); kb_ = *(const u32x4*)(P + (size_t)tok * OD_N + 512 + lane * 16 + 8); }
        const u32x4 ur = *(const u32x4*)(P + (size_t)tok * OD_N + 1280 + c0); const u32x4 vr = *(const u32x4*)(P + (size_t)tok * OD_N + 1792 + c0);
        if (lane < 24) GATES[(size_t)tok * 24 + lane] = sigmoidf_(ext);
        if (lane < 48) {
            const int br = lane >> 4, idx = (lane & 15) * 16;
            float* dst = nullptr;
            if (tok < NP) { const int t = tok % SEQ;
                if (br == 0) dst = out + O_CMP + (size_t)tok * 256 + idx;
                else if (br == 1) dst = out + O_SLP + (size_t)tok * 256 + idx;
                else if (t >= SEQ - 512) dst = out + O_WNP + ((size_t)(tok / SEQ) * 512 + (t - (SEQ - 512))) * 256 + idx;
            } else { const int s = tok - NP;
                if (br == 0) dst = out + O_CMS + (size_t)s * 256 + idx;
                else if (br == 1) dst = out + O_SLS + (size_t)s * 256 + idx;
                else dst = out + O_WNS + ((size_t)(s / DSQ) * 512 + 504 + (s % DSQ)) * 256 + idx; }
            if (dst) { const u32x4 a = ka, b = kb_;
                __builtin_nontemporal_store((f32x4){bflo(a.x), bfhi(a.x), bflo(a.y), bfhi(a.y)}, (f32x4*)dst); __builtin_nontemporal_store((f32x4){bflo(a.z), bfhi(a.z), bflo(a.w), bfhi(a.w)}, (f32x4*)dst + 1);
                __builtin_nontemporal_store((f32x4){bflo(b.x), bfhi(b.x), bflo(b.y), bfhi(b.y)}, (f32x4*)dst + 2); __builtin_nontemporal_store((f32x4){bflo(b.z), bfhi(b.z), bflo(b.w), bfhi(b.w)}, (f32x4*)dst + 3); }
        }
        const float uu[8] = {bflo(ur.x), bfhi(ur.x), bflo(ur.y), bfhi(ur.y), bflo(ur.z), bfhi(ur.z), bflo(ur.w), bfhi(ur.w)};
        float vv[8] = {bflo(vr.x), bfhi(vr.x), bflo(vr.y), bfhi(vr.y), bflo(vr.z), bfhi(vr.z), bflo(vr.w), bfhi(vr.w)};
        float s = 0.f, ug[8];
#pragma unroll
        for (int e = 0; e < 8; ++e) { ug[e] = geluf_(uu[e]); vv[e] = geluf_(vv[e]); s += vv[e]; }
        { u32x4 w; w.x = pk2(ug[0], ug[1]); w.y = pk2(ug[2], ug[3]); w.z = pk2(ug[4], ug[5]); w.w = pk2(ug[6], ug[7]); *(u32x4*)(UG + (size_t)tok * 512 + c0) = w; }
        const float mu = wave_sum(s) * (1.f / 512.f); float q = 0.f;
#pragma unroll
        for (int e = 0; e < 8; ++e) { vv[e] -= mu; q += vv[e] * vv[e]; }
        const float r = rsqrtf(wave_sum(q) * (1.f / 512.f) + 1e-6f);
        const f32x4 o0 = (f32x4){vv[0], vv[1], vv[2], vv[3]} * r * g0 + b0, o1 = (f32x4){vv[4], vv[5], vv[6], vv[7]} * r * g1 + b1;
        { u32x4 w; w.x = pk2(o0[0], o0[1]); w.y = pk2(o0[2], o0[3]); w.z = pk2(o1[0], o1[1]); w.w = pk2(o1[2], o1[3]); *(u32x4*)(VLN + (size_t)tok * 512 + c0) = w; }
        if (tok >= NP) { ((f32x4*)(out + O_DV + (size_t)(tok - NP) * 512 + c0))[0] = o0; ((f32x4*)(out + O_DV + (size_t)(tok - NP) * 512 + c0))[1] = o1; }
    }
}
constexpr unsigned WINCOPY_N4 = 128u * 504u * 64u;
DEV void phase_win_copy(unsigned lo, unsigned hi) {
    const int tid = opaque_tid();
    const float* src_ = pin(7); float* out = pout();
    const unsigned n4 = hi;
    const unsigned step = NTHR;
    unsigned i0 = lo + tid;
    for (; i0 + 7u * step < n4; i0 += 8u * step) {
        f32x4 v[8];
#pragma unroll
        for (int u = 0; u < 8; ++u) { const unsigned i = i0 + u * step; const unsigned db = i / (504u * 64u), r = i % (504u * 64u); v[u] = __builtin_nontemporal_load((const f32x4*)(src_ + (size_t)db * 512 * 256 + 8 * 256) + r); }
#pragma unroll
        for (int u = 0; u < 8; ++u) { const unsigned i = i0 + u * step; const unsigned db = i / (504u * 64u), r = i % (504u * 64u); __builtin_nontemporal_store(v[u], (f32x4*)(out + O_WNS + (size_t)db * 512 * 256) + r); }
    }
    for (; i0 < n4; i0 += step) { const unsigned db = i0 / (504u * 64u), r = i0 % (504u * 64u); ((f32x4*)(out + O_WNS + (size_t)db * 512 * 256))[r] = ((const f32x4*)(src_ + (size_t)db * 512 * 256 + 8 * 256))[r]; }
}

DEV void phase_vtp(const bf16_t* P, bf16_t* VTP, LAS unsigned char* lds) {
    const int tid = opaque_tid();
    for (int item = blockIdx.x; item < 256; item += gridDim.x) {
        const int seq = item >> 6, tb = item & 63;
        { const int tok = tid >> 3, part = tid & 7, v = part >> 1, half = part & 1;
          const bf16_t* src_ = P + ((size_t)seq * SEQ + tb * 64 + tok) * OD_N + 512 + ((v >> 1) + 1) * 256 + 128 + (v & 1) * 64 + half * 32;
#pragma unroll
          for (int i = 0; i < 4; ++i) { const u32x4 w = *(const u32x4*)(src_ + i * 8); const unsigned ww[4] = {w.x, w.y, w.z, w.w};
#pragma unroll
              for (int e = 0; e < 4; ++e) { const int dh = half * 32 + i * 8 + 2 * e;
                  *(LAS bf16_t*)(lds + ((v * 64 + dh) * 72 + tok) * 2) = (bf16_t)(ww[e] & 0xffffu); *(LAS bf16_t*)(lds + ((v * 64 + dh + 1) * 72 + tok) * 2) = (bf16_t)(ww[e] >> 16); } } }
        lds_barrier();
#pragma unroll
        for (int i = 0; i < 4; ++i) { const int id = tid + i * 512, v = id >> 9, dh = (id >> 3) & 63, sg = id & 7;
            *(u32x4*)(VTP + ((size_t)(((v >> 1) * 4 + seq) * 2 + (v & 1)) * 64 + dh) * SEQ + tb * 64 + sg * 8) = *(const LAS u32x4*)(lds + ((v * 64 + dh) * 72 + sg * 8) * 2); }
        lds_barrier();
    }
}

struct RowRef { const float* f; const bf16_t* h; };
DEV float rr_get(const RowRef& r, int d) { return r.f ? r.f[d] : bf2f(r.h[d]); }
DEV RowRef kv_row(const Params& p, const bf16_t* P, int seqidx, int br, int kv, int g, int pos) {
    RowRef r; r.f = nullptr; r.h = nullptr;
    const int co = 512 + br * 256 + kv * 128 + g * 64;
    if (seqidx < 4) { r.h = P + ((size_t)seqidx * SEQ + pos) * OD_N + co; return r; }
    const int db = seqidx - 4;
    if (pos >= PAST) { r.h = P + ((size_t)NP + db * DSQ + (pos - PAST)) * OD_N + co; return r; }
    if (br == 2) { r.f = pin(7) + ((((size_t)db * 512 + (pos - (PAST - 512))) * 2 + kv) * 2 + g) * 64; return r; }
    const int page = ppt()[db * 16 + (pos >> 7)];
    r.f = (br == 0 ? pin(5) : pin(6)) + ((((size_t)page * 128 + (pos & 127)) * 2 + kv) * 2 + g) * 64;
    return r;
}
DEV size_t vct_off(int seqidx, int g) { return seqidx < 4 ? (size_t)(seqidx * 2 + g) * 64 * 256 : (size_t)4 * 2 * 64 * 256 + (size_t)((seqidx - 4) * 2 + g) * 64 * 128; }
DEV size_t kc_off(int seqidx, int g, int j) { return seqidx < 4 ? ((size_t)(seqidx * 2 + g) * 256 + j) * 64 : ((size_t)4 * 2 * 256 + (size_t)((seqidx - 4) * 2 + g) * 128 + j) * 64; }

DEV void phase_compress_naive(const Params& p, const bf16_t* P, float* KCF, LAS unsigned char* lds, int gw, int ngw, int lane, int wave) {
    LAS float* hid = (LAS float*)lds + wave * 128;
    const float* pe = pin(22); const float* w1 = pin(23); const float* w2 = pin(24);
    const int n_p = 4 * 2 * 255 * 2, n_s = 128 * 2 * 127 * 2;
    for (int it = gw; it < n_p + n_s; it += ngw) {
        int seqidx, g, j, kv;
        if (it < n_p) { kv = it & 1; int r = it >> 1; j = r % 255; r /= 255; g = r & 1; seqidx = r >> 1; }
        else { int r = it - n_p; kv = r & 1; r >>= 1; j = r % 127; r /= 127; g = r & 1; seqidx = 4 + (r >> 1); }
        float a0 = 0.f, a1 = 0.f;
        for (int s = 0; s < 32; ++s) {
            const RowRef rr = kv_row(p, P, seqidx, 0, kv, g, 16 * j + s);
            for (int d = 0; d < 64; ++d) {
                const float x = rr_get(rr, d) + pe[(size_t)(kv * 32 + s) * 64 + d];
                const float* wr_ = w1 + ((size_t)(kv * 32 + s) * 64 + d) * 128;
                a0 += x * wr_[lane]; a1 += x * wr_[lane + 64];
            }
        }
        hid[lane] = siluf_(a0); hid[lane + 64] = siluf_(a1);
        asm volatile("s_waitcnt lgkmcnt(0)" ::: "memory");
        float o = 0.f;
        for (int h = 0; h < 128; ++h) o += hid[h] * w2[(size_t)kv * 8192 + h * 64 + lane];
        KCF[(size_t)kv * KC_ELEMS + kc_off(seqidx, g, j) + lane] = o;
        asm volatile("s_waitcnt lgkmcnt(0)" ::: "memory");
    }
}

DEV void phase_attn_naive(const Params& p, const bf16_t* P, const float* KCF, const float* GATES, bf16_t* MIX, LAS unsigned char* lds, int gw, int ngw, int lane, int wave) {
    LAS float* qs = (LAS float*)lds + wave * 1216;
    LAS float* pbuf = qs + 64;
    LAS float* pc = pbuf + 1024;
    LAS int* blk = (LAS int*)pc;
    const float NEG = -1e30f;
    for (int it = gw; it < 4 * 2 * SEQ + 128 * 2 * DSQ; it += ngw) {
        int seqidx, g, ti, qpos, tok, nc, ns, wstart;
        if (it < 4 * 2 * SEQ) { ti = it % SEQ; const int r = it / SEQ; g = r & 1; seqidx = r >> 1; qpos = ti; tok = seqidx * SEQ + ti; nc = 255; ns = 64; wstart = 0; }
        else { const int r0 = it - 4 * 2 * SEQ; ti = r0 % DSQ; const int r = r0 / DSQ; g = r & 1; seqidx = 4 + (r >> 1); qpos = PAST + ti; tok = NP + (seqidx - 4) * DSQ + ti; nc = 127; ns = 33; wstart = PAST - 512; }
        const int cur = qpos >> 6;
        float imp = 0.f; float oc[4];
        for (int r = 0; r < 4; ++r) {
            const int h = g * 4 + r; const float slope = exp2f(-(float)(h + 1));
            qs[lane] = bf2f(P[(size_t)tok * OD_N + h * 64 + lane]) * 0.125f;
            asm volatile("s_waitcnt lgkmcnt(0)" ::: "memory");
            float sc[4]; float mx = NEG;
            for (int jj = 0; jj < 4; ++jj) { const int j = jj * 64 + lane; const bool ok = j < nc && 16 * j + 31 <= qpos; float s = NEG;
                if (ok) { const float* kr = KCF + kc_off(seqidx, g, j); s = 0.f; for (int d = 0; d < 64; ++d) s += qs[d] * kr[d]; s -= slope * (float)(qpos - (16 * j + 31)); }
                sc[jj] = s; mx = fmaxf(mx, s); }
            for (int o = 1; o < 64; o <<= 1) mx = fmaxf(mx, __shfl_xor(mx, o));
            float sum = 0.f;
            for (int jj = 0; jj < 4; ++jj) { sc[jj] = sc[jj] > -1e29f ? __expf(sc[jj] - mx) : 0.f; sum += sc[jj]; }
            sum = fmaxf(wave_sum(sum), 1e-30f);
            for (int jj = 0; jj < 4; ++jj) pbuf[jj * 64 + lane] = sc[jj] / sum;
            asm volatile("s_waitcnt lgkmcnt(0)" ::: "memory");
            float o = 0.f;
            for (int j = 0; j < nc; ++j) o += pbuf[j] * KCF[KC_ELEMS + kc_off(seqidx, g, j) + lane];
            oc[r] = o;
            for (int j = 4 * lane - 1; j <= 4 * lane + 3; ++j) if (j >= 0 && j < nc) {
                const int lo = max(16 * j, 64 * lane), hi = min(16 * j + 32, 64 * lane + 64); if (hi > lo) imp += pbuf[j] * ((float)(hi - lo) * (1.f / 32.f)); }
            asm volatile("s_waitcnt lgkmcnt(0)" ::: "memory");
        }
        const bool valid = lane < ns && lane <= cur; const bool forced = lane == 0 || lane == cur || lane == cur - 1;
        const float score = valid ? (forced ? 1e4f : imp) : NEG;
        int rank = 0;
        for (int s2 = 0; s2 < ns; ++s2) { const float o = __shfl(score, s2); rank += (o > score || (o == score && s2 < lane)) ? 1 : 0; }
        const unsigned long long selmask = __ballot(valid && rank < 16);
        if (lane == 0) { int n = 0; for (int s2 = 0; s2 < 64; ++s2) if ((selmask >> s2) & 1ull) blk[n++] = s2; for (; n < 16; ++n) blk[n] = -1; }
        asm volatile("s_waitcnt lgkmcnt(0)" ::: "memory");
        const int nsel = __popcll(selmask);
        for (int r = 0; r < 4; ++r) {
            const int h = g * 4 + r; const float slope = exp2f(-(float)(h + 1));
            qs[lane] = bf2f(P[(size_t)tok * OD_N + h * 64 + lane]) * 0.125f;
            asm volatile("s_waitcnt lgkmcnt(0)" ::: "memory");
            float res[2];
            for (int brn = 1; brn <= 2; ++brn) {
                const int wlo = max(wstart, qpos - 511);
                const int nkeys = brn == 1 ? nsel * 64 : (qpos - wlo + 1);
                float mx = NEG;
                for (int i0 = 0; i0 < nkeys; i0 += 64) { const int i = i0 + lane; float s = NEG;
                    if (i < nkeys) { const int pos = brn == 1 ? blk[i >> 6] * 64 + (i & 63) : wlo + i;
                        if (pos <= qpos) { const RowRef kr = kv_row(p, P, seqidx, brn, 0, g, pos); s = 0.f; for (int d = 0; d < 64; ++d) s += qs[d] * rr_get(kr, d); s -= slope * (float)(qpos - pos); } }
                    if (i < 1024) pbuf[i] = s; mx = fmaxf(mx, s); }
                for (int o = 1; o < 64; o <<= 1) mx = fmaxf(mx, __shfl_xor(mx, o));
                asm volatile("s_waitcnt lgkmcnt(0)" ::: "memory");
                float sum = 0.f;
                for (int i0 = 0; i0 < nkeys; i0 += 64) { const int i = i0 + lane; if (i < nkeys) { const float s = pbuf[i]; const float e = s > -1e29f ? __expf(s - mx) : 0.f; pbuf[i] = e; sum += e; } }
                sum = fmaxf(wave_sum(sum), 1e-30f);
                asm volatile("s_waitcnt lgkmcnt(0)" ::: "memory");
                float o = 0.f;
                for (int i = 0; i < nkeys; ++i) { const float e = pbuf[i]; if (e != 0.f) { const int pos = brn == 1 ? blk[i >> 6] * 64 + (i & 63) : wlo + i; const RowRef vr = kv_row(p, P, seqidx, brn, 1, g, pos); o += e * rr_get(vr, lane); } }
                res[brn - 1] = o / sum;
                asm volatile("s_waitcnt lgkmcnt(0)" ::: "memory");
            }
            const float* gt = GATES + (size_t)tok * 24 + h * 3;
            MIX[(size_t)tok * D + h * 64 + lane] = (bf16_t)f2bf(gt[0] * oc[r] + gt[1] * res[0] + gt[2] * res[1]);
        }
    }
}

template <bool SMP>
DEV void phase_compress(const Params& p, const bf16_t* P, unsigned char* ws, LAS unsigned char* lds, int first, int stride, int item_end) {
    constexpr int CA0 = 0, CA1 = 17920, PB = 35840, HID = 68608, ARS = 272;
    const int tid = opaque_tid(), lane = tid & 63, wave = __builtin_amdgcn_readfirstlane(tid >> 6), fr = lane & 15, fq = lane >> 4;
    const bf16_t* W1t = (const bf16_t*)(ws + WS_WC1); const bf16_t* W2t = (const bf16_t*)(ws + WS_WC2); const float* cb = (const float*)(ws + WS_CBIAS);
    const int srow = tid >> 3, piece = tid & 7, sl = piece >> 2, d0 = (piece & 3) * 16;
    const int q16 = tid & 15, segid = tid >> 4, slS = segid & 1, rS = segid >> 1;
    const int colbase = (wave < 4 ? 32 * wave : 128 + 32 * (wave - 4)), shift = wave < 4 ? 0 : 1;
    const bf16_t* W1w = W1t + ((size_t)colbase + fr) * 1024 + fq * 8;
    auto loadB = [&](bf16x8 (&bb)[4][2], int kvsel, int c8) {
#pragma unroll
        for (int k4 = 0; k4 < 4; ++k4)
#pragma unroll
            for (int ct = 0; ct < 2; ++ct) bb[k4][ct] = *(const bf16x8*)(W1w + ((size_t)kvsel * 256 + ct * 16) * 1024 + c8 * 128 + k4 * 32);
    };
    bf16x8 bA[4][2], bB[4][2];
    if (first < item_end) loadB(bA, first & 1, 0);
    for (int item = first; item < item_end; item += stride) {
        int kv, g, nb, seqidx, nh;
        if (!SMP) { kv = item & 1; g = (item >> 1) & 1; nb = (item >> 2) & 3; seqidx = item >> 4; nh = 256; }
        else { const int i2 = item - 64; kv = i2 & 1; g = (i2 >> 1) & 1; nb = (i2 >> 2) & 1; seqidx = 4 + (i2 >> 3); nh = 128; }
        const int nc = nh - 1;
        f32x4 acc[4][2];
#pragma unroll
        for (int rt = 0; rt < 4; ++rt)
#pragma unroll
            for (int ct = 0; ct < 2; ++ct) acc[rt][ct] = (f32x4){0.f, 0.f, 0.f, 0.f};
        auto mm = [&](LAS unsigned char* buf, bf16x8 (&bc)[4][2]) {
#pragma unroll
            for (int k4 = 0; k4 < 4; ++k4) {
#pragma unroll
                for (int rt = 0; rt < 4; ++rt) { const bf16x8 a = lds_frag(buf, rt * 16 + fr + shift, ARS, k4 * 64 + fq * 16);
#pragma unroll
                    for (int ct = 0; ct < 2; ++ct) acc[rt][ct] = __builtin_amdgcn_mfma_f32_16x16x32_bf16(a, bc[k4][ct], acc[rt][ct], 0, 0, 0); }
            }
        };
        if constexpr (SMP) {
            int pg[4];
#pragma unroll
            for (int i = 0; i < 4; ++i) pg[i] = ppt()[(seqidx - 4) * 16 + ((nb * 64 + i * 16 + rS) >> 3)];
            const bool has_e = nb * 64 + 64 < nh;
            const int page_e = has_e ? ppt()[(seqidx - 4) * 16 + ((nb * 64 + 64) >> 3)] : 0;
            const float* cbase = pin(5) + (size_t)(kv * 2 + g) * 64 + 4 * q16;
            auto fetchS = [&](int c8, f32x4 (&v)[4], f32x4& ve) {
                const int tap = 2 * c8 + slS;
#pragma unroll
                for (int i = 0; i < 4; ++i) { const int pos = 16 * (nb * 64 + i * 16 + rS) + tap; v[i] = *(const f32x4*)(cbase + ((size_t)pg[i] * 128 + (pos & 127)) * 256); }
                if (tid < 32) { if (has_e) { const int pos = 16 * (nb * 64 + 64) + tap; ve = *(const f32x4*)(cbase + ((size_t)page_e * 128 + (pos & 127)) * 256); } else ve = (f32x4){0.f, 0.f, 0.f, 0.f}; }
            };
            f32x4 ra[4], rb[4], ea, eb;
            fetchS(0, ra, ea); fetchS(1, rb, eb);
            auto chunkS = [&](int c8, f32x4 (&v)[4], f32x4& ve, bf16x8 (&bc)[4][2], bf16x8 (&bn)[4][2]) {
                LAS unsigned char* buf = lds + ((c8 & 1) ? CA1 : CA0);
#pragma unroll
                for (int i = 0; i < 4; ++i) { u32x2 w; w.x = pk2(v[i].x, v[i].y); w.y = pk2(v[i].z, v[i].w); *(LAS u32x2*)(buf + (i * 16 + rS) * ARS + (slS * 64 + 4 * q16) * 2) = w; }
                if (tid < 32) { u32x2 w; w.x = pk2(ve.x, ve.y); w.y = pk2(ve.z, ve.w); *(LAS u32x2*)(buf + 64 * ARS + (slS * 64 + 4 * q16) * 2) = w; }
                lds_barrier();
                if (c8 + 2 < 8) fetchS(c8 + 2, v, ve);
                loadB(bn, c8 == 7 ? ((item + stride) & 1) : kv, (c8 + 1) & 7);
                mm(buf, bc);
            };
            for (int c8 = 0; c8 < 8; c8 += 2) { chunkS(c8, ra, ea, bA, bB); chunkS(c8 + 1, rb, eb, bB, bA); }
        } else {
            auto fetchA = [&](int c8, int row, u32x4& o0, u32x4& o1) {
                const int n = nb * 64 + row;
                if (n >= nh) { o0 = (u32x4){0u, 0u, 0u, 0u}; o1 = o0; return; }
                const int pos = 16 * n + 2 * c8 + sl;
                const bf16_t* src_ = P + ((size_t)seqidx * SEQ + pos) * OD_N + 512 + kv * 128 + g * 64 + d0; o0 = *(const u32x4*)src_; o1 = *(const u32x4*)(src_ + 8);
            };
            u32x4 r0, r1, e0, e1, s0, s1, f0, f1;
            fetchA(0, srow, r0, r1); if (tid < 8) fetchA(0, 64, e0, e1);
            fetchA(1, srow, s0, s1); if (tid < 8) fetchA(1, 64, f0, f1);
            auto chunk = [&](int c8, u32x4& q0, u32x4& q1, u32x4& x0, u32x4& x1, bf16x8 (&bc)[4][2], bf16x8 (&bn)[4][2]) {
                LAS unsigned char* buf = lds + ((c8 & 1) ? CA1 : CA0);
                *(LAS u32x4*)(buf + srow * ARS + (sl * 64 + d0) * 2) = q0; *(LAS u32x4*)(buf + srow * ARS + (sl * 64 + d0) * 2 + 16) = q1;
                if (tid < 8) { *(LAS u32x4*)(buf + 64 * ARS + (sl * 64 + d0) * 2) = x0; *(LAS u32x4*)(buf + 64 * ARS + (sl * 64 + d0) * 2 + 16) = x1; }
                lds_barrier();
                if (c8 + 2 < 8) { fetchA(c8 + 2, srow, q0, q1); if (tid < 8) fetchA(c8 + 2, 64, x0, x1); }
                loadB(bn, c8 == 7 ? ((item + stride) & 1) : kv, (c8 + 1) & 7);
                mm(buf, bc);
            };
            for (int c8 = 0; c8 < 8; c8 += 2) { chunk(c8, r0, r1, e0, e1, bA, bB); chunk(c8 + 1, s0, s1, f0, f1, bB, bA); }
        }
        lds_barrier();
        LAS float* PBm = (LAS float*)(lds + PB);
        if (wave >= 4) {
#pragma unroll
            for (int rt = 0; rt < 4; ++rt)
#pragma unroll
                for (int ct = 0; ct < 2; ++ct)
#pragma unroll
                    for (int jj = 0; jj < 4; ++jj) PBm[(rt * 16 + fq * 4 + jj) * 128 + 32 * (wave - 4) + ct * 16 + fr] = acc[rt][ct][jj];
        }
        lds_barrier();
        if (wave < 4) {
#pragma unroll
            for (int rt = 0; rt < 4; ++rt)
#pragma unroll
                for (int ct = 0; ct < 2; ++ct) { const int hc = 32 * wave + ct * 16 + fr; const float bia = cb[kv * 128 + hc];
#pragma unroll
                    for (int jj = 0; jj < 4; ++jj) { const int i = rt * 16 + fq * 4 + jj;
                        *(LAS bf16_t*)(lds + HID + i * ARS + hc * 2) = (bf16_t)f2bf(siluf_(acc[rt][ct][jj] + PBm[i * 128 + hc] + bia)); } }
        }
        lds_barrier();
        {
            const int rt = wave >> 1;
            bf16_t* OUT = (bf16_t*)(ws + (kv == 0 ? WS_KC : WS_VC));
#pragma unroll
            for (int ti = 0; ti < 2; ++ti) { const int ct2 = (wave & 1) * 2 + ti; f32x4 a2 = {0.f, 0.f, 0.f, 0.f};
#pragma unroll
                for (int k4 = 0; k4 < 4; ++k4) { const bf16x8 a = lds_frag(lds + HID, rt * 16 + fr, ARS, k4 * 64 + fq * 16);
                    const bf16x8 b = *(const bf16x8*)(W2t + ((size_t)kv * 64 + ct2 * 16 + fr) * 128 + k4 * 32 + fq * 8);
                    a2 = __builtin_amdgcn_mfma_f32_16x16x32_bf16(a, b, a2, 0, 0, 0); }
                if (kv == 0) {
#pragma unroll
                    for (int jj = 0; jj < 4; ++jj) { const int j = nb * 64 + rt * 16 + fq * 4 + jj; if (j < nc) OUT[kc_off(seqidx, g, j) + ct2 * 16 + fr] = (bf16_t)f2bf(a2[jj]); }
                } else {
                    const int j0 = nb * 64 + rt * 16 + fq * 4;
                    u32x2 w; w.x = pk2(a2[0], a2[1]); w.y = pk2(a2[2], j0 + 3 < nc ? a2[3] : 0.f);
                    *(u32x2*)(OUT + vct_off(seqidx, g) + (size_t)(ct2 * 16 + fr) * nh + j0) = w;
                } }
        }
        lds_barrier();
    }
}

DEV void phase_compress_s(const Params& p, unsigned char* ws, LAS unsigned char* lds, int first, int stride, int item_end) {
    constexpr int CA0 = 0, CA1 = 18688, PB = 0, PBS = 132, HID = 67584, ARS = 144, HRS = 272;
    const int tid = opaque_tid(), lane = tid & 63, wave = __builtin_amdgcn_readfirstlane(tid >> 6), fr = lane & 15, fq = lane >> 4;
    const bf16_t* W1t = (const bf16_t*)(ws + WS_WC1); const bf16_t* W2t = (const bf16_t*)(ws + WS_WC2); const float* cb = (const float*)(ws + WS_CBIAS);
    const int q16 = tid & 15, r32 = tid >> 4;
    const int colbase = (wave < 4 ? 32 * wave : 128 + 32 * (wave - 4)), shift = wave < 4 ? 0 : 1;
    const bf16_t* W1w = W1t + ((size_t)colbase + fr) * 1024 + fq * 8;
    auto loadB = [&](bf16x8 (&bb)[2][2], int kvsel, int c16) {
#pragma unroll
        for (int k2 = 0; k2 < 2; ++k2)
#pragma unroll
            for (int ct = 0; ct < 2; ++ct) bb[k2][ct] = *(const bf16x8*)(W1w + ((size_t)kvsel * 256 + ct * 16) * 1024 + c16 * 64 + k2 * 32);
    };
    bf16x8 bA[2][2], bB[2][2];
    if (first < item_end) loadB(bA, first & 1, 0);
    if (tid < 18) { *(LAS u32x2*)(lds + CA0 + 128 * ARS + tid * 8) = (u32x2){0u, 0u}; *(LAS u32x2*)(lds + CA1 + 128 * ARS + tid * 8) = (u32x2){0u, 0u}; }
    for (int item = first; item < item_end; item += stride) {
        const int kv = item & 1, g = (item >> 1) & 1, seqidx = 4 + (item >> 2);
        constexpr int nh = 128, nc = 127;
        f32x4 acc[8][2];
#pragma unroll
        for (int rt = 0; rt < 8; ++rt)
#pragma unroll
            for (int ct = 0; ct < 2; ++ct) acc[rt][ct] = (f32x4){0.f, 0.f, 0.f, 0.f};
        int pg[4];
#pragma unroll
        for (int i = 0; i < 4; ++i) pg[i] = ppt()[(seqidx - 4) * 16 + ((i * 32 + r32) >> 3)];
        const float* cbase = pin(5) + (size_t)(kv * 2 + g) * 64 + 4 * q16;
        auto fetchS = [&](int c16, f32x4 (&v)[4]) {
#pragma unroll
            for (int i = 0; i < 4; ++i) { const int pos = 16 * (i * 32 + r32) + c16; v[i] = __builtin_nontemporal_load((const f32x4*)(cbase + ((size_t)pg[i] * 128 + (pos & 127)) * 256)); }
        };
        f32x4 ra[4], rb[4], rc[4];
        fetchS(0, ra); fetchS(1, rb); fetchS(2, rc);
        auto chunkS = [&](int c16, f32x4 (&v)[4], bf16x8 (&bc)[2][2], bf16x8 (&bn)[2][2]) {
            LAS unsigned char* buf = lds + ((c16 & 1) ? CA1 : CA0);
#pragma unroll
            for (int i = 0; i < 4; ++i) { u32x2 w; w.x = pk2(v[i].x, v[i].y); w.y = pk2(v[i].z, v[i].w); *(LAS u32x2*)(buf + (i * 32 + r32) * ARS + q16 * 8) = w; }
            lds_barrier();
            if (c16 + 3 < 16) fetchS(c16 + 3, v);
            loadB(bn, c16 == 15 ? ((item + stride) & 1) : kv, (c16 + 1) & 15);
#pragma unroll
            for (int k2 = 0; k2 < 2; ++k2) {
#pragma unroll
                for (int rt = 0; rt < 8; ++rt) { const bf16x8 a = lds_frag(buf, rt * 16 + fr + shift, ARS, k2 * 64 + fq * 16);
#pragma unroll
                    for (int ct = 0; ct < 2; ++ct) acc[rt][ct] = __builtin_amdgcn_mfma_f32_16x16x32_bf16(a, bc[k2][ct], acc[rt][ct], 0, 0, 0);
                    if ((rt & 3) == 3) __builtin_amdgcn_sched_barrier(0); }
            }
        };
        chunkS(0, ra, bA, bB); chunkS(1, rb, bB, bA); chunkS(2, rc, bA, bB); chunkS(3, ra, bB, bA); chunkS(4, rb, bA, bB); chunkS(5, rc, bB, bA); chunkS(6, ra, bA, bB); chunkS(7, rb, bB, bA);
        chunkS(8, rc, bA, bB); chunkS(9, ra, bB, bA); chunkS(10, rb, bA, bB); chunkS(11, rc, bB, bA); chunkS(12, ra, bA, bB); chunkS(13, rb, bB, bA); chunkS(14, rc, bA, bB); chunkS(15, ra, bB, bA);
        lds_barrier();
        LAS float* PBm = (LAS float*)(lds + PB);
        if (wave >= 4) {
#pragma unroll
            for (int rt = 0; rt < 8; ++rt)
#pragma unroll
                for (int ct = 0; ct < 2; ++ct)
#pragma unroll
                    for (int jj = 0; jj < 4; ++jj) PBm[(rt * 16 + fq * 4 + jj) * PBS + 32 * (wave - 4) + ct * 16 + fr] = acc[rt][ct][jj];
        }
        lds_barrier();
        if (wave < 4) {
#pragma unroll
            for (int rt = 0; rt < 8; ++rt)
#pragma unroll
                for (int ct = 0; ct < 2; ++ct) { const int hc = 32 * wave + ct * 16 + fr; const float bia = cb[kv * 128 + hc];
#pragma unroll
                    for (int jj = 0; jj < 4; ++jj) { const int i = rt * 16 + fq * 4 + jj;
                        *(LAS bf16_t*)(lds + HID + i * HRS + hc * 2) = (bf16_t)f2bf(siluf_(acc[rt][ct][jj] + PBm[i * PBS + hc] + bia)); } }
        }
        lds_barrier();
        {
            const int rt = wave;
            bf16_t* OUT = (bf16_t*)(ws + (kv == 0 ? WS_KC : WS_VC));
#pragma unroll
            for (int ct2 = 0; ct2 < 4; ++ct2) { f32x4 a2 = {0.f, 0.f, 0.f, 0.f};
#pragma unroll
                for (int k4 = 0; k4 < 4; ++k4) { const bf16x8 a = lds_frag(lds + HID, rt * 16 + fr, HRS, k4 * 64 + fq * 16);
                    const bf16x8 b = *(const bf16x8*)(W2t + ((size_t)kv * 64 + ct2 * 16 + fr) * 128 + k4 * 32 + fq * 8);
                    a2 = __builtin_amdgcn_mfma_f32_16x16x32_bf16(a, b, a2, 0, 0, 0); }
                if (kv == 0) {
#pragma unroll
                    for (int jj = 0; jj < 4; ++jj) { const int j = rt * 16 + fq * 4 + jj; if (j < nc) OUT[kc_off(seqidx, g, j) + ct2 * 16 + fr] = (bf16_t)f2bf(a2[jj]); }
                } else {
                    const int j0 = rt * 16 + fq * 4;
                    u32x2 w; w.x = pk2(a2[0], a2[1]); w.y = pk2(a2[2], j0 + 3 < nc ? a2[3] : 0.f);
                    *(u32x2*)(OUT + vct_off(seqidx, g) + (size_t)(ct2 * 16 + fr) * nh + j0) = w;
                } }
        }
        lds_barrier();
        if (tid < 18) { *(LAS u32x2*)(lds + CA0 + 128 * ARS + tid * 8) = (u32x2){0u, 0u}; *(LAS u32x2*)(lds + CA1 + 128 * ARS + tid * 8) = (u32x2){0u, 0u}; }
    }
    lds_barrier();
}

struct KVRegs { u32x4 k, v; };
DEV u32x4 load8(const RowRef& r, int seg) {
    if (r.h) return *(const u32x4*)(r.h + seg * 8);
    if (r.f) { const f32x4 a = *(const f32x4*)(r.f + seg * 8), b = *(const f32x4*)(r.f + seg * 8 + 4); u32x4 o; o.x = pk2(a.x, a.y); o.y = pk2(a.z, a.w); o.z = pk2(b.x, b.y); o.w = pk2(b.z, b.w); return o; }
    return (u32x4){0u, 0u, 0u, 0u};
}
constexpr int AT_BUF = 18432, AT_VT = 9216, AT_PW = 36864, AT_PSUM = 55296, AT_SELM = 88064, AT_PC = 88320, AT_RS = 144;
DEV void attn_scores(LAS unsigned char* kt, const bf16x8 (&Qf)[2], const f32x4 (&cb)[4], f32x4 (&s)[4], int fr, int fq) {
    __builtin_amdgcn_s_setprio(1);
#pragma unroll
    for (int ct = 0; ct < 4; ++ct) { f32x4 acc = cb[ct];
#pragma unroll
        for (int k2 = 0; k2 < 2; ++k2) acc = __builtin_amdgcn_mfma_f32_16x16x32_bf16(lds_frag(kt, ct * 16 + fr, AT_RS, k2 * 64 + fq * 16), Qf[k2], acc, 0, 0, 0);
        s[ct] = acc; }
    __builtin_amdgcn_s_setprio(0);
}
DEV void attn_softmax_pv(LAS unsigned char* vt, const f32x4 (&s)[4], f32x4 (&O)[4], f32x4& L, float& m, float b0, int fr, int fq) {
    float v = fmaxf(fmaxf(fmaxf(s[0][0], s[0][1]), fmaxf(s[0][2], s[0][3])), fmaxf(fmaxf(s[1][0], s[1][1]), fmaxf(s[1][2], s[1][3])));
    v = fmaxf(v, fmaxf(fmaxf(fmaxf(s[2][0], s[2][1]), fmaxf(s[2][2], s[2][3])), fmaxf(fmaxf(s[3][0], s[3][1]), fmaxf(s[3][2], s[3][3]))));
    v = xrow_max(v);
    const float mn = fmaxf(m, v + b0), alpha = __builtin_amdgcn_exp2f(m - mn), nb = b0 - mn; m = mn;
    float pv[4][4];
#pragma unroll
    for (int ct = 0; ct < 4; ++ct)
#pragma unroll
        for (int jj = 0; jj < 4; ++jj) pv[ct][jj] = __builtin_amdgcn_exp2f(s[ct][jj] + nb);
#pragma unroll
    for (int dt = 0; dt < 4; ++dt) O[dt] *= alpha;
    L *= alpha;
    const u32x4 one4 = {0x3F803F80u, 0x3F803F80u, 0x3F803F80u, 0x3F803F80u};
    __builtin_amdgcn_s_setprio(1);
#pragma unroll
    for (int ks = 0; ks < 2; ++ks) {
        u32x4 pb; pb.x = pk2(pv[2 * ks][0], pv[2 * ks][1]); pb.y = pk2(pv[2 * ks][2], pv[2 * ks][3]); pb.z = pk2(pv[2 * ks + 1][0], pv[2 * ks + 1][1]); pb.w = pk2(pv[2 * ks + 1][2], pv[2 * ks + 1][3]);
        const bf16x8 Pb = __builtin_bit_cast(bf16x8, pb);
#pragma unroll
        for (int dt = 0; dt < 4; ++dt) {
            const int lb = fr * AT_RS + ((((fq >> 1) ^ (fr >> 3)) & 1) << 4) + (fq & 1) * 8;
            const u32x2 a0 = *(const LAS u32x2*)(vt + dt * 16 * AT_RS + lb + (((ks ^ (dt >> 1)) * 4 + ((0 ^ (dt & 1)) * 2)) << 4)), a1 = *(const LAS u32x2*)(vt + dt * 16 * AT_RS + lb + (((ks ^ (dt >> 1)) * 4 + ((1 ^ (dt & 1)) * 2)) << 4));
            const u32x4 av = {a0.x, a0.y, a1.x, a1.y};
            O[dt] = __builtin_amdgcn_mfma_f32_16x16x32_bf16(__builtin_bit_cast(bf16x8, av), Pb, O[dt], 0, 0, 0);
        }
        L = __builtin_amdgcn_mfma_f32_16x16x32_bf16(__builtin_bit_cast(bf16x8, one4), Pb, L, 0, 0, 0);
    }
    __builtin_amdgcn_s_setprio(0);
}
DEV float row_sum4(float v) { return xrow_sum(v); }

struct AttnCtx {
    int seqidx, g, nc, nh, wstart; bool prompt;
    int pt_lane;
};
template <int BR>
DEV void attn_fetch(const Params& p, const bf16_t* P, const bf16_t* KC, const bf16_t* VCT, const bf16_t* VTP, const AttnCtx& c, int kb, int key, int seg, KVRegs& R, bool want_v) {
    const int lane_ = threadIdx.x & 63;
    if (BR == 0) {
        const int j = kb * 64 + key;
        R.k = j < c.nc ? *(const u32x4*)(KC + kc_off(c.seqidx, c.g, j) + seg * 8) : (u32x4){0u, 0u, 0u, 0u};
        if (want_v) R.v = *(const u32x4*)(VCT + vct_off(c.seqidx, c.g) + (size_t)key * c.nh + kb * 64 + seg * 8);
    } else {
        const int pos = kb * 64 + key;
        if (c.prompt) {
            R.k = *(const u32x4*)(P + ((size_t)c.seqidx * SEQ + pos) * OD_N + 512 + BR * 256 + c.g * 64 + seg * 8);
            R.v = *(const u32x4*)(VTP + ((size_t)(((BR - 1) * 4 + c.seqidx) * 2 + c.g) * 64 + key) * SEQ + kb * 64 + seg * 8);
        } else {
            if (pos >= PAST + DSQ) { R.k = (u32x4){0u, 0u, 0u, 0u}; R.v = R.k; }
            else if (pos >= PAST) { const bf16_t* b = P + ((size_t)NP + (c.seqidx - 4) * DSQ + (pos - PAST)) * OD_N + 512 + BR * 256 + c.g * 64 + seg * 8; R.k = *(const u32x4*)b; R.v = *(const u32x4*)(b + 128); }
            else {
                const float* b;
                if (BR == 2) b = pin(7) + (((size_t)(c.seqidx - 4) * 512 + (pos - (PAST - 512))) * 4 + c.g) * 64 + seg * 8;
                else { const int page = __shfl(c.pt_lane, (pos >> 7) | (lane_ & 48)); b = pin(6) + (((size_t)page * 128 + (pos & 127)) * 4 + c.g) * 64 + seg * 8; }
                const f32x4 k0 = *(const f32x4*)b, k1 = *(const f32x4*)(b + 4), v0 = *(const f32x4*)(b + 128), v1 = *(const f32x4*)(b + 132);
                R.k.x = pk2(k0.x, k0.y); R.k.y = pk2(k0.z, k0.w); R.k.z = pk2(k1.x, k1.y); R.k.w = pk2(k1.z, k1.w);
                R.v.x = pk2(v0.x, v0.y); R.v.y = pk2(v0.z, v0.w); R.v.z = pk2(v1.x, v1.y); R.v.w = pk2(v1.z, v1.w);
            }
        }
    }
}
DEV void attn_store(LAS unsigned char* buf, const KVRegs& r, int key, int seg, bool vtrans, bool want_v) {
    *(LAS u32x4*)(buf + key * AT_RS + seg * 16) = r.k;
    if (!want_v) return;
    if (vtrans) *(LAS u32x4*)(buf + AT_VT + key * AT_RS + seg * 16) = r.v;
    else { const unsigned w[4] = {r.v.x, r.v.y, r.v.z, r.v.w};
#pragma unroll
        for (int e = 0; e < 4; ++e) { *(LAS bf16_t*)(buf + AT_VT + (seg * 8 + 2 * e) * AT_RS + key * 2) = (bf16_t)(w[e] & 0xffffu); *(LAS bf16_t*)(buf + AT_VT + (seg * 8 + 2 * e + 1) * AT_RS + key * 2) = (bf16_t)(w[e] >> 16); } }
}

struct KV2 { u32x4 k0, v0, k1, v1; };
constexpr int A2_BUFSTRIDE_S = 36864, A2_PSUM = 73728, A2_SELM = 106496, A2_PC = 106752;
DEV u32x4 pack8(const float* b) { const f32x4 a = *(const f32x4*)b, c = *(const f32x4*)(b + 4); u32x4 o; o.x = pk2(a.x, a.y); o.y = pk2(a.z, a.w); o.z = pk2(c.x, c.y); o.w = pk2(c.z, c.w); return o; }
template <int BR>
DEV void attn_fetch2(const bf16_t* P, const bf16_t* KC, const bf16_t* VCT, const bf16_t* VTP, const AttnCtx& c, int kb, int key, int seg, u32x4& Rk0, u32x4& Rv0, u32x4& Rk1, u32x4& Rv1, bool want_v) {
    const int lane_ = threadIdx.x & 63;
    const u32x4 Z = {0u, 0u, 0u, 0u};
    if (c.prompt) {
        if (BR == 0) { const int j = kb * 64 + key;
            Rk0 = j < c.nc ? *(const u32x4*)(KC + kc_off(c.seqidx, c.g, j) + seg * 8) : Z;
            if (want_v) Rv0 = *(const u32x4*)(VCT + vct_off(c.seqidx, c.g) + (size_t)key * c.nh + kb * 64 + seg * 8); }
        else { const int pos = kb * 64 + key;
            Rk0 = *(const u32x4*)(P + ((size_t)c.seqidx * SEQ + pos) * OD_N + 512 + BR * 256 + c.g * 64 + seg * 8);
            Rv0 = *(const u32x4*)(VTP + ((size_t)(((BR - 1) * 4 + c.seqidx) * 2 + c.g) * 64 + key) * SEQ + kb * 64 + seg * 8); }
    } else {
        if (BR == 0) { const int j = kb * 64 + key;
            Rk0 = j < c.nc ? *(const u32x4*)(KC + kc_off(c.seqidx, 0, j) + seg * 8) : Z;
            Rk1 = j < c.nc ? *(const u32x4*)(KC + kc_off(c.seqidx, 1, j) + seg * 8) : Z;
            if (want_v) { const bf16_t* vb = VCT + vct_off(c.seqidx, 0) + (size_t)key * c.nh + kb * 64 + seg * 8;
                Rv0 = *(const u32x4*)vb; asm volatile("" : "+v"(Rv0));
                Rv1 = *(const u32x4*)(vb + 64 * 128); asm volatile("" : "+v"(Rv1)); } }
        else { const int pos = kb * 64 + key;
            if (pos >= PAST + DSQ) { Rk0 = Z; Rk1 = Z; Rv0 = Z; Rv1 = Z; }
            else if (pos >= PAST) { const bf16_t* b = P + ((size_t)NP + (c.seqidx - 4) * DSQ + (pos - PAST)) * OD_N + 512 + BR * 256 + seg * 8;
                Rk0 = *(const u32x4*)b; Rk1 = *(const u32x4*)(b + 64); Rv0 = *(const u32x4*)(b + 128); Rv1 = *(const u32x4*)(b + 192); }
            else { const float* b;
                if (BR == 2) b = pin(7) + ((size_t)(c.seqidx - 4) * 512 + (pos - (PAST - 512))) * 256 + seg * 8;
                else { const int page = __shfl(c.pt_lane, (pos >> 7) | (lane_ & 48)); b = pin(6) + ((size_t)page * 128 + (pos & 127)) * 256 + seg * 8; }
                Rk0 = pack8(b); Rk1 = pack8(b + 64); Rv0 = pack8(b + 128); Rv1 = pack8(b + 192); }
        }
    }
}
template <int BR>
DEV void attn_fetch1(const bf16_t* P, const bf16_t* KC, const bf16_t* VCT, const bf16_t* VTP, const AttnCtx& c, int g, int kb, int key, int seg, u32x4& Rk, u32x4& Rv, bool want_v) {
    const int lane_ = threadIdx.x & 63;
    const u32x4 Z = {0u, 0u, 0u, 0u};
    if (BR == 0) { const int j = kb * 64 + key;
        Rk = j < c.nc ? *(const u32x4*)(KC + kc_off(c.seqidx, g, j) + seg * 8) : Z;
        if (want_v) Rv = *(const u32x4*)(VCT + vct_off(c.seqidx, g) + (size_t)key * c.nh + kb * 64 + seg * 8);
    } else if (c.prompt) { const int pos = kb * 64 + key;
        Rk = *(const u32x4*)(P + ((size_t)c.seqidx * SEQ + pos) * OD_N + 512 + BR * 256 + g * 64 + seg * 8);
        Rv = *(const u32x4*)(VTP + ((size_t)(((BR - 1) * 4 + c.seqidx) * 2 + g) * 64 + key) * SEQ + kb * 64 + seg * 8);
    } else { const int pos = kb * 64 + key;
        if (pos >= PAST + DSQ) { Rk = Z; Rv = Z; }
        else if (pos >= PAST) { const bf16_t* b = P + ((size_t)NP + (c.seqidx - 4) * DSQ + (pos - PAST)) * OD_N + 512 + BR * 256 + g * 64 + seg * 8; Rk = *(const u32x4*)b; Rv = *(const u32x4*)(b + 128); }
        else { const float* b;
            if (BR == 2) b = pin(7) + ((size_t)(c.seqidx - 4) * 512 + (pos - (PAST - 512))) * 256 + g * 64 + seg * 8;
            else { const int page = __shfl(c.pt_lane, (pos >> 7) | (lane_ & 48)); b = pin(6) + ((size_t)page * 128 + (pos & 127)) * 256 + g * 64 + seg * 8; }
            Rk = pack8(b); Rv = pack8(b + 128); }
    }
}
DEV void attn_store1(LAS unsigned char* b, const u32x4& k, const u32x4& v, int key, int seg, bool vtrans, bool want_v) {
    *(LAS u32x4*)(b + key * AT_RS + seg * 16) = k;
    if (want_v) {
        if (vtrans) *(LAS u32x4*)(b + AT_VT + key * AT_RS + ((seg ^ ((key >> 3) & 7)) << 4)) = v;
        else { const unsigned w[4] = {v.x, v.y, v.z, v.w}; const int ksw = ((((key >> 3) ^ seg) & 7) << 4) + (key & 7) * 2;
#pragma unroll
            for (int e = 0; e < 4; ++e) { *(LAS bf16_t*)(b + AT_VT + (seg * 8 + 2 * e) * AT_RS + ksw) = (bf16_t)(w[e] & 0xffffu); *(LAS bf16_t*)(b + AT_VT + (seg * 8 + 2 * e + 1) * AT_RS + ksw) = (bf16_t)(w[e] >> 16); } }
    }
}
DEV void attn_store2(LAS unsigned char* buf, const u32x4& k0, const u32x4& v0, const u32x4& k1, const u32x4& v1, int key, int seg, bool vtrans, bool want_v, int nslots) {
    attn_store1(buf, k0, v0, key, seg, vtrans, want_v);
    if (nslots > 1) attn_store1(buf + 18432, k1, v1, key, seg, vtrans, want_v);
}

DEV void phase_attn(const Params& p, const bf16_t* P, const bf16_t* KC, const bf16_t* VCT, const bf16_t* VTP, const float* GATES, bf16_t* MIX, LAS unsigned char* lds) {
    const int tid = opaque_tid(), lane = tid & 63, wave = __builtin_amdgcn_readfirstlane(tid >> 6), fr = lane & 15, fq = lane >> 4;
    const int r = wave & 3, qsub = wave >> 2, key = tid >> 3, seg = tid & 7;
    LAS float* PSUM = (LAS float*)(lds + A2_PSUM);
    LAS float* PC = (LAS float*)(lds + A2_PC);
    LAS unsigned long long* SELM = (LAS unsigned long long*)(lds + A2_SELM);
    const float NEG = -1e30f;
    unsigned* qctr = (unsigned*)(pws() + WS_BAR) + 3520;
    LAS int* qslot = (LAS int*)(lds + 147456 - 1024 + 16);
#if PROFILE == 2
    LAS unsigned* TA = (LAS unsigned*)(lds + 147456 - 512) + 64;
    if (tid == 0) for (int i = 0; i < 16; ++i) TA[i] = 0;
    unsigned long long tprev = 0;
#define ASEC(k) do { if (tid == 0) { const unsigned long long tn = __builtin_amdgcn_s_memrealtime(); TA[k] += (unsigned)(tn - tprev); tprev = tn; } } while (0)
#define ACNT(k) do { if (tid == 0) TA[k] += 1; } while (0)
#else
#define ASEC(k)
#define ACNT(k)
#endif
    int xq = blockIdx.x & 7, ntried = 0; bool sample_done = false;
    for (;;) {
        if (tid == 0) {
            int q = -1;
            if (!sample_done) { const int v = (int)__hip_atomic_fetch_add(qctr, 1u, __ATOMIC_RELAXED, __HIP_MEMORY_SCOPE_AGENT); if (v < 128) q = v; }
            if (q < 0) { int x = xq, k = ntried;
                while (k < 8) { const int v = (int)__hip_atomic_fetch_add(qctr + 1 + x, 1u, __ATOMIC_RELAXED, __HIP_MEMORY_SCOPE_AGENT); if (v < 128) { q = 128 + x * 128 + v; break; } x = (x + 1) & 7; ++k; }
                q = q < 0 ? (1 << 20) : (q | (k << 24)); }
            *qslot = q;
        }
        lds_barrier();
        int q = *qslot;
        lds_barrier();
        if (q >= (1 << 20) && (q & ((1 << 24) - 1)) == (1 << 20)) break;
        if (q >= 128) { sample_done = true; const int k = q >> 24; q &= (1 << 24) - 1; xq = (xq + (k - ntried)) & 7; ntried = k; }
        ASEC(15);
        AttnCtx c; int t0, ns;
        if (q >= 128) { c.prompt = true; const int q2 = q - 128; const int qt = 127 - (q2 & 127); const int pr = q2 >> 7; c.g = pr & 1; c.seqidx = pr >> 1; t0 = qt * 32; c.nc = 255; c.nh = 256; ns = 64; c.wstart = 0; }
        else { c.prompt = false; c.g = qsub; c.seqidx = 4 + q; t0 = PAST; c.nc = 127; c.nh = 128; ns = 33; c.wstart = PAST - 512; }
        c.pt_lane = c.prompt ? 0 : ppt()[(c.seqidx - 4) * 16 + (lane & 15)];
        const bool prompt = c.prompt; const int seqidx = c.seqidx, g = c.g, nc = c.nc, wstart = c.wstart;
        const int bufstride = A2_BUFSTRIDE_S, myslot = qsub * 18432;
        const int gS0 = prompt ? g : 0, gS1 = prompt ? g : 1;
        const int h = g * 4 + r; const float slope = exp2f(-(float)(h + 1)) * 1.4426950408889634f;
        const int qmin = t0, qmax = prompt ? t0 + 31 : t0 + 7;
        const int qminH = prompt ? t0 + 16 * qsub : t0, qmaxH = prompt ? qminH + 15 : t0 + 7;
        int qpos, tokr; bool act;
        if (prompt) { qpos = t0 + qsub * 16 + fr; tokr = seqidx * SEQ + qpos; act = true; }
        else { const int tc = min(fr, 7); qpos = PAST + tc; tokr = NP + (seqidx - 4) * DSQ + tc; act = fr < 8; }
        bf16x8 Qf[2];
        { const size_t tq = prompt ? (size_t)seqidx * SEQ + t0 + qsub * 16 + fr : (size_t)NP + (seqidx - 4) * DSQ + min(fr, 7);
#pragma unroll
          for (int k2 = 0; k2 < 2; ++k2) { const u32x4 qv = *(const u32x4*)(P + tq * OD_N + h * 64 + k2 * 32 + fq * 8);
              u32x4 o; constexpr float QS = 0.125f * 1.4426950408889634f;
              o.x = pk2(bflo(qv.x) * QS, bfhi(qv.x) * QS); o.y = pk2(bflo(qv.y) * QS, bfhi(qv.y) * QS); o.z = pk2(bflo(qv.z) * QS, bfhi(qv.z) * QS); o.w = pk2(bflo(qv.w) * QS, bfhi(qv.w) * QS);
              Qf[k2] = __builtin_bit_cast(bf16x8, o); } }
        for (int i = tid; i < 8192; i += NTHR) PSUM[i] = 0.f;
        f32x4 outv[4];
#pragma unroll
        for (int ct = 0; ct < 4; ++ct) outv[ct] = (f32x4){0.f, 0.f, 0.f, 0.f};
        f32x4 O[4]; f32x4 L = {0.f, 0.f, 0.f, 0.f}; float m = -1e20f, inv = 0.f;
        u32x4 rk0 = {0u, 0u, 0u, 0u}, rv0 = rk0, rk1 = rk0, rv1 = rk0;
        unsigned long long selrow = 0ull, umaskA = 0ull, umaskB = 0ull, amask = 0ull;
        const int ntc = prompt ? min(4, ((qmax - 31) >> 4) / 64 + 1) : 2;
#pragma unroll
        for (int stage = 0; stage < 4; ++stage) {
            constexpr int dummy = 0; (void)dummy;
            const int BRs = stage == 0 || stage == 1 ? 0 : stage - 1;
            unsigned long long remA, remB;
            if (stage <= 1) { remA = (1ull << ntc) - 1ull; remB = remA; }
            else if (stage == 2) { remA = umaskA; remB = umaskB; }
            else { const int qa = t0, qb = prompt ? t0 + 16 : t0, ea = prompt ? t0 + 15 : t0 + 7, eb = prompt ? t0 + 31 : t0 + 7;
                   const int loA = max(wstart, qa - 511) >> 6, hiA = ea >> 6, loB = max(wstart, qb - 511) >> 6, hiB = eb >> 6;
                   remA = (hiA >= 63 ? ~0ull : ((1ull << (hiA + 1)) - 1ull)) & ~((1ull << loA) - 1ull); remB = (hiB >= 63 ? ~0ull : ((1ull << (hiB + 1)) - 1ull)) & ~((1ull << loB) - 1ull); }
            remA = __builtin_amdgcn_readfirstlane((unsigned)remA) | ((unsigned long long)__builtin_amdgcn_readfirstlane((unsigned)(remA >> 32)) << 32);
            remB = __builtin_amdgcn_readfirstlane((unsigned)remB) | ((unsigned long long)__builtin_amdgcn_readfirstlane((unsigned)(remB >> 32)) << 32);
            const bool want_v = stage != 1;
            const bool vtrans = BRs == 0 || prompt;
            if (stage != 1) {
#pragma unroll
                for (int ct = 0; ct < 4; ++ct) O[ct] = (f32x4){0.f, 0.f, 0.f, 0.f};
                m = -1e20f; L = (f32x4){0.f, 0.f, 0.f, 0.f};
            }
            f32x4 cb[4];
            { const float bstep = BRs == 0 ? 16.f * slope : slope;
#pragma unroll
              for (int ct = 0; ct < 4; ++ct)
#pragma unroll
                  for (int jj = 0; jj < 4; ++jj) cb[ct][jj] = bstep * (float)(fq * 4 + ct * 16 + jj); }
            if (remA | remB) {
                unsigned long long rfA = remA, rfB = remB;
                if (rfA) { const int kb0 = __builtin_ctzll(rfA); rfA &= rfA - 1ull; if (BRs == 0) attn_fetch1<0>(P, KC, VCT, VTP, c, gS0, kb0, key, seg, rk0, rv0, want_v); else if (BRs == 1) attn_fetch1<1>(P, KC, VCT, VTP, c, gS0, kb0, key, seg, rk0, rv0, want_v); else attn_fetch1<2>(P, KC, VCT, VTP, c, gS0, kb0, key, seg, rk0, rv0, want_v); attn_store1(lds, rk0, rv0, key, seg, vtrans, want_v); }
                if (rfB) { const int kb0 = __builtin_ctzll(rfB); rfB &= rfB - 1ull; if (BRs == 0) attn_fetch1<0>(P, KC, VCT, VTP, c, gS1, kb0, key, seg, rk1, rv1, want_v); else if (BRs == 1) attn_fetch1<1>(P, KC, VCT, VTP, c, gS1, kb0, key, seg, rk1, rv1, want_v); else attn_fetch1<2>(P, KC, VCT, VTP, c, gS1, kb0, key, seg, rk1, rv1, want_v); attn_store1(lds + 18432, rk1, rv1, key, seg, vtrans, want_v); }
                if (rfA) { const int kb1 = __builtin_ctzll(rfA); rfA &= rfA - 1ull; if (BRs == 0) attn_fetch1<0>(P, KC, VCT, VTP, c, gS0, kb1, key, seg, rk0, rv0, want_v); else if (BRs == 1) attn_fetch1<1>(P, KC, VCT, VTP, c, gS0, kb1, key, seg, rk0, rv0, want_v); else attn_fetch1<2>(P, KC, VCT, VTP, c, gS0, kb1, key, seg, rk0, rv0, want_v); }
                if (rfB) { const int kb1 = __builtin_ctzll(rfB); rfB &= rfB - 1ull; if (BRs == 0) attn_fetch1<0>(P, KC, VCT, VTP, c, gS1, kb1, key, seg, rk1, rv1, want_v); else if (BRs == 1) attn_fetch1<1>(P, KC, VCT, VTP, c, gS1, kb1, key, seg, rk1, rv1, want_v); else attn_fetch1<2>(P, KC, VCT, VTP, c, gS1, kb1, key, seg, rk1, rv1, want_v); }
                lds_barrier();
                int cur = 0;
                while (remA | remB) {
                    int kbA = -1, kbB = -1;
                    if (remA) { kbA = __builtin_ctzll(remA); remA &= remA - 1ull; }
                    if (remB) { kbB = __builtin_ctzll(remB); remB &= remB - 1ull; }
                    const int kb = qsub ? kbB : kbA;
                    ACNT(prompt ? 10 : 11);
                    LAS unsigned char* buf = lds + cur * bufstride + myslot;
                    if (kb >= 0 || stage == 1) {
                    f32x4 s[4];
                    attn_scores(buf, Qf, cb, s, fr, fq);
                    bool interior;
                    if (BRs == 0) interior = (kb * 64 + 63 < nc) && (16 * (kb * 64 + 63) + 31 <= qminH);
                    else if (BRs == 1) interior = ((amask >> kb) & 1ull) != 0ull && (kb * 64 + 63 <= qminH);
                    else interior = (kb * 64 + 63 <= qminH) && (qmaxH - kb * 64 <= 511) && (kb * 64 >= wstart);
                    const int col0 = kb * 64 + fq * 4;
                    const int kp0 = BRs == 0 ? 16 * col0 + 31 : col0;
                    const float b0 = slope * (float)(BRs == 0 ? 1024 * kb + 31 : 64 * kb);
                    if (!interior) {
                        asm volatile("; boundary tile" ::: "memory");
                        const int d0 = qpos - kp0;
                        const bool selok = BRs == 1 ? (((selrow >> kb) & 1ull) != 0ull) : true;
#pragma unroll
                        for (int ct = 0; ct < 4; ++ct)
#pragma unroll
                            for (int jj = 0; jj < 4; ++jj) {
                                const int c = ct * 16 + jj; bool ok;
                                if (BRs == 0) ok = (col0 + c < nc) && (d0 >= 16 * c);
                                else if (BRs == 1) ok = selok && (d0 >= c);
                                else ok = (d0 >= c) && (d0 < 512 + c) && (kp0 + c >= wstart);
                                s[ct][jj] = ok ? s[ct][jj] : NEG; }
                    }
                    if (stage != 1) attn_softmax_pv(buf + AT_VT, s, O, L, m, b0, fr, fq);
                    else {
#pragma unroll
                        for (int ct = 0; ct < 4; ++ct) { f32x4 pq;
#pragma unroll
                            for (int jj = 0; jj < 4; ++jj) pq[jj] = __builtin_amdgcn_exp2f(s[ct][jj] + (b0 - m)) * inv;
                            *(LAS f32x4*)(PC + (wave * 16 + fr) * 68 + ct * 16 + fq * 4) = pq; }
                        lds_barrier();
                        { const int q2 = tid >> 8, t2 = (tid >> 4) & 15, k0 = (tid & 15) * 4;
                          f32x4 a = *(const LAS f32x4*)(PC + ((q2 * 4 + 0) * 16 + t2) * 68 + k0);
                          a += *(const LAS f32x4*)(PC + ((q2 * 4 + 1) * 16 + t2) * 68 + k0); a += *(const LAS f32x4*)(PC + ((q2 * 4 + 2) * 16 + t2) * 68 + k0); a += *(const LAS f32x4*)(PC + ((q2 * 4 + 3) * 16 + t2) * 68 + k0);
                          *(LAS f32x4*)(PSUM + (q2 * 16 + t2) * 256 + kb * 64 + k0) = a; }
                    }
                    }
                    if (remA) { attn_store1(lds + (cur ^ 1) * bufstride, rk0, rv0, key, seg, vtrans, want_v);
                        if (rfA) { const int kbn = __builtin_ctzll(rfA); rfA &= rfA - 1ull; if (BRs == 0) attn_fetch1<0>(P, KC, VCT, VTP, c, gS0, kbn, key, seg, rk0, rv0, want_v); else if (BRs == 1) attn_fetch1<1>(P, KC, VCT, VTP, c, gS0, kbn, key, seg, rk0, rv0, want_v); else attn_fetch1<2>(P, KC, VCT, VTP, c, gS0, kbn, key, seg, rk0, rv0, want_v); } }
                    if (remB) { attn_store1(lds + (cur ^ 1) * bufstride + 18432, rk1, rv1, key, seg, vtrans, want_v);
                        if (rfB) { const int kbn = __builtin_ctzll(rfB); rfB &= rfB - 1ull; if (BRs == 0) attn_fetch1<0>(P, KC, VCT, VTP, c, gS1, kbn, key, seg, rk1, rv1, want_v); else if (BRs == 1) attn_fetch1<1>(P, KC, VCT, VTP, c, gS1, kbn, key, seg, rk1, rv1, want_v); else attn_fetch1<2>(P, KC, VCT, VTP, c, gS1, kbn, key, seg, rk1, rv1, want_v); } }
                    lds_barrier();
                    cur ^= 1;
                }
            }
            ASEC((prompt ? 0 : 5) + stage);
            if (stage == 0) {
                inv = 1.f / fmaxf(L[0], 1e-30f); const float gt = GATES[(size_t)tokr * 24 + h * 3 + 0] * inv;
#pragma unroll
                for (int ct = 0; ct < 4; ++ct) outv[ct] += gt * O[ct];
            } else if (stage == 1) {
                unsigned kq[4], T[4]; bool vld[4];
#pragma unroll
                for (int i = 0; i < 4; ++i) {
                    const int ql = wave * 4 + i, qs_ = ql >> 4, t_ = ql & 15;
                    const int qp = prompt ? t0 + ql : PAST + min(t_, 7); const int curb = qp >> 6;
                    float imp = 0.f;
#pragma unroll
                    for (int dj = -1; dj <= 3; ++dj) { const int j = 4 * lane + dj; if (j >= 0 && j < nc) { const int lo = max(16 * j, 64 * lane), hi = min(16 * j + 32, 64 * lane + 64); imp += PSUM[(qs_ * 16 + t_) * 256 + j] * ((float)(hi - lo) * (1.f / 32.f)); } }
                    const bool valid = lane < ns && lane <= curb; const bool forced = lane == 0 || lane == curb || lane == curb - 1;
                    const float score = lane < ns ? (valid ? (forced ? 1e4f : imp) : NEG) : -3e38f;
                    unsigned k_ = __float_as_uint(score); k_ ^= ((unsigned)((int)k_ >> 31)) | 0x80000000u;
                    kq[i] = k_; vld[i] = valid; T[i] = 0u;
                }
#pragma unroll
                for (int b = 31; b >= 0; --b)
#pragma unroll
                    for (int i = 0; i < 4; ++i) { const unsigned cand = T[i] | (1u << b); const unsigned long long bm = __builtin_amdgcn_ballot_w64(kq[i] >= cand); int cnt; asm("s_bcnt1_i32_b64 %0, %1" : "=s"(cnt) : "s"(bm) : "scc"); T[i] = cnt >= 16 ? cand : T[i]; }
#pragma unroll
                for (int i = 0; i < 4; ++i) {
                    const int ql = wave * 4 + i, t_ = ql & 15; const bool qact = prompt || t_ < 8;
                    const unsigned long long gtm = __ballot(kq[i] > T[i]), tie = __ballot(kq[i] == T[i]);
                    const int need = 16 - __popcll(gtm);
                    const int below = __builtin_amdgcn_mbcnt_hi((unsigned)(tie >> 32), __builtin_amdgcn_mbcnt_lo((unsigned)tie, 0u));
                    const unsigned long long msk = __ballot(vld[i] && (kq[i] > T[i] || (kq[i] == T[i] && below < need)));
                    if (lane == 0) SELM[ql] = qact ? msk : 0ull;
                }
                lds_barrier();
                { const bool lact = lane < 32 && (prompt || (lane & 15) < 8);
                  unsigned long long u = lane < 32 ? SELM[lane] : 0ull; unsigned long long a = lact ? u : ~0ull;
                  unsigned ul = (unsigned)u, uh = (unsigned)(u >> 32), al = (unsigned)a, ah = (unsigned)(a >> 32);
                  ul |= dpp_u<DPP_XOR1>(ul); uh |= dpp_u<DPP_XOR1>(uh); al &= dpp_u<DPP_XOR1>(al); ah &= dpp_u<DPP_XOR1>(ah);
                  ul |= dpp_u<DPP_XOR2>(ul); uh |= dpp_u<DPP_XOR2>(uh); al &= dpp_u<DPP_XOR2>(al); ah &= dpp_u<DPP_XOR2>(ah);
                  ul |= dpp_u<DPP_HMIRROR>(ul); uh |= dpp_u<DPP_HMIRROR>(uh); al &= dpp_u<DPP_HMIRROR>(al); ah &= dpp_u<DPP_HMIRROR>(ah);
                  ul |= dpp_u<DPP_MIRROR>(ul); uh |= dpp_u<DPP_MIRROR>(uh); al &= dpp_u<DPP_MIRROR>(al); ah &= dpp_u<DPP_MIRROR>(ah);
                  umaskA = (unsigned long long)(unsigned)__builtin_amdgcn_readlane((int)ul, 0) | ((unsigned long long)(unsigned)__builtin_amdgcn_readlane((int)uh, 0) << 32);
                  umaskB = (unsigned long long)(unsigned)__builtin_amdgcn_readlane((int)ul, 16) | ((unsigned long long)(unsigned)__builtin_amdgcn_readlane((int)uh, 16) << 32);
                  { const unsigned long long aA = (unsigned long long)(unsigned)__builtin_amdgcn_readlane((int)al, 0) | ((unsigned long long)(unsigned)__builtin_amdgcn_readlane((int)ah, 0) << 32);
                    const unsigned long long aB = (unsigned long long)(unsigned)__builtin_amdgcn_readlane((int)al, 16) | ((unsigned long long)(unsigned)__builtin_amdgcn_readlane((int)ah, 16) << 32);
                    amask = qsub ? aB : aA; }
                  selrow = SELM[qsub * 16 + fr]; }
                ASEC(prompt ? 4 : 9);
            } else {
                const float gt = GATES[(size_t)tokr * 24 + h * 3 + (stage - 1)] / fmaxf(L[0], 1e-30f);
#pragma unroll
                for (int ct = 0; ct < 4; ++ct) outv[ct] += gt * O[ct];
            }
        }
        if (act) {
#pragma unroll
            for (int dt = 0; dt < 4; ++dt) { u32x2 w; w.x = pk2(outv[dt][0], outv[dt][1]); w.y = pk2(outv[dt][2], outv[dt][3]);
                *(u32x2*)(MIX + (size_t)tokr * D + h * 64 + dt * 16 + fq * 4) = w; }
        }
        lds_barrier();
    }
}

DEV void phase_chunkmlp(const Params& p, unsigned char* ws, const bf16_t* UG, const bf16_t* VLN, bf16_t* MIX, LAS unsigned char* lds) {
    constexpr int VRS = 272;
    const int tid = opaque_tid(), lane = tid & 63, wave = __builtin_amdgcn_readfirstlane(tid >> 6), fr = lane & 15, fq = lane >> 4;
    const bf16_t* WDS = (const bf16_t*)(ws + WS_WDS); const float* bsd = pin(26);
    for (int item = blockIdx.x; item < 1024; item += gridDim.x) {
        const int g = item & 7, n = (item >> 3) & 31, b = item >> 8;
        const size_t tok0 = (size_t)b * SEQ + n * 128;
        const int nks = (16 * wave + 15) / 32 + 1;
        const int s = tid >> 2, part = tid & 3, tl = 16 * wave + fr;
        const bf16_t* src_ = VLN + (tok0 + s) * 512 + g * 64 + part * 16;
        const u32x4 va = *(const u32x4*)src_, vb = *(const u32x4*)(src_ + 8);
        bf16x8 wf[4];
#pragma unroll
        for (int k4 = 0; k4 < 4; ++k4) wf[k4] = k4 < nks ? *(const bf16x8*)(WDS + ((size_t)g * 128 + tl) * 128 + k4 * 32 + fq * 8) : (bf16x8){0, 0, 0, 0, 0, 0, 0, 0};
        f32x4 ug[4];
#pragma unroll
        for (int ct = 0; ct < 4; ++ct) { const u32x2 w = *(const u32x2*)(UG + (tok0 + tl) * 512 + g * 64 + ct * 16 + fq * 4); ug[ct] = (f32x4){bflo(w.x), bfhi(w.x), bflo(w.y), bfhi(w.y)}; }
        const float bb = bsd[g * 128 + tl];
        { const unsigned vw[8] = {va.x, va.y, va.z, va.w, vb.x, vb.y, vb.z, vb.w};
#pragma unroll
          for (int e = 0; e < 8; ++e) { *(LAS bf16_t*)(lds + (part * 16 + 2 * e) * VRS + s * 2) = (bf16_t)(vw[e] & 0xffffu); *(LAS bf16_t*)(lds + (part * 16 + 2 * e + 1) * VRS + s * 2) = (bf16_t)(vw[e] >> 16); } }
        lds_barrier();
        f32x4 acc[4];
#pragma unroll
        for (int ct = 0; ct < 4; ++ct) acc[ct] = (f32x4){0.f, 0.f, 0.f, 0.f};
#pragma unroll
        for (int k4 = 0; k4 < 4; ++k4) if (k4 < nks) {
#pragma unroll
            for (int ct = 0; ct < 4; ++ct) acc[ct] = __builtin_amdgcn_mfma_f32_16x16x32_bf16(lds_frag(lds, ct * 16 + fr, VRS, k4 * 64 + fq * 16), wf[k4], acc[ct], 0, 0, 0);
        }
#pragma unroll
        for (int ct = 0; ct < 4; ++ct) { u32x2 w; w.x = pk2(ug[ct][0] * (acc[ct][0] + bb), ug[ct][1] * (acc[ct][1] + bb)); w.y = pk2(ug[ct][2] * (acc[ct][2] + bb), ug[ct][3] * (acc[ct][3] + bb));
            *(u32x2*)(MIX + (tok0 + tl) * D + 512 + g * 64 + ct * 16 + fq * 4) = w; }
        lds_barrier();
    }
}

DEV void phase_chunkmlp_naive(const Params& p, const bf16_t* UG, const bf16_t* VLN, bf16_t* MIX, int tok_lo, int gw, int ngw, int lane) {
    const float* wsd = pin(25); const float* bsd = pin(26);
    const size_t gt = (size_t)gw * 64 + lane, ngt = (size_t)ngw * 64;
    for (size_t i = (size_t)tok_lo * 512 + gt; i < (size_t)NT * 512; i += ngt) {
        const int tok = (int)(i >> 9), ch = (int)(i & 511), g = ch >> 6;
        const int tc = tok < NP ? (tok % SEQ) & 127 : (tok - NP) % DSQ;
        float m = bsd[g * 128 + tc];
        const float* wr_ = wsd + ((size_t)g * 128 + tc) * 128;
        for (int s = 0; s <= tc; ++s) m += wr_[s] * bf2f(VLN[(size_t)(tok - tc + s) * 512 + ch]);
        MIX[(size_t)tok * D + 512 + ch] = (bf16_t)f2bf(bf2f(UG[i]) * m);
    }
}

#define XB_TMO      128
#define XB_XCNT(j)  (256  + 64 * (j))
#define XB_XSUB(j)  (1280 + 64 * (j))
#define XB_XGEN(j)  (2304 + 64 * (j))
#define XB_TOP      3328
#define XB_TOPGEN   3392
#define XCD_BAR_WORDS 3456
#define XB_SPIN_CAP (1u << 20)
DEV unsigned xb_ld(unsigned* p)              { return __hip_atomic_load(p, __ATOMIC_RELAXED, __HIP_MEMORY_SCOPE_AGENT); }
DEV unsigned xb_add(unsigned* p, unsigned v) { return __hip_atomic_fetch_add(p, v, __ATOMIC_RELAXED, __HIP_MEMORY_SCOPE_AGENT); }
DEV unsigned xb_xcc_id() { return (unsigned)__builtin_amdgcn_s_getreg((3 << 11) | 20) & 0xFu; }
#define XB_SPIN(cond, bar) do { unsigned _sp = 0; while (cond) { __builtin_amdgcn_s_sleep(1); \
    if ((++_sp & 255u) == 0u) { if (xb_ld(&(bar)[XB_TMO])) break; if (_sp > XB_SPIN_CAP) { atomicAdd(&(bar)[XB_TMO], 1u); break; } } } } while (0)
struct XcdBarrier { unsigned* bar; unsigned x; volatile LAS unsigned* st; };
DEV XcdBarrier xcd_barrier_post(unsigned* bar, volatile LAS unsigned* st) {
    XcdBarrier b; b.bar = bar; b.x = xb_xcc_id(); b.st = st;
    if (threadIdx.x == 0) (void)xb_add(&bar[XB_XCNT(b.x)], 1u);
    return b;
}
DEV void xcd_barrier_complete(unsigned* bar, unsigned x, unsigned& nloc, unsigned& nx) {
    const unsigned G = gridDim.x * gridDim.y * gridDim.z;
    unsigned sum, cnt, mine, sp = 0u;
    for (;;) {
        sum = 0u; cnt = 0u; mine = 0u;
#pragma unroll
        for (unsigned j = 0; j < 16; ++j) { const unsigned c = xb_ld(&bar[XB_XCNT(j)]); sum += c; cnt += (c > 0u) ? 1u : 0u; mine = (j == x) ? c : mine; }
        if (sum == G) break;
        __builtin_amdgcn_s_sleep(1);
        if ((++sp & 255u) == 0u) { if (xb_ld(&bar[XB_TMO])) break; if (sp > XB_SPIN_CAP) { atomicAdd(&bar[XB_TMO], 1u); break; } }
    }
    nloc = mine > 0u ? mine : 1u; nx = cnt > 0u ? cnt : 1u;
}
DEV void xcd_barrier(const XcdBarrier& b, LAS unsigned long long* stamp = nullptr) {
    asm volatile("s_waitcnt vmcnt(0)" ::: "memory");
    __syncthreads();
    if (threadIdx.x == 0) {
        unsigned* bar = b.bar;
        __builtin_amdgcn_s_waitcnt(0);
        unsigned nloc = b.st[0], nx = b.st[1];
        if (nloc == 0u) { xcd_barrier_complete(bar, b.x, nloc, nx); b.st[0] = nloc; b.st[1] = nx; }
        const unsigned old = xb_add(&bar[XB_XSUB(b.x)], 1u);
        const unsigned gen = old / nloc;
        if (old + 1u == (gen + 1u) * nloc) {
            __builtin_amdgcn_fence(__ATOMIC_RELEASE, "agent");
            asm volatile("s_waitcnt vmcnt(0)" ::: "memory");
            const unsigned og = xb_add(&bar[XB_TOP], 1u);
            const unsigned tg = og / nx;
            if (og + 1u == (tg + 1u) * nx) xb_add(&bar[XB_TOPGEN], 1u);
            else XB_SPIN(xb_ld(&bar[XB_TOPGEN]) == tg, bar);
            __builtin_amdgcn_fence(__ATOMIC_ACQUIRE, "agent");
            xb_add(&bar[XB_XGEN(b.x)], 1u);
            asm volatile("s_waitcnt vmcnt(0)" ::: "memory");
        } else {
            XB_SPIN(xb_ld(&bar[XB_XGEN(b.x)]) == gen, bar);
            __builtin_amdgcn_fence(__ATOMIC_ACQUIRE, "agent");
            asm volatile("s_waitcnt vmcnt(0)" ::: "memory");
        }
        if (stamp) *stamp = __builtin_amdgcn_s_memrealtime();
    }
    __syncthreads();
}

#if PROFILE == 3
#define PROF_T0() unsigned long long pt0_ = __builtin_amdgcn_s_memrealtime()
#define PROF_MAX(slot) do { const unsigned long long pt1_ = __builtin_amdgcn_s_memrealtime(); if (threadIdx.x == 0) atomicMax((unsigned*)(pws() + WS_BAR) + 3600 + (slot), (unsigned)(pt1_ - pt0_)); pt0_ = pt1_; } while (0)
#else
#define PROF_T0()
#define PROF_MAX(slot)
#endif
__global__ void __launch_bounds__(NTHR, 2) fwd_kernel(Params p) {
    extern __shared__ __attribute__((aligned(16))) unsigned char lds_raw[];
    LAS unsigned char* lds = (LAS unsigned char*)lds_raw;
    cg::grid_group grid = cg::this_grid();
    const int G = gridDim.x;
    if (threadIdx.x < 2) ((volatile LAS unsigned*)(lds + 147456 - 1024))[threadIdx.x] = 0u;
    if (threadIdx.x == 0) { LAS unsigned long long* t = (LAS unsigned long long*)(lds + PTAB_OFF);
#pragma unroll
        for (int i = 0; i < 29; ++i) t[i] = (unsigned long long)p.in[i];
        t[29] = (unsigned long long)p.out; t[30] = (unsigned long long)p.ws; }
    __syncthreads();
    const XcdBarrier xbar = xcd_barrier_post((unsigned*)(pws() + WS_BAR), (volatile LAS unsigned*)(lds + 147456 - 1024));
#define PH_IDS const int tid_ = opaque_tid(), lane = tid_ & 63, wave = __builtin_amdgcn_readfirstlane(tid_ >> 6), gw = blockIdx.x * 8 + wave, ngw = G * 8; (void)lane; (void)gw; (void)ngw
#define ws pws()
#define X ((float*)(pws() + WS_X))
#define H ((bf16_t*)(pws() + WS_H))
#define ACT ((bf16_t*)(pws() + WS_ACT))
#define Y ((float*)(pws() + WS_Y))
#define P ((bf16_t*)(pws() + WS_P))
#define EXT ((float*)(pws() + WS_EXT))
#define MIX ((bf16_t*)(pws() + WS_MIX))
#define OB ((float*)(pws() + WS_OB))
#define QKV ((float*)(pws() + WS_QKV))
#define GB ((float*)(pws() + WS_GB))
#define GATES ((float*)(pws() + WS_GATES))
#define UG ((bf16_t*)(pws() + WS_UG))
#define VLN ((bf16_t*)(pws() + WS_VLN))
#define YT ((float*)(pws() + WS_YT))
#define norm_g pin(9)
#define RSTD ((float*)(pws() + WS_RSTD))
#if PROFILE
    LAS unsigned long long* TS = (LAS unsigned long long*)(lds + 147456 - 512); int nst = 0;
    if (blockIdx.x == 0 && threadIdx.x == 0) TS[nst] = __builtin_amdgcn_s_memrealtime();
    ++nst;
#define GSYNC() do { xcd_barrier(xbar, TS + nst); ++nst; } while (0)
#define GSYNC_CG() do { grid.sync(); if (blockIdx.x == 0 && threadIdx.x == 0) TS[nst] = __builtin_amdgcn_s_memrealtime(); ++nst; } while (0)
#else
#define GSYNC() xcd_barrier(xbar)
#define GSYNC_CG() grid.sync()
#endif
#define FFN(mat) do { gemm_phase(lds, H, (const bf16_t*)(ws + WS_WGU) + (size_t)(mat) * 5632 * 1024, NT, 5632, 1024, EpiSwiglu{ACT, RSTD}); GSYNC(); \
                      gemm_phase(lds, ACT, (const bf16_t*)(ws + WS_WD) + (size_t)(mat) * 1024 * FF, NP, 1024, FF, EpiBf16{(bf16_t*)Y, D}); \
                      gemm_phase(lds, ACT, (const bf16_t*)(ws + WS_WD) + (size_t)(mat) * 1024 * FF, NS, 1024, FF, EpiBf16{(bf16_t*)YT - (size_t)NP * D, D, (size_t)NS * D}, NP, 11); GSYNC(); } while (0)

#if DEBUG_FILL
    { PH_IDS; for (size_t i = (size_t)gw * 64 + lane; i < O_END; i += (size_t)ngw * 64) pout()[i] = 0.f; }
#endif
    { PH_IDS; phase_prep(p, lds, gw, ngw, lane, wave); }
    { PH_IDS; RowNormArgs a{}; a.x_in_p = pin(0); a.x_in_s = pin(1); a.xb = H; a.write_x = true; a.rstd = RSTD; phase_rownorm(a, gw, ngw, lane); }
    GSYNC_CG();
    FFN(0);
    { PH_IDS; RowNormArgs a{}; a.Ysrc = Y; a.Yt = (const bf16_t*)YT; a.ntp = 11; a.g_post = norm_g + 1 * D; a.scale = 0.5f; a.xb = H; a.write_x = true; a.rstd = RSTD;
      phase_rownorm(a, gw, ngw, lane); }
    GSYNC();
    gemm_phase(lds, H, (const bf16_t*)(ws + WS_WEIN), NT, EV_N + 256, 1024, EpiInProj{P, EV_N, EV_N, EXT, 8, RSTD});
    GSYNC();
    { PROF_T0(); { PH_IDS; phase_even_a(p, P, EXT, QKV, GB, NP, gw, ngw, lane); } PROF_MAX(5);
    phase_chunk_prep(p, P, EXT, ws, lds); PROF_MAX(6); }
    GSYNC();
    { PROF_T0();
    if (blockIdx.x < 64) { phase_scan(p, ws, OB, lds, blockIdx.x); PROF_MAX(0); }
    else { delta_recurrence(p, QKV, GB, OB, lds, 16 + (int)blockIdx.x - 64, G - 64, 16, 16 + 512); PROF_MAX(1);
           phase_compress_s(p, ws, lds, (int)blockIdx.x - 64, G - 64, 512);
           { const int nS = G - 64, sidx = (int)blockIdx.x - 64, heavy = 512 % nS;
             const unsigned W = heavy ? (unsigned)(heavy + (nS - heavy) * 8) : (unsigned)nS;
             const unsigned c0 = !heavy || sidx < heavy ? (unsigned)sidx : (unsigned)(heavy + (sidx - heavy) * 8), c1 = c0 + (!heavy || sidx < heavy ? 1u : 8u);
             phase_win_copy((unsigned)((unsigned long long)WINCOPY_N4 * c0 / W), (unsigned)((unsigned long long)WINCOPY_N4 * c1 / W)); }
           PROF_MAX(7); } }
    GSYNC();
    { PH_IDS; phase_even_c(p, P, OB, MIX, gw, ngw, lane); }
    GSYNC();
    gemm_phase(lds, MIX, (const bf16_t*)(ws + WS_WEOUT), NP, 1024, 1024, EpiBf16{(bf16_t*)Y, D});
    gemm_phase(lds, MIX, (const bf16_t*)(ws + WS_WEOUT), NS, 1024, 1024, EpiBf16{(bf16_t*)YT - (size_t)NP * D, D, (size_t)NS * D}, NP, 4);
    GSYNC();
    { PH_IDS; RowNormArgs a{};  a.Ysrc = Y; a.Yt = (const bf16_t*)YT; a.ntp = 4; a.g_post = norm_g + 3 * D; a.scale = 1.f; a.xb = H; a.write_x = true; a.rstd = RSTD; phase_rownorm(a, gw, ngw, lane); }
    GSYNC();
    FFN(1);
    { PH_IDS; RowNormArgs a{};  a.Ysrc = Y; a.Yt = (const bf16_t*)YT; a.ntp = 11; a.g_post = norm_g + 5 * D; a.scale = 0.5f; a.xb = H; a.write_x = true; a.rstd = RSTD; phase_rownorm(a, gw, ngw, lane); }
    GSYNC();
    FFN(2);
    { PH_IDS; RowNormArgs a{};  a.Ysrc = Y; a.Yt = (const bf16_t*)YT; a.ntp = 11; a.g_post = norm_g + 7 * D; a.scale = 0.5f; a.xb = H; a.write_x = true; a.rstd = RSTD;
      phase_rownorm(a, gw, ngw, lane); }
    GSYNC();
    gemm_phase(lds, H, (const bf16_t*)(ws + WS_WOIN), NT, OD_N + 256, 1024, EpiInProj{P, OD_N, OD_N, EXT, 24, RSTD});
    GSYNC();
    { PROF_T0(); { PH_IDS; const int bid = (int)blockIdx.x, nc_ = min(64, (int)G);
        const unsigned W = (unsigned)(nc_ * 1 + ((int)G - nc_) * 7), c0 = (unsigned)(bid < nc_ ? bid * 1 : nc_ * 1 + (bid - nc_) * 7), c1 = c0 + (bid < nc_ ? 1u : 7u);
        const int lo = (int)((unsigned long long)NT * c0 / W), hi = (int)((unsigned long long)NT * c1 / W);
        phase_odd_a(p, P, EXT, GATES, UG, VLN, lo + wave, 8, lane, hi); } PROF_MAX(2); }
    { PROF_T0();
    phase_vtp(P, (bf16_t*)(ws + WS_VTP), lds); PROF_MAX(3);
    phase_compress<false>(p, P, ws, lds, blockIdx.x, G, 64); PROF_MAX(4); }
    GSYNC();

    phase_attn(p, P, (const bf16_t*)(ws + WS_KC), (const bf16_t*)(ws + WS_VC), (const bf16_t*)(ws + WS_VTP), GATES, MIX, lds);

    phase_chunkmlp(p, ws, UG, VLN, MIX, lds);
#if PROFILE == 2
    if (threadIdx.x == 0) { unsigned* W = (unsigned*)(pws() + WS_BAR) + 3600; LAS unsigned* TA = (LAS unsigned*)(lds + 147456 - 512) + 64; for (int i = 0; i < 12; ++i) atomicMax(W + i, TA[i]); }
#endif
    { PH_IDS; phase_chunkmlp_naive(p, UG, VLN, MIX, NP, gw, ngw, lane); }
    GSYNC();
    gemm_phase(lds, MIX, (const bf16_t*)(ws + WS_WOOUT), NP, 1024, 1024, EpiBf16{(bf16_t*)Y, D});
    gemm_phase(lds, MIX, (const bf16_t*)(ws + WS_WOOUT), NS, 1024, 1024, EpiBf16{(bf16_t*)YT - (size_t)NP * D, D, (size_t)NS * D}, NP, 4);
    GSYNC();
    { PH_IDS; RowNormArgs a{};  a.Ysrc = Y; a.Yt = (const bf16_t*)YT; a.ntp = 4; a.g_post = norm_g + 9 * D; a.scale = 1.f; a.xb = H; a.write_x = true; a.rstd = RSTD; phase_rownorm(a, gw, ngw, lane); }
    GSYNC();
    FFN(3);
    { PH_IDS; RowNormArgs a{};  a.Ysrc = Y; a.Yt = (const bf16_t*)YT; a.ntp = 11; a.g_post = norm_g + 11 * D; a.scale = 0.5f; a.xb = H; a.write_x = false; a.out_p = pout() + O_YP; a.out_s = pout() + O_YS; phase_rownorm(a, gw, ngw, lane); }
#if PROFILE == 3
    GSYNC();
    if (blockIdx.x == 127 && threadIdx.x < 12) {
        const unsigned tot = ((unsigned*)(pws() + WS_BAR))[3600 + threadIdx.x];
        const int cnt = (int)((tot + 500) / 1000);
        const size_t offs[12] = {O_YP, O_YS, O_DP, O_DS, O_CAP, O_CAS, O_CBP, O_CBS, O_CMP, O_CMS, O_SLP, O_SLS};
        for (int i = 0; i < cnt && i < 4000; ++i) ((unsigned*)pout())[offs[threadIdx.x] + i] = 0xAAAAAAAAu;
    }
#elif PROFILE == 2
    GSYNC();
    if (blockIdx.x == 127 && threadIdx.x < 12) {
        const unsigned tot = ((unsigned*)(pws() + WS_BAR))[3600 + threadIdx.x];
        const int cnt = threadIdx.x >= 10 ? (int)tot : (int)((tot + 500) / 1000);
        const size_t offs[12] = {O_YP, O_YS, O_DP, O_DS, O_CAP, O_CAS, O_CBP, O_CBS, O_CMP, O_CMS, O_SLP, O_SLS};
        for (int i = 0; i < cnt && i < 4000; ++i) ((unsigned*)pout())[offs[threadIdx.x] + i] = 0xAAAAAAAAu;
    }
#elif PROFILE
    GSYNC();
    if (blockIdx.x == 0 && threadIdx.x < 13) {
        const int cat_of[24] = {0, 1, 2, 4, 6, 8, 9, 10, 7, 3, 1, 2, 3, 1, 2, 5, 6, 11, 12, 7, 3, 1, 2, 3};
        unsigned long long tot = 0;
        for (int i = 0; i < 24; ++i) if (cat_of[i] == (int)threadIdx.x) tot += TS[i + 1] - TS[i];
        const int cnt = (int)((tot + 500) / 1000);
        const size_t offs[13] = {O_YP, O_YS, O_DP, O_DS, O_CAP, O_CAS, O_CBP, O_CBS, O_CMP, O_CMS, O_SLP, O_SLS, O_WNP};
        for (int i = 0; i < cnt && i < 4000; ++i) ((unsigned*)pout())[offs[threadIdx.x] + i] = 0xAAAAAAAAu;
    }
#endif
}

#undef ws
#undef X
#undef H
#undef ACT
#undef Y
#undef P
#undef EXT
#undef MIX
#undef OB
#undef QKV
#undef GB
#undef GATES
#undef UG
#undef VLN
#undef YT
#undef norm_g
#undef RSTD
extern "C" void kernel_launch(void* const* d_in, const int* in_sizes, int n_in, void* d_out, int out_size, void* d_ws, size_t ws_size, hipStream_t stream) {
    constexpr int LDS_BYTES = 147456;
    static int grid = 0;
    if (grid == 0) {
        int dev = 0, cus = 0, per_cu = 0;
        hipGetDevice(&dev);
        hipDeviceGetAttribute(&cus, hipDeviceAttributeMultiprocessorCount, dev);
        hipFuncSetAttribute((const void*)fwd_kernel, hipFuncAttributeMaxDynamicSharedMemorySize, LDS_BYTES);
        hipOccupancyMaxActiveBlocksPerMultiprocessor(&per_cu, (const void*)fwd_kernel, NTHR, LDS_BYTES);
        if (per_cu < 1) { fprintf(stderr, "occupancy query says %d blocks/CU\n", per_cu); per_cu = 1; }
        grid = cus;
        if (ws_size < WS_END) { fprintf(stderr, "workspace too small: %zu < %zu\n", ws_size, (size_t)WS_END); grid = -1; }
        if (n_in != 29) { fprintf(stderr, "expected 29 inputs, got %d\n", n_in); grid = -1; }
    }
    if (grid < 0) return;
    Params p{};
    for (int i = 0; i < 29; ++i) p.in[i] = (const float*)d_in[i];
    p.page_table = (const int*)d_in[8];
    p.out = (float*)d_out; p.ws = (unsigned char*)d_ws;
    (void)hipMemsetAsync((unsigned char*)d_ws + WS_BAR, 0, 16384, stream);
    void* args[] = {&p};
    hipError_t e = hipLaunchCooperativeKernel((const void*)fwd_kernel, dim3(grid), dim3(NTHR), args, LDS_BYTES, stream);
    if (e != hipSuccess) fprintf(stderr, "cooperative launch failed: %s (grid %d)\n", hipGetErrorString(e), grid);
}
```

```cpp
#include <hip/hip_runtime.h>
#include <hip/hip_cooperative_groups.h>
#include <cstdio>
#include <cstdint>
namespace cg = cooperative_groups;
#define DEBUG_FILL 0
#ifndef PROFILE
#define PROFILE 0
#endif
#ifndef GEMM_SP2
#define GEMM_SP2 1
#endif
#define PV_A 0
#define PV_B 3
#ifndef ATT_ABL
#define ATT_ABL 0
#endif

typedef unsigned short bf16_t;
typedef short bf16x8 __attribute__((ext_vector_type(8)));
typedef float f32x4 __attribute__((ext_vector_type(4)));
typedef unsigned u32x4 __attribute__((ext_vector_type(4)));
typedef unsigned u32x2 __attribute__((ext_vector_type(2)));
#define DEV __device__ __forceinline__
#define LAS __attribute__((address_space(3)))

constexpr int D = 1024, NP = 16384, NS = 1024, NT = NP + NS, SEQ = 4096, NB = 4, DB = 128, DSQ = 8, PAST = 2048;
constexpr int FF = 2816;
constexpr int EV_N = 3584, EV_SRC = 3592, OD_N = 2304, OD_SRC = 2328;
constexpr int NTHR = 512;

constexpr size_t O_YP = 0, O_YS = O_YP + (size_t)NP * D, O_DP = O_YS + (size_t)NS * D, O_DS = O_DP + 4 * 4 * 128 * 128,
                 O_CAP = O_DS + (size_t)128 * 4 * 128 * 128, O_CAS = O_CAP + 4 * 3 * 1536, O_CBP = O_CAS + 128 * 3 * 1536,
                 O_CBS = O_CBP + 4 * 2 * 512, O_CMP = O_CBS + 128 * 2 * 512, O_CMS = O_CMP + (size_t)NP * 256,
                 O_SLP = O_CMS + (size_t)NS * 256, O_SLS = O_SLP + (size_t)NP * 256, O_WNP = O_SLS + (size_t)NS * 256,
                 O_WNS = O_WNP + 4 * 512 * 256, O_DV = O_WNS + (size_t)128 * 512 * 256, O_END = O_DV + (size_t)NS * 512;

constexpr size_t al256(size_t x) { return (x + 255) & ~(size_t)255; }
constexpr size_t WS_WGU = 0;
constexpr size_t WS_WD = WS_WGU + (size_t)4 * 5632 * 1024 * 2;
constexpr size_t WS_WEIN = WS_WD + (size_t)4 * 1024 * 2816 * 2;
constexpr size_t WS_WEOUT = WS_WEIN + (size_t)(EV_N + 256) * 1024 * 2;
constexpr size_t WS_WOIN = WS_WEOUT + (size_t)1024 * 1024 * 2;
constexpr size_t WS_WOOUT = WS_WOIN + (size_t)(OD_N + 256) * 1024 * 2;
constexpr size_t WS_WC1 = WS_WOOUT + (size_t)1024 * 1024 * 2;
constexpr size_t WS_WC2 = WS_WC1 + (size_t)2 * 256 * 1024 * 2;
constexpr size_t WS_WDS = WS_WC2 + (size_t)2 * 64 * 128 * 2;
constexpr size_t WS_CBIAS = WS_WDS + (size_t)8 * 128 * 128 * 2;
constexpr size_t WS_X = al256(WS_CBIAS + 2 * 128 * 4);
constexpr size_t WS_H = WS_X + (size_t)NT * D * 4;
constexpr size_t WS_ACT = WS_H + (size_t)NT * D * 2;
constexpr size_t WS_Y = WS_ACT + (size_t)NT * FF * 2;
constexpr size_t WS_P = WS_Y + (size_t)NT * D * 4;
constexpr size_t WS_EXT = WS_P + (size_t)NT * EV_N * 2;
constexpr size_t WS_MIX = al256(WS_EXT + (size_t)NT * 24 * 4);
constexpr size_t WS_OB = WS_MIX + (size_t)NT * D * 2;
constexpr size_t WS_CW = WS_OB + (size_t)NT * 512 * 4;
constexpr size_t WS_CQ = WS_CW + (size_t)1024 * 64 * 128 * 2;
constexpr size_t WS_CKT = WS_CQ + (size_t)1024 * 64 * 128 * 2;
constexpr size_t WS_CU = WS_CKT + (size_t)1024 * 64 * 128 * 2;
constexpr size_t WS_CI = WS_CU + (size_t)1024 * 64 * 128 * 4;
constexpr size_t WS_CGL = WS_CI + (size_t)1024 * 64 * 64 * 2;
constexpr size_t WS_KC = al256(WS_CGL + 1024 * 4);
constexpr size_t KC_ELEMS = (size_t)(4 * 2 * 256 + 128 * 2 * 128) * 64;
constexpr size_t WS_VC = WS_KC + KC_ELEMS * 2;
constexpr size_t WS_QKV = al256(WS_VC + KC_ELEMS * 2);
constexpr size_t WS_GB = WS_QKV + (size_t)NT * 1536 * 4;
constexpr size_t WS_GATES = WS_GB + (size_t)NT * 8 * 4;
constexpr size_t WS_UG = al256(WS_GATES + (size_t)NT * 24 * 4);
constexpr size_t WS_VLN = WS_UG + (size_t)NT * 512 * 4;
constexpr size_t WS_KCF = WS_VLN + (size_t)NT * 512 * 4;
constexpr size_t WS_VTP = al256(WS_KCF + KC_ELEMS * 2 * 4);
constexpr size_t WS_YT = WS_VTP + (size_t)2 * 4 * 2 * 64 * 4096 * 2;
constexpr size_t WS_RSTD = WS_YT + (size_t)11 * NS * D * 4;
constexpr size_t WS_BAR = al256(WS_RSTD + (size_t)NT * 4);
constexpr size_t WS_END = WS_BAR + 16384;

struct Params {
    const float* in[29];
    const int* page_table;
    float* out;
    unsigned char* ws;
};

DEV unsigned f2bf(float f) { return (unsigned)__builtin_bit_cast(unsigned short, (__bf16)f); }
typedef __bf16 hwbf16x2 __attribute__((ext_vector_type(2)));
typedef float f32x2_ __attribute__((ext_vector_type(2)));
DEV unsigned pk2(float lo, float hi) { const f32x2_ v = {lo, hi}; return __builtin_bit_cast(unsigned, __builtin_convertvector(v, hwbf16x2)); }
DEV float bf2f(unsigned short v) { return __builtin_bit_cast(float, (unsigned)v << 16); }
DEV float bflo(unsigned v) { return __builtin_bit_cast(float, v << 16); }
DEV float bfhi(unsigned v) { return __builtin_bit_cast(float, v & 0xffff0000u); }
DEV int opaque_tid() { int t = threadIdx.x; asm volatile("" : "+v"(t)); return t; }
constexpr int PTAB_OFF = 147456 - 1024 + 64;
DEV unsigned long long ptab_get(int i) { const unsigned long long v = ((LAS unsigned long long*)(unsigned)PTAB_OFF)[i];
    return (unsigned long long)(unsigned)__builtin_amdgcn_readfirstlane((unsigned)v) | ((unsigned long long)(unsigned)__builtin_amdgcn_readfirstlane((unsigned)(v >> 32)) << 32); }
#define GAS __attribute__((address_space(1)))
DEV const float* pin(int i) { return (const float*)(GAS const float*)ptab_get(i); }
DEV const int* ppt() { return (const int*)(GAS const int*)ptab_get(8); }
DEV float* pout() { return (float*)(GAS float*)ptab_get(29); }
DEV unsigned char* pws() { return (unsigned char*)(GAS unsigned char*)ptab_get(30); }
DEV void lds_barrier() { asm volatile("s_waitcnt lgkmcnt(0)" ::: "memory"); __builtin_amdgcn_s_barrier(); asm volatile("" ::: "memory"); }
template <int CTRL> DEV float dpp_f(float v) { return __builtin_bit_cast(float, __builtin_amdgcn_update_dpp(0, __builtin_bit_cast(int, v), CTRL, 0xf, 0xf, true)); }
template <int CTRL> DEV unsigned dpp_u(unsigned v) { return (unsigned)__builtin_amdgcn_update_dpp(0, (int)v, CTRL, 0xf, 0xf, true); }
constexpr int DPP_XOR1 = 0xB1, DPP_XOR2 = 0x4E, DPP_HMIRROR = 0x141, DPP_MIRROR = 0x140;
DEV float sum8_(float v) { v += dpp_f<DPP_XOR1>(v); v += dpp_f<DPP_XOR2>(v); v += dpp_f<DPP_HMIRROR>(v); return v; }
DEV float sum16_(float v) { v = sum8_(v); v += dpp_f<DPP_MIRROR>(v); return v; }
DEV void swap16_(float v, float& a, float& b) { a = v; b = v; asm volatile("v_nop\n\tv_nop\n\tv_permlane16_swap_b32 %0, %1" : "+v"(a), "+v"(b)); }
DEV void swap32_(float v, float& a, float& b) { a = v; b = v; asm volatile("v_nop\n\tv_nop\n\tv_permlane32_swap_b32 %0, %1" : "+v"(a), "+v"(b)); }
DEV float xrow_sum(float v) { float a, b; swap16_(v, a, b); v = a + b; swap32_(v, a, b); return a + b; }
DEV float xrow_max(float v) { float a, b; swap16_(v, a, b); v = fmaxf(a, b); swap32_(v, a, b); return fmaxf(a, b); }
DEV float wave_sum(float v) { return xrow_sum(sum16_(v)); }
DEV float sigmoidf_(float x) { return __builtin_amdgcn_rcpf(1.f + __expf(-x)); }
DEV float siluf_(float x) { return x * __builtin_amdgcn_rcpf(1.f + __expf(-x)); }
DEV float softplusf_(float x) { return x > 20.f ? x : log1pf(__expf(x)); }
DEV float geluf_(float x) { const float u = 0.7978845608028654f * (x + 0.044715f * x * x * x); return x * __builtin_amdgcn_rcpf(1.f + __expf(-2.f * u)); }

DEV void transpose_item(const float* W, int ldn, int k0, int n0, bf16_t* WT, int ldk, int dst_row0, LAS float* scr, int lane, const float* gk = nullptr) {
    const float gv = gk ? gk[k0 + lane] : 1.f;
#pragma unroll 8
    for (int i = 0; i < 32; ++i) { const int kk = 2 * i + (lane >> 5); scr[kk * 33 + (lane & 31)] = W[(size_t)(k0 + kk) * ldn + n0 + (lane & 31)] * __shfl(gv, kk); }
    asm volatile("s_waitcnt lgkmcnt(0)" ::: "memory");
    const int c = lane & 7;
#pragma unroll
    for (int j = 0; j < 4; ++j) { const int n = (lane >> 3) + 8 * j; const LAS float* s = scr + (8 * c) * 33 + n;
        u32x4 o; o.x = pk2(s[0 * 33], s[1 * 33]); o.y = pk2(s[2 * 33], s[3 * 33]); o.z = pk2(s[4 * 33], s[5 * 33]); o.w = pk2(s[6 * 33], s[7 * 33]);
        *(u32x4*)(WT + (size_t)(dst_row0 + n) * ldk + k0 + 8 * c) = o; }
    asm volatile("s_waitcnt lgkmcnt(0)" ::: "memory");
}

DEV void phase_prep(const Params& p, LAS unsigned char* lds, int gw, int ngw, int lane, int wave) {
    LAS float* scr = (LAS float*)(lds + wave * 16384);
    unsigned char* ws = pws();
    constexpr int I_G = 16 * 88;
    constexpr int I_D = 44 * 32;
    constexpr int I_EIN = 16 * 112, I_SQ = 16 * 32, I_OIN = 16 * 72, I_C1 = 4 * 16 * 4;
    constexpr int T0 = 4 * I_G, T1 = T0 + 4 * I_G, T2 = T1 + 4 * I_D, T3 = T2 + I_EIN, T4 = T3 + I_SQ, T5 = T4 + I_OIN, T6 = T5 + I_SQ, T7 = T6 + I_C1;
    for (int it = gw; it < T7 + 32; it += ngw) {
        if (it >= T7) {
            const int r = it - T7, kb = r & 15;
            if (r < 16) transpose_item(pin(13), EV_SRC, kb * 64, 2048, (bf16_t*)(ws + WS_WEIN), 1024, EV_N, scr, lane, pin(9) + 2 * D);
            else transpose_item(pin(20), OD_SRC, kb * 64, 512, (bf16_t*)(ws + WS_WOIN), 1024, OD_N, scr, lane, pin(9) + 8 * D);
            continue;
        }
        if (it < T1) {
            const bool up = it >= T0; const int r = up ? it - T0 : it; const int mat = r / I_G, rr = r % I_G, kb = rr / 88, nb = rr % 88;
            const float* W = (up ? pin(11) : pin(10)) + (size_t)mat * 1024 * FF;
            bf16_t* WT = (bf16_t*)(ws + WS_WGU) + (size_t)mat * 5632 * 1024;
            const int n0 = nb * 32, pn = n0 / 128, c = n0 % 128;
            transpose_item(W, FF, kb * 64, n0, WT, 1024, pn * 256 + (up ? 128 : 0) + c, scr, lane, pin(9) + ((mat >> 1) * 6 + ((mat & 1) ? 4 : 0)) * D);
        } else if (it < T2) {
            const int r = it - T1, mat = r / I_D, rr = r % I_D, kb = rr / 32, nb = rr % 32;
            transpose_item(pin(12) + (size_t)mat * FF * 1024, 1024, kb * 64, nb * 32, (bf16_t*)(ws + WS_WD) + (size_t)mat * 1024 * FF, FF, nb * 32, scr, lane);
        } else if (it < T3) {
            const int r = it - T2, kb = r / 112, nb = r % 112, dr = nb * 32;
            transpose_item(pin(13), EV_SRC, kb * 64, dr < 2048 ? dr : dr + 8, (bf16_t*)(ws + WS_WEIN), 1024, dr, scr, lane, pin(9) + 2 * D);
        } else if (it < T4) {
            const int r = it - T3, kb = r / 32, nb = r % 32;
            transpose_item(pin(14), 1024, kb * 64, nb * 32, (bf16_t*)(ws + WS_WEOUT), 1024, nb * 32, scr, lane);
        } else if (it < T5) {
            const int r = it - T4, kb = r / 72, nb = r % 72, dr = nb * 32;
            transpose_item(pin(20), OD_SRC, kb * 64, dr < 512 ? dr : dr + 24, (bf16_t*)(ws + WS_WOIN), 1024, dr, scr, lane, pin(9) + 8 * D);
        } else if (it < T6) {
            const int r = it - T5, kb = r / 32, nb = r % 32;
            transpose_item(pin(21), 1024, kb * 64, nb * 32, (bf16_t*)(ws + WS_WOOUT), 1024, nb * 32, scr, lane);
        } else {
            const int r = it - T6, kvh = r / 64, rr = r % 64, kb = rr / 4, nb = rr % 4;
            const float* W = pin(23) + (size_t)(kvh >> 1) * 2048 * 128 + (size_t)(kvh & 1) * 1024 * 128;
            transpose_item(W, 128, kb * 64, nb * 32, (bf16_t*)(ws + WS_WC1) + (size_t)(kvh >> 1) * 256 * 1024, 1024, (kvh & 1) * 128 + nb * 32, scr, lane);
        }
    }
    const int gt = gw * 64 + lane, ngt = ngw * 64;
    for (int i = gt; i < 2 * 64 * 128; i += ngt) {
        const int kv = i / 8192, r = i % 8192, d = r / 128, h = r % 128;
        ((bf16_t*)(ws + WS_WC2))[i] = (bf16_t)f2bf(pin(24)[(size_t)kv * 8192 + h * 64 + d]);
    }
    for (int i = gt; i < 8 * 128 * 128; i += ngt) {
        const int t = (i / 128) % 128, s = i % 128;
        ((bf16_t*)(ws + WS_WDS))[i] = (bf16_t)f2bf(s <= t ? pin(25)[i] : 0.f);
    }
    for (int o = gw; o < 256; o += ngw) {
        const int kv = o / 128, h = o % 128; float acc = 0.f;
        for (int k = lane; k < 2048; k += 64) acc += pin(22)[(size_t)kv * 2048 + k] * pin(23)[((size_t)kv * 2048 + k) * 128 + h];
        acc = wave_sum(acc);
        if (lane == 0) ((float*)(ws + WS_CBIAS))[o] = acc;
    }
}

struct RowNormArgs {
    const float* x_in_p; const float* x_in_s;
    const float* Ysrc;
    const bf16_t* Yt; int ntp;
    const float* g_post; float scale;
    bf16_t* xb;
    float* rstd;
    float* out_p; float* out_s;
    bool write_x;
};
DEV void phase_rownorm(const RowNormArgs& a, int gw, int ngw, int lane) {
    f32x4 gpost[4];
#pragma unroll
    for (int j = 0; j < 4; ++j) gpost[j] = a.Ysrc ? ((const f32x4*)a.g_post)[lane + 64 * j] : (f32x4){0.f, 0.f, 0.f, 0.f};
    for (int row = gw; row < NT; row += ngw) {
        f32x4 v[4];
        if (a.x_in_p) { const float* xr = row < NP ? a.x_in_p + (size_t)row * D : a.x_in_s + (size_t)(row - NP) * D;
#pragma unroll
            for (int j = 0; j < 4; ++j) v[j] = ((const f32x4*)xr)[lane + 64 * j]; }
        else {
#pragma unroll
            for (int j = 0; j < 4; ++j) { const u32x2 w = ((const u32x2*)(a.xb + (size_t)row * D))[lane + 64 * j]; v[j] = (f32x4){bflo(w.x), bfhi(w.x), bflo(w.y), bfhi(w.y)}; } }
        if (a.Ysrc) {
            f32x4 y[4]; float s = 0.f;
#pragma unroll
            for (int j = 0; j < 4; ++j) {
                if (row < NP) { const u32x2 w = ((const u32x2*)((const bf16_t*)a.Ysrc + (size_t)row * D))[lane + 64 * j]; y[j] = (f32x4){bflo(w.x), bfhi(w.x), bflo(w.y), bfhi(w.y)}; }
                else { y[j] = (f32x4){0.f, 0.f, 0.f, 0.f};
                    for (int q = 0; q < a.ntp; ++q) { const u32x2 w = ((const u32x2*)(a.Yt + ((size_t)q * NS + (row - NP)) * D))[lane + 64 * j]; y[j] += (f32x4){bflo(w.x), bfhi(w.x), bflo(w.y), bfhi(w.y)}; } }
                s += (y[j].x * y[j].x + y[j].y * y[j].y) + (y[j].z * y[j].z + y[j].w * y[j].w); }
            const float r = a.scale * rsqrtf(wave_sum(s) * (1.f / D) + 1e-6f);
#pragma unroll
            for (int j = 0; j < 4; ++j) v[j] += y[j] * gpost[j] * r;
        }
        if (a.out_p) {
            float* o = row < NP ? a.out_p + (size_t)row * D : a.out_s + (size_t)(row - NP) * D;
#pragma unroll
            for (int j = 0; j < 4; ++j) __builtin_nontemporal_store(v[j], (f32x4*)o + lane + 64 * j);
        }
        if (a.write_x) {
#pragma unroll
            for (int j = 0; j < 4; ++j) { u32x2 w; w.x = pk2(v[j].x, v[j].y); w.y = pk2(v[j].z, v[j].w); ((u32x2*)(a.xb + (size_t)row * D))[lane + 64 * j] = w; }
        }
        if (a.rstd) {
            float s = 0.f;
#pragma unroll
            for (int j = 0; j < 4; ++j) s += (v[j].x * v[j].x + v[j].y * v[j].y) + (v[j].z * v[j].z + v[j].w * v[j].w);
            const float r = rsqrtf(wave_sum(s) * (1.f / D) + 1e-6f);
            if (lane == 0) a.rstd[row] = r;
        }
    }
}

constexpr int BM = 256, BK = 64, HALF = 128, NXCD = 8, WGM = 8, HT = HALF * BK;
DEV int lds_byte(int r, int c) { const int st = (r >> 4) * 2 + (c >> 5), rr = r & 15, cc = c & 31, ob = rr * 64 + cc * 2; return st * 1024 + (ob ^ (((ob >> 9) & 1) << 5)); }
DEV void stage_rc(int b, int& R, int& C) { const int st = b / 1024, sb = b % 1024, swz = sb ^ (((sb >> 9) & 1) << 5); R = (st >> 1) * 16 + swz / 64; C = (st & 1) * 32 + (swz % 64) / 2; }

struct EpiF32 {
    static constexpr bool ROWSCALE = false;
    float* C0; int ldc; size_t part_stride;
    DEV void operator()(const f32x4 (&acc)[2][2][4][2], int brow, int bcol, int wr, int wc, int fr, int fq, int part, const float (&rs)[8]) const {
        float* C = C0 + (size_t)part * part_stride;
#pragma unroll
        for (int ai = 0; ai < 2; ++ai)
#pragma unroll
            for (int m = 0; m < 4; ++m) { float* rowp = C + (size_t)(brow + ai * HALF + wr * 64 + m * 16 + fr) * ldc + bcol + wc * 32 + fq * 4;
#pragma unroll
                for (int bj = 0; bj < 2; ++bj)
#pragma unroll
                    for (int n = 0; n < 2; ++n) *(f32x4*)(rowp + bj * HALF + n * 16) = acc[ai][bj][m][n]; }
    }
};
struct EpiBf16 {
    static constexpr bool ROWSCALE = false;
    bf16_t* C0; int ldc; size_t part_stride;
    DEV void operator()(const f32x4 (&acc)[2][2][4][2], int brow, int bcol, int wr, int wc, int fr, int fq, int part, const float (&rs)[8]) const {
        bf16_t* C = C0 + (size_t)part * part_stride;
#pragma unroll
        for (int ai = 0; ai < 2; ++ai)
#pragma unroll
            for (int m = 0; m < 4; ++m) { bf16_t* rowp = C + (size_t)(brow + ai * HALF + wr * 64 + m * 16 + fr) * ldc + bcol + wc * 32 + fq * 4;
#pragma unroll
                for (int bj = 0; bj < 2; ++bj)
#pragma unroll
                    for (int n = 0; n < 2; ++n) { const f32x4 v = acc[ai][bj][m][n]; u32x2 w; w.x = pk2(v[0], v[1]); w.y = pk2(v[2], v[3]); *(u32x2*)(rowp + bj * HALF + n * 16) = w; } }
    }
};
struct EpiInProj {
    static constexpr bool ROWSCALE = true;
    bf16_t* C; int ldc; int n_main; float* ext; int n_ext; const float* rstd;
    DEV void operator()(const f32x4 (&acc)[2][2][4][2], int brow, int bcol, int wr, int wc, int fr, int fq, int part, const float (&rs)[8]) const {
        if (bcol < n_main) {
#pragma unroll
            for (int ai = 0; ai < 2; ++ai)
#pragma unroll
                for (int m = 0; m < 4; ++m) { const int row = brow + ai * HALF + wr * 64 + m * 16 + fr; const float r = rs[ai * 4 + m]; bf16_t* rowp = C + (size_t)row * ldc + bcol + wc * 32 + fq * 4;
#pragma unroll
                    for (int bj = 0; bj < 2; ++bj)
#pragma unroll
                        for (int n = 0; n < 2; ++n) { const f32x4 v = acc[ai][bj][m][n] * r; u32x2 w; w.x = pk2(v[0], v[1]); w.y = pk2(v[2], v[3]); *(u32x2*)(rowp + bj * HALF + n * 16) = w; } }
            return; }
        if (wc == 0) {
#pragma unroll
            for (int n = 0; n < 2; ++n) { const int c = n * 16 + fq * 4;
                if (c < n_ext) {
#pragma unroll
                    for (int ai = 0; ai < 2; ++ai)
#pragma unroll
                        for (int m = 0; m < 4; ++m) { const int row = brow + ai * HALF + wr * 64 + m * 16 + fr; *(f32x4*)(ext + (size_t)row * 24 + c) = acc[ai][0][m][n] * rs[ai * 4 + m]; }
                } }
        }
    }
};
struct EpiSwiglu {
    static constexpr bool ROWSCALE = true;
    bf16_t* C; const float* rstd;
    DEV void operator()(const f32x4 (&acc)[2][2][4][2], int brow, int bcol, int wr, int wc, int fr, int fq, int part, const float (&rs)[8]) const {
#pragma unroll
        for (int ai = 0; ai < 2; ++ai)
#pragma unroll
            for (int m = 0; m < 4; ++m) { const int row = brow + ai * HALF + wr * 64 + m * 16 + fr; const float r = rs[ai * 4 + m]; bf16_t* rowp = C + (size_t)row * FF + (bcol >> 1) + wc * 32 + fq * 4;
#pragma unroll
                for (int n = 0; n < 2; ++n) { const f32x4 g = acc[ai][0][m][n] * r, u = acc[ai][1][m][n] * r;
                    u32x2 w; w.x = pk2(siluf_(g[0]) * u[0], siluf_(g[1]) * u[1]); w.y = pk2(siluf_(g[2]) * u[2], siluf_(g[3]) * u[3]); *(u32x2*)(rowp + n * 16) = w; } }
    }
};

template <class Epi>
DEV void gemm_phase(LAS unsigned char* lds, const bf16_t* __restrict__ A, const bf16_t* __restrict__ Bt, int M, int N, int K, const Epi& E, int row0 = 0, int nparts = 1) {
    const int tidg = opaque_tid();
    const int wid = __builtin_amdgcn_readfirstlane(tidg >> 6), lane = tidg & 63, wr = wid >> 2, wc = wid & 3, fr = lane & 15, fq = lane >> 4;
    unsigned voff[2];
#pragma unroll
    for (int i = 0; i < 2; ++i) { int R, C; stage_rc(tidg * 16 + i * 8192, R, C); voff[i] = (unsigned)(R * K + C) * 2u; }
    const size_t hstep = (size_t)HALF * K * 2;
    const unsigned ldsw = (unsigned)wid * 1024u;
    const int aoff = lds_byte(wr * 64 + fr, fq * 8), boff = lds_byte(wc * 32 + fr, fq * 8);
#define G_SA(b, h) (((b) * 2 + (h)) * (HT * 2))
#define G_SB(b, h) ((4 + (b) * 2 + (h)) * (HT * 2))
#define STAGE(bufoff, gbase) do { _Pragma("unroll") for (int _i = 0; _i < 2; ++_i) \
      __builtin_amdgcn_global_load_lds((const unsigned*)((const char*)(gbase) + voff[_i]), (LAS unsigned*)(lds + (bufoff) + ldsw + _i * 8192), 16, 0, 0); } while (0)
#define LDA(dst, b, h) do { _Pragma("unroll") for (int m = 0; m < 4; ++m) _Pragma("unroll") for (int k = 0; k < 2; ++k) dst[m][k] = *(const LAS bf16x8*)(lds + G_SA(b, h) + aoff + m * 2048 + k * 1024); } while (0)
#define LDB(dst, b, h) do { _Pragma("unroll") for (int n = 0; n < 2; ++n) _Pragma("unroll") for (int k = 0; k < 2; ++k) dst[n][k] = *(const LAS bf16x8*)(lds + G_SB(b, h) + boff + n * 2048 + k * 1024); } while (0)
#define MMA(ai, bj, At, Bq) do { __builtin_amdgcn_s_setprio(1); \
    _Pragma("unroll") for (int m = 0; m < 4; ++m) _Pragma("unroll") for (int n = 0; n < 2; ++n) _Pragma("unroll") for (int k = 0; k < 2; ++k) \
      acc[ai][bj][m][n] = __builtin_amdgcn_mfma_f32_16x16x32_bf16(Bq[n][k], At[m][k], acc[ai][bj][m][n], 0, 0, 0); \
    __builtin_amdgcn_s_setprio(0); } while (0)
#define WAIT_V(n) asm volatile("s_waitcnt vmcnt(" #n ")" ::: "memory")
#define WAIT_L(n) asm volatile("s_waitcnt lgkmcnt(" #n ")" ::: "memory")
#define BAR __builtin_amdgcn_s_barrier()
#define SCHED __builtin_amdgcn_sched_barrier(0)
    const int nM = M / BM, nN = N / BM, nwg = nM * nN, nunits = nwg * nparts;
    const int nt = K / BK / nparts;
    auto decode = [&](int L, int& brow, int& bcol, int& part, const char*& uA, const char*& uB) {
        part = L % nparts;
        int wgid = L / nparts;
        { const int q = nwg / NXCD, r = nwg % NXCD, xcd = wgid % NXCD, off = wgid / NXCD; wgid = (xcd < r ? xcd * (q + 1) : r * (q + 1) + (xcd - r) * q) + off; }
        const int nig = WGM * nN, gid = wgid / nig, fm = gid * WGM, gsz = min(nM - fm, WGM);
        const int pm = fm + ((wgid % nig) % gsz), pn = (wgid % nig) / gsz; brow = row0 + pm * BM; bcol = pn * BM;
        uA = (const char*)A + ((size_t)brow * K + (size_t)part * nt * BK) * 2; uB = (const char*)Bt + ((size_t)bcol * K + (size_t)part * nt * BK) * 2;
    };
    int L = blockIdx.x;
    if (L < nunits) {
        int brow, bcol, part; const char* cA; const char* cB;
        decode(L, brow, bcol, part, cA, cB);
        f32x4 acc[2][2][4][2];
#pragma unroll
        for (int a = 0; a < 2; ++a)
#pragma unroll
            for (int b = 0; b < 2; ++b)
#pragma unroll
                for (int m = 0; m < 4; ++m)
#pragma unroll
                    for (int n = 0; n < 2; ++n) acc[a][b][m][n] = (f32x4){0.f, 0.f, 0.f, 0.f};
        bf16x8 At[4][2], B0[2][2], B1[2][2];
        float rs[8];
        if constexpr (Epi::ROWSCALE) {
#pragma unroll
            for (int i = 0; i < 8; ++i) rs[i] = E.rstd[brow + (i >> 2) * HALF + wr * 64 + (i & 3) * 16 + fr];
        }
#if GEMM_SP2
        STAGE(G_SB(0, 0), cB); STAGE(G_SB(0, 1), cB + hstep); STAGE(G_SA(0, 0), cA); STAGE(G_SA(0, 1), cA + hstep);
        if (wr == 1) BAR;
        WAIT_V(2); BAR;
        STAGE(G_SB(1, 0), cB + 128); STAGE(G_SA(1, 0), cA + 128); STAGE(G_SB(1, 1), cB + hstep + 128);
        WAIT_V(6); BAR;
#else
        STAGE(G_SB(0, 0), cB); STAGE(G_SA(0, 0), cA);
        STAGE(G_SB(0, 1), cB + hstep); STAGE(G_SA(0, 1), cA + hstep);
        if (wr == 1) BAR;
        WAIT_V(4); BAR;
        STAGE(G_SB(1, 0), cB + 128); STAGE(G_SA(1, 0), cA + 128); STAGE(G_SB(1, 1), cB + hstep + 128);
        WAIT_V(6); BAR;
#endif
        for (;;) {
            const int Ln = L + (int)gridDim.x; const bool has_next = Ln < nunits;
            int nbrow = brow, nbcol = bcol, npart = part; const char* nA = cA; const char* nB = cB;
            if (has_next) decode(Ln, nbrow, nbcol, npart, nA, nB);
            for (int t = 0; t < nt; t += 2) {
                const bool last = (t == nt - 2);
                const char* a1 = cA + (size_t)(t + 1) * 128;
                const char* a2 = last ? nA : cA + (size_t)(t + 2) * 128; const char* b2 = last ? nB : cB + (size_t)(t + 2) * 128;
                const char* a3 = a2 + 128; const char* b3 = b2 + 128;
#if GEMM_SP2
                LDB(B0, 0, 0); LDB(B1, 0, 1); SCHED; LDA(At, 0, 0); STAGE(G_SA(1, 1), a1 + hstep);
                WAIT_V(8); WAIT_L(0); BAR; MMA(0, 0, At, B0); MMA(0, 1, At, B1); BAR; SCHED;
                LDA(At, 0, 1); STAGE(G_SB(0, 0), b2); STAGE(G_SB(0, 1), b2 + hstep); STAGE(G_SA(0, 0), a2);
                WAIT_V(8); WAIT_L(0); BAR; MMA(1, 0, At, B0); MMA(1, 1, At, B1); BAR; SCHED;
                LDB(B0, 1, 0); LDB(B1, 1, 1); SCHED; LDA(At, 1, 0); STAGE(G_SA(0, 1), a2 + hstep);
                WAIT_V(8); WAIT_L(0); BAR; MMA(0, 0, At, B0); MMA(0, 1, At, B1); BAR; SCHED;
                LDA(At, 1, 1); STAGE(G_SB(1, 0), b3); STAGE(G_SB(1, 1), b3 + hstep); STAGE(G_SA(1, 0), a3);
                WAIT_V(8); WAIT_L(0); BAR; MMA(1, 0, At, B0); MMA(1, 1, At, B1); BAR; SCHED;
#else
                LDB(B0, 0, 0); SCHED; LDA(At, 0, 0); STAGE(G_SA(1, 1), a1 + hstep);
                WAIT_L(8); BAR; WAIT_L(0); MMA(0, 0, At, B0); BAR; SCHED;
                LDB(B1, 0, 1); STAGE(G_SB(0, 0), b2);
                BAR; WAIT_L(0); MMA(0, 1, At, B1); BAR;
                LDA(At, 0, 1); STAGE(G_SA(0, 0), a2);
                BAR; WAIT_L(0); MMA(1, 0, At, B0); BAR; SCHED;
                STAGE(G_SB(0, 1), b2 + hstep);
                WAIT_V(6); BAR; MMA(1, 1, At, B1); BAR;
                LDB(B0, 1, 0); SCHED; LDA(At, 1, 0); STAGE(G_SA(0, 1), a2 + hstep);
                WAIT_L(8); BAR; WAIT_L(0); MMA(0, 0, At, B0); BAR; SCHED;
                LDB(B1, 1, 1); STAGE(G_SB(1, 0), b3);
                BAR; WAIT_L(0); MMA(0, 1, At, B1); BAR;
                LDA(At, 1, 1); STAGE(G_SA(1, 0), a3);
                BAR; WAIT_L(0); MMA(1, 0, At, B0); BAR; SCHED;
                STAGE(G_SB(1, 1), b3 + hstep);
                WAIT_V(6); BAR; MMA(1, 1, At, B1); BAR;
#endif
            }
            E(acc, brow, bcol, wr, wc, fr, fq, part, rs);
            if (!has_next) break;
#pragma unroll
            for (int a = 0; a < 2; ++a)
#pragma unroll
                for (int b = 0; b < 2; ++b)
#pragma unroll
                    for (int m = 0; m < 4; ++m)
#pragma unroll
                        for (int n = 0; n < 2; ++n) acc[a][b][m][n] = (f32x4){0.f, 0.f, 0.f, 0.f};
            L = Ln; brow = nbrow; bcol = nbcol; part = npart; cA = nA; cB = nB;
            if constexpr (Epi::ROWSCALE) {
#pragma unroll
                for (int i = 0; i < 8; ++i) rs[i] = E.rstd[brow + (i >> 2) * HALF + wr * 64 + (i & 3) * 16 + fr];
            }
        }
        WAIT_V(0);
        if (wr == 0) BAR;
        BAR;
    }
    __syncthreads();
#undef G_SA
#undef G_SB
#undef STAGE
#undef LDA
#undef LDB
#undef MMA
}

DEV void phase_even_a(const Params& p, const bf16_t* P, const float* EXT, float* QKV, float* GB, int tok_lo, int gw, int ngw, int lane) {
    const float* wconv = pin(15); const float* a_log = pin(16); const float* dt_bias = pin(17);
    for (int tok = tok_lo + gw; tok < NT; tok += ngw) {
        int t, base; const float* buf = nullptr;
        if (tok < NP) { t = tok % SEQ; base = tok - t; } else { t = (tok - NP) % DSQ; base = tok - t; buf = pin(3) + (size_t)((tok - NP) / DSQ) * 3 * 1536; }
        for (int seg = 0; seg < 3; ++seg) {
            const int c0 = seg * 512 + lane * 8;
            float y[8];
#pragma unroll
            for (int e = 0; e < 8; ++e) y[e] = 0.f;
            for (int j = 0; j < 4; ++j) {
                const int m = t - 3 + j; float xv[8];
                if (m >= 0) { const u32x4 r = *(const u32x4*)(P + (size_t)(base + m) * EV_N + c0);
                    xv[0] = bflo(r.x); xv[1] = bfhi(r.x); xv[2] = bflo(r.y); xv[3] = bfhi(r.y); xv[4] = bflo(r.z); xv[5] = bfhi(r.z); xv[6] = bflo(r.w); xv[7] = bfhi(r.w); }
                else if (buf) {
#pragma unroll
                    for (int e = 0; e < 8; ++e) xv[e] = buf[(size_t)(3 + m) * 1536 + c0 + e]; }
                else {
#pragma unroll
                    for (int e = 0; e < 8; ++e) xv[e] = 0.f; }
#pragma unroll
                for (int e = 0; e < 8; ++e) y[e] += wconv[j * 1536 + c0 + e] * xv[e];
            }
            float ss = 0.f;
#pragma unroll
            for (int e = 0; e < 8; ++e) { y[e] = siluf_(y[e]); ss += y[e] * y[e]; }
            if (seg < 2) {
                ss = sum16_(ss);
                const float r = rsqrtf(ss + 1e-6f) * (seg == 0 ? 0.08838834764831845f : 1.f);
#pragma unroll
                for (int e = 0; e < 8; ++e) y[e] *= r;
            }
#pragma unroll
            for (int e = 0; e < 8; ++e) QKV[(size_t)tok * 1536 + c0 + e] = y[e];
        }
        if (lane < 4) {
            const float b = EXT[(size_t)tok * 24 + lane], a = EXT[(size_t)tok * 24 + 4 + lane];
            GB[(size_t)tok * 8 + lane] = -__expf(a_log[lane]) * softplusf_(a + dt_bias[lane]);
            GB[(size_t)tok * 8 + 4 + lane] = sigmoidf_(b);
        }
    }
    const int gt = gw * 64 + lane, ngt = ngw * 64;
    for (int i = gt; i < 4 * 3 * 1536; i += ngt) { const int b = i / 4608, r = (i / 1536) % 3, c = i % 1536; pout()[O_CAP + i] = bf2f(P[(size_t)(b * SEQ + 4093 + r) * EV_N + c]); }
    for (int i = gt; i < 128 * 3 * 1536; i += ngt) { const int b = i / 4608, r = (i / 1536) % 3, c = i % 1536; pout()[O_CAS + i] = bf2f(P[(size_t)(NP + b * 8 + 5 + r) * EV_N + c]); }
}

DEV void delta_recurrence(const Params& p, const float* QKV, const float* GB, float* OB, LAS unsigned char* lds, int first_item, int item_stride, int n_items_lo, int n_items_hi) {
    LAS float* kqT = (LAS float*)lds;
    LAS float* red_kv = kqT + 8 * 512;
    LAS float* red_o = red_kv + 512;
    const int tid = opaque_tid(), part = tid >> 7, j = tid & 127;
    for (int item = first_item; item < n_items_hi; item += item_stride) {
        if (item < n_items_lo) continue;
        const int db = (item - 16) >> 2, h = (item - 16) & 3, base = NP + db * DSQ;
        const float* S0 = pin(2) + (size_t)(db * 4 + h) * 16384; float* Sout = pout() + O_DS + (size_t)(db * 4 + h) * 16384;
        float S[32];
#pragma unroll
        for (int i = 0; i < 32; ++i) S[i] = __builtin_nontemporal_load(S0 + (size_t)(part * 32 + i) * 128 + j);
        if (tid < 384) { const int seg = tid >> 7; const int src = seg == 0 ? 512 : (seg == 1 ? 0 : 1024);
            float x[DSQ];
#pragma unroll
            for (int t = 0; t < DSQ; ++t) x[t] = QKV[(size_t)(base + t) * 1536 + src + h * 128 + j];
#pragma unroll
            for (int t = 0; t < DSQ; ++t) kqT[t * 512 + tid] = x[t]; }
        else if (tid < 384 + 2 * DSQ) { const int t = (tid - 384) >> 1, w = (tid - 384) & 1; kqT[t * 512 + 384 + w] = GB[(size_t)(base + t) * 8 + w * 4 + h]; }
        __syncthreads();
        for (int t = 0; t < DSQ; ++t) {
            const size_t tok = (size_t)(base + t);
            LAS float* kq = kqT + t * 512;
            const float decay = __expf(kq[384]), beta = kq[385];
            float pk = 0.f;
#pragma unroll
            for (int i = 0; i < 32; ++i) { S[i] *= decay; pk += S[i] * kq[part * 32 + i]; }
            red_kv[part * 128 + j] = pk;
            lds_barrier();
            const float kvm = (red_kv[j] + red_kv[128 + j]) + (red_kv[256 + j] + red_kv[384 + j]);
            const float dl = beta * (kq[256 + j] - kvm);
            float po = 0.f;
#pragma unroll
            for (int i = 0; i < 32; ++i) { S[i] += kq[part * 32 + i] * dl; po += S[i] * kq[128 + part * 32 + i]; }
            red_o[part * 128 + j] = po;
            lds_barrier();
            if (part == 0) OB[tok * 512 + h * 128 + j] = (red_o[j] + red_o[128 + j]) + (red_o[256 + j] + red_o[384 + j]);
        }
#pragma unroll
        for (int i = 0; i < 32; ++i) __builtin_nontemporal_store(S[i], Sout + (size_t)(part * 32 + i) * 128 + j);
        __syncthreads();
    }
}

DEV bf16x8 lds_frag(LAS unsigned char* base, int row, int stride_b, int kbyte) { return *(const LAS bf16x8*)(base + row * stride_b + kbyte); }
DEV void phase_chunk_prep(const Params& p, const bf16_t* P, const float* EXT, unsigned char* ws, LAS unsigned char* lds) {
    constexpr int QS = 0, KS = 17408, VBT = 34816, KGT = 53248, KTT = 71680, AM = 90112, TM = 106752, GCS = 115968, BETAS = 116224, WCS = 116736;
    constexpr int RS = 272, TS = 144;
    const int tid = opaque_tid(), lane = tid & 63, wave = __builtin_amdgcn_readfirstlane(tid >> 6), fr = lane & 15, fq = lane >> 4;
    const float* wconv = pin(15); const float* a_log = pin(16); const float* dt_bias = pin(17);
    LAS float* gcs = (LAS float*)(lds + GCS); LAS float* betas = (LAS float*)(lds + BETAS); LAS float* Am = (LAS float*)(lds + AM);
    bf16_t* CW = (bf16_t*)(ws + WS_CW); bf16_t* CQ = (bf16_t*)(ws + WS_CQ); bf16_t* CKT = (bf16_t*)(ws + WS_CKT); float* CU = (float*)(ws + WS_CU);
    bf16_t* CI = (bf16_t*)(ws + WS_CI); float* CGL = (float*)(ws + WS_CGL);
    int h_staged = -1;
    for (int item = blockIdx.x; item < 1024; item += gridDim.x) {
        const int bh = item >> 6, n = item & 63, b = bh >> 2, h = bh & 3;
        const size_t ci = (size_t)item;
        if (h != h_staged) {
            for (int i = tid; i < 1536; i += NTHR) { const int sg = i >> 9, j = (i >> 7) & 3, ch = i & 127; ((LAS float*)(lds + WCS))[i] = wconv[j * 1536 + sg * 512 + h * 128 + ch]; }
            h_staged = h; }
        if (wave == 0) {
            const size_t tok = (size_t)b * SEQ + n * 64 + lane;
            const float a = EXT[tok * 24 + 4 + h], bb = EXT[tok * 24 + h];
            float g = -__expf(a_log[h]) * softplusf_(a + dt_bias[h]);
#pragma unroll
            for (int o = 1; o < 64; o <<= 1) { const float t = __shfl_up(g, o); if (lane >= o) g += t; }
            gcs[lane] = g; betas[lane] = sigmoidf_(bb);
            if (lane == 63) CGL[item] = g;
        }
        lds_barrier();
        {
            const int c = tid >> 3, part = tid & 7, t = n * 64 + c;
            const int csw = (((c >> 3) ^ part) << 4) + (c & 7) * 2;
            const float gc = gcs[c], beta = betas[c], glast = gcs[63];
            const float eg = __expf(gc), et = __expf(glast - gc);
#pragma unroll
            for (int seg = 0; seg < 3; ++seg) {
                const int ch0 = seg * 512 + h * 128 + part * 16;
                float y[16];
#pragma unroll
                for (int e = 0; e < 16; ++e) y[e] = 0.f;
#pragma unroll
                for (int j = 0; j < 4; ++j) {
                    const int m = t - 3 + j;
                    if (m >= 0) {
                        const u32x4 r0 = *(const u32x4*)(P + ((size_t)b * SEQ + m) * EV_N + ch0), r1 = *(const u32x4*)(P + ((size_t)b * SEQ + m) * EV_N + ch0 + 8);
                        const float x[16] = {bflo(r0.x), bfhi(r0.x), bflo(r0.y), bfhi(r0.y), bflo(r0.z), bfhi(r0.z), bflo(r0.w), bfhi(r0.w),
                                             bflo(r1.x), bfhi(r1.x), bflo(r1.y), bfhi(r1.y), bflo(r1.z), bfhi(r1.z), bflo(r1.w), bfhi(r1.w)};
                        const LAS float* wl = (const LAS float*)(lds + WCS) + (seg * 4 + j) * 128 + part * 16;
                        const f32x4 w0 = *(const LAS f32x4*)wl, w1 = *(const LAS f32x4*)(wl + 4), w2 = *(const LAS f32x4*)(wl + 8), w3 = *(const LAS f32x4*)(wl + 12);
                        const float wv[16] = {w0.x, w0.y, w0.z, w0.w, w1.x, w1.y, w1.z, w1.w, w2.x, w2.y, w2.z, w2.w, w3.x, w3.y, w3.z, w3.w};
#pragma unroll
                        for (int e = 0; e < 16; ++e) y[e] += wv[e] * x[e];
                    }
                }
                float ss = 0.f;
#pragma unroll
                for (int e = 0; e < 16; ++e) { y[e] = siluf_(y[e]); ss += y[e] * y[e]; }
                if (seg < 2) {
                    ss = sum8_(ss);
                    const float r = rsqrtf(ss + 1e-6f) * (seg == 0 ? 0.08838834764831845f : 1.f);
#pragma unroll
                    for (int e = 0; e < 16; ++e) y[e] *= r;
                }
                if (seg == 0) {
                    u32x4 a0, a1, d0, d1;
                    a0.x = pk2(y[0], y[1]); a0.y = pk2(y[2], y[3]); a0.z = pk2(y[4], y[5]); a0.w = pk2(y[6], y[7]);
                    a1.x = pk2(y[8], y[9]); a1.y = pk2(y[10], y[11]); a1.z = pk2(y[12], y[13]); a1.w = pk2(y[14], y[15]);
                    *(LAS u32x4*)(lds + QS + c * RS + part * 32) = a0; *(LAS u32x4*)(lds + QS + c * RS + part * 32 + 16) = a1;
                    d0.x = pk2(y[0] * eg, y[1] * eg); d0.y = pk2(y[2] * eg, y[3] * eg); d0.z = pk2(y[4] * eg, y[5] * eg); d0.w = pk2(y[6] * eg, y[7] * eg);
                    d1.x = pk2(y[8] * eg, y[9] * eg); d1.y = pk2(y[10] * eg, y[11] * eg); d1.z = pk2(y[12] * eg, y[13] * eg); d1.w = pk2(y[14] * eg, y[15] * eg);
                    { bf16_t* fb = CQ + ((((ci * 4 + (c >> 4)) * 4 + (part >> 1)) * 64 + (part & 1) * 32 + (c & 15)) << 3); *(u32x4*)fb = d0; *(u32x4*)(fb + 128) = d1; }
                } else if (seg == 1) {
                    u32x4 a0, a1;
                    a0.x = pk2(y[0], y[1]); a0.y = pk2(y[2], y[3]); a0.z = pk2(y[4], y[5]); a0.w = pk2(y[6], y[7]);
                    a1.x = pk2(y[8], y[9]); a1.y = pk2(y[10], y[11]); a1.z = pk2(y[12], y[13]); a1.w = pk2(y[14], y[15]);
                    *(LAS u32x4*)(lds + KS + c * RS + part * 32) = a0; *(LAS u32x4*)(lds + KS + c * RS + part * 32 + 16) = a1;
                    const float bg = beta * eg;
#pragma unroll
                    for (int e = 0; e < 16; ++e) { *(LAS bf16_t*)(lds + KGT + (part * 16 + e) * TS + csw) = (bf16_t)f2bf(y[e] * bg);
                                                   *(LAS bf16_t*)(lds + KTT + (part * 16 + e) * TS + csw) = (bf16_t)f2bf(y[e] * et); }
                } else {
#pragma unroll
                    for (int e = 0; e < 16; ++e) *(LAS bf16_t*)(lds + VBT + (part * 16 + e) * TS + csw) = (bf16_t)f2bf(y[e] * beta);
                }
            }
        }
        lds_barrier();
#pragma unroll
        for (int i = 0; i < 2; ++i) { const int id = tid + i * 512, row = id >> 3, s8 = id & 7;
            *(u32x4*)(CKT + ((((ci * 8 + (row >> 4)) * 2 + (s8 >> 2)) * 64 + (s8 & 3) * 16 + (row & 15)) << 3)) = *(const LAS u32x4*)(lds + KTT + row * TS + ((s8 ^ ((row >> 4) & 7)) << 4)); }
        {
            const int rt = wave >> 1;
#pragma unroll
            for (int ti = 0; ti < 2; ++ti) {
                const int ct = (wave & 1) * 2 + ti;
                f32x4 accK = {0.f, 0.f, 0.f, 0.f}, accQ = {0.f, 0.f, 0.f, 0.f};
                __builtin_amdgcn_s_setprio(1);
#pragma unroll
                for (int k4 = 0; k4 < 4; ++k4) {
                    const bf16x8 aK = lds_frag(lds + KS, rt * 16 + fr, RS, k4 * 64 + fq * 16), aQ = lds_frag(lds + QS, rt * 16 + fr, RS, k4 * 64 + fq * 16), bK = lds_frag(lds + KS, ct * 16 + fr, RS, k4 * 64 + fq * 16);
                    accK = __builtin_amdgcn_mfma_f32_16x16x32_bf16(aK, bK, accK, 0, 0, 0);
                    accQ = __builtin_amdgcn_mfma_f32_16x16x32_bf16(bK, aQ, accQ, 0, 0, 0);
                }
                __builtin_amdgcn_s_setprio(0);
                const int s = ct * 16 + fr; const float gs = gcs[s];
#pragma unroll
                for (int jj = 0; jj < 4; ++jj) { const int c_ = rt * 16 + fq * 4 + jj;
                    const float dm = s <= c_ ? __expf(gcs[c_] - gs) : 0.f;
                    Am[c_ * 65 + s] = s < c_ ? betas[c_] * accK[jj] * dm : 0.f; }
                { const int cq = rt * 16 + fr; const float gq = gcs[cq]; float iv[4];
#pragma unroll
                  for (int jj = 0; jj < 4; ++jj) { const int sq = ct * 16 + fq * 4 + jj; iv[jj] = sq <= cq ? accQ[jj] * __expf(gq - gcs[sq]) : 0.f; }
                  u32x2 w; w.x = pk2(iv[0], iv[1]); w.y = pk2(iv[2], iv[3]);
                  *(u32x2*)(CI + ((((ci * 4 + rt) * 2 + (ct >> 1)) * 64 + ((ct & 1) * 2 + (fq >> 1)) * 16 + fr) << 3) + (fq & 1) * 4) = w; }
            }
        }
        lds_barrier();
        {
            const int j = tid >> 3, pp = tid & 7;
            float Tr[8];
#pragma unroll
            for (int q = 0; q < 8; ++q) Tr[q] = 0.f;
#pragma unroll
            for (int i = 0; i < 64; ++i) {
                float s = 0.f;
#pragma unroll
                for (int q = 0; q < 8; ++q) if (8 * q < i) s += Am[i * 65 + pp + 8 * q] * Tr[q];
                s = sum8_(s);
                const float ti = (i == j ? 1.f : 0.f) - s;
                if (pp == (i & 7)) Tr[i >> 3] = ti;
            }
#pragma unroll
            for (int q = 0; q < 8; ++q) *(LAS bf16_t*)(lds + TM + (pp + 8 * q) * TS + j * 2) = (bf16_t)f2bf(Tr[q]);
        }
        lds_barrier();
        {
            const int rt = wave >> 1;
#pragma unroll
            for (int ti = 0; ti < 4; ++ti) {
                const int ct = (wave & 1) * 4 + ti;
                f32x4 accU = {0.f, 0.f, 0.f, 0.f}, accW = {0.f, 0.f, 0.f, 0.f};
                __builtin_amdgcn_s_setprio(1);
#pragma unroll
                for (int k2 = 0; k2 < 2; ++k2) {
                    const bf16x8 a = lds_frag(lds + TM, rt * 16 + fr, TS, k2 * 64 + fq * 16), bU = lds_frag(lds + VBT, ct * 16 + fr, TS, ((k2 * 4 + fq) ^ ct) << 4), bW = lds_frag(lds + KGT, ct * 16 + fr, TS, ((k2 * 4 + fq) ^ ct) << 4);
                    accU = __builtin_amdgcn_mfma_f32_16x16x32_bf16(a, bU, accU, 0, 0, 0);
                    accW = __builtin_amdgcn_mfma_f32_16x16x32_bf16(bW, a, accW, 0, 0, 0);
                }
                __builtin_amdgcn_s_setprio(0);
                *(f32x4*)(CU + ((((ci * 4 + rt) * 8 + ct) * 64 + lane) << 2)) = accU;
                { u32x2 w; w.x = pk2(accW[0], accW[1]); w.y = pk2(accW[2], accW[3]);
                  *(u32x2*)(CW + ((((ci * 4 + rt) * 4 + (ct >> 1)) * 64 + ((ct & 1) * 2 + (fq >> 1)) * 16 + fr) << 3) + (fq & 1) * 4) = w; }
            }
        }
        lds_barrier();
    }
}

struct ScanFrag { bf16x8 wA[4], qA[4], iA[2], kA[2]; f32x4 u[2]; float gl; };
DEV void scan_load(ScanFrag& f, const bf16_t* CW, const bf16_t* CQ, const bf16_t* CKT, const float* CU, const bf16_t* CI, const float* CGL, size_t ci, bool act, int wave, int sl, int lane) {
    if (act) {
#pragma unroll
        for (int k4 = 0; k4 < 4; ++k4) { f.wA[k4] = *(const bf16x8*)(CW + ((((ci * 4 + wave) * 4 + k4) * 64 + lane) << 3)); f.qA[k4] = *(const bf16x8*)(CQ + ((((ci * 4 + wave) * 4 + k4) * 64 + lane) << 3)); }
#pragma unroll
        for (int k2 = 0; k2 < 2; ++k2) f.iA[k2] = *(const bf16x8*)(CI + ((((ci * 4 + wave) * 2 + k2) * 64 + lane) << 3));
#pragma unroll
        for (int ct = 0; ct < 2; ++ct) f.u[ct] = *(const f32x4*)(CU + ((((ci * 4 + wave) * 8 + sl * 2 + ct) * 64 + lane) << 2));
    }
#pragma unroll
    for (int k2 = 0; k2 < 2; ++k2) f.kA[k2] = *(const bf16x8*)(CKT + ((((ci * 8 + wave) * 2 + k2) * 64 + lane) << 3));
    f.gl = CGL[ci];
}
DEV void phase_scan(const Params& p, unsigned char* ws, float* OB, LAS unsigned char* lds, int unit) {
    constexpr int ST = 0, VNT = 8704, SRS = 272, VRS = 144;
    const int tid = opaque_tid(), lane = tid & 63, wave = __builtin_amdgcn_readfirstlane(tid >> 6), fr = lane & 15, fq = lane >> 4;
    const int bh = (unit & 7) + 8 * (unit >> 5), sl = (unit >> 3) & 3, b = bh >> 2, h = bh & 3; const bool act = wave < 4;
    const bf16_t* CW = (const bf16_t*)(ws + WS_CW); const bf16_t* CQ = (const bf16_t*)(ws + WS_CQ); const bf16_t* CKT = (const bf16_t*)(ws + WS_CKT); const float* CU = (const float*)(ws + WS_CU);
    const bf16_t* CI = (const bf16_t*)(ws + WS_CI); const float* CGL = (const float*)(ws + WS_CGL);
    for (int i = tid; i < (8704 + 4608) / 4; i += NTHR) ((LAS unsigned*)lds)[i] = 0u;
    f32x4 accS[2] = {{0.f, 0.f, 0.f, 0.f}, {0.f, 0.f, 0.f, 0.f}};
    ScanFrag F0, F1, F2;
    scan_load(F0, CW, CQ, CKT, CU, CI, CGL, (size_t)bh * 64, act, wave, sl, lane);
    scan_load(F1, CW, CQ, CKT, CU, CI, CGL, (size_t)bh * 64 + 1, act, wave, sl, lane);
    __syncthreads();
    auto compute = [&](const ScanFrag& cur, int n) {
        f32x4 ao[2] = {{0.f, 0.f, 0.f, 0.f}, {0.f, 0.f, 0.f, 0.f}};
        if (act) {
            f32x4 av[2] = {{0.f, 0.f, 0.f, 0.f}, {0.f, 0.f, 0.f, 0.f}};
#pragma unroll
            for (int k4 = 0; k4 < 4; ++k4)
#pragma unroll
                for (int ct = 0; ct < 2; ++ct) { const bf16x8 bS = lds_frag(lds + ST, ct * 16 + fr, SRS, k4 * 64 + fq * 16);
                    av[ct] = __builtin_amdgcn_mfma_f32_16x16x32_bf16(cur.wA[k4], bS, av[ct], 0, 0, 0); ao[ct] = __builtin_amdgcn_mfma_f32_16x16x32_bf16(cur.qA[k4], bS, ao[ct], 0, 0, 0); }
#pragma unroll
            for (int ct = 0; ct < 2; ++ct) { u32x2 w; w.x = pk2(cur.u[ct][0] - av[ct][0], cur.u[ct][1] - av[ct][1]); w.y = pk2(cur.u[ct][2] - av[ct][2], cur.u[ct][3] - av[ct][3]);
                *(LAS u32x2*)(lds + VNT + (ct * 16 + fr) * VRS + (wave * 16 + fq * 4) * 2) = w; }
        }
        lds_barrier();
        if (act) {
#pragma unroll
            for (int ct = 0; ct < 2; ++ct) {
#pragma unroll
                for (int k2 = 0; k2 < 2; ++k2) { const bf16x8 bV = lds_frag(lds + VNT, ct * 16 + fr, VRS, k2 * 64 + fq * 16); ao[ct] = __builtin_amdgcn_mfma_f32_16x16x32_bf16(cur.iA[k2], bV, ao[ct], 0, 0, 0); }
#pragma unroll
                for (int jj = 0; jj < 4; ++jj) OB[((size_t)b * SEQ + n * 64 + wave * 16 + fq * 4 + jj) * 512 + h * 128 + sl * 32 + ct * 16 + fr] = ao[ct][jj];
            }
        }
        const float dec = __expf(cur.gl);
#pragma unroll
        for (int c2 = 0; c2 < 2; ++c2) {
            accS[c2] *= dec;
#pragma unroll
            for (int k2 = 0; k2 < 2; ++k2) { const bf16x8 bV = lds_frag(lds + VNT, c2 * 16 + fr, VRS, k2 * 64 + fq * 16); accS[c2] = __builtin_amdgcn_mfma_f32_16x16x32_bf16(cur.kA[k2], bV, accS[c2], 0, 0, 0); }
            u32x2 w; w.x = pk2(accS[c2][0], accS[c2][1]); w.y = pk2(accS[c2][2], accS[c2][3]);
            *(LAS u32x2*)(lds + ST + (c2 * 16 + fr) * SRS + (wave * 16 + fq * 4) * 2) = w;
        }
        lds_barrier();
    };
#define SCAN_STEP(n, CUR, NX2) do { if ((n) + 2 < 64) scan_load(NX2, CW, CQ, CKT, CU, CI, CGL, (size_t)bh * 64 + (n) + 2, act, wave, sl, lane); compute(CUR, (n)); } while (0)
    for (int n = 0; n < 63; n += 3) { SCAN_STEP(n, F0, F2); SCAN_STEP(n + 1, F1, F0); SCAN_STEP(n + 2, F2, F1); }
    SCAN_STEP(63, F0, F2);
#undef SCAN_STEP
    float* Sout = pout() + O_DP + (size_t)bh * 16384;
#pragma unroll
    for (int c2 = 0; c2 < 2; ++c2)
#pragma unroll
        for (int jj = 0; jj < 4; ++jj) Sout[(size_t)(wave * 16 + fq * 4 + jj) * 128 + sl * 32 + c2 * 16 + fr] = accS[c2][jj];
    __syncthreads();
}

DEV void phase_even_c(const Params& p, const bf16_t* P, const float* OB, bf16_t* MIX, int gw, int ngw, int lane) {
    const float* gn = pin(18); const float* wb = pin(19);
    float gnv[8], wbv[3][8];
#pragma unroll
    for (int e = 0; e < 8; ++e) { gnv[e] = gn[(lane * 8 + e) & 127];
#pragma unroll
        for (int j = 0; j < 3; ++j) wbv[j][e] = wb[j * 512 + lane * 8 + e]; }
    for (int tok = gw; tok < NT; tok += ngw) {
        int t, base; const float* buf = nullptr;
        if (tok < NP) { t = tok % SEQ; base = tok - t; } else { t = (tok - NP) % DSQ; base = tok - t; buf = pin(4) + (size_t)((tok - NP) / DSQ) * 2 * 512; }
        const int c0 = lane * 8;
        const f32x4 oa = *(const f32x4*)(OB + (size_t)tok * 512 + c0), ob = *(const f32x4*)(OB + (size_t)tok * 512 + c0 + 4);
        const u32x4 zr = *(const u32x4*)(P + (size_t)tok * EV_N + 1536 + c0);
        const u32x4 br = *(const u32x4*)(P + (size_t)tok * EV_N + 2560 + c0);
        u32x4 hrs[3], crs[3];
#pragma unroll
        for (int j = 0; j < 3; ++j) { const int m = t - 2 + j;
            if (m >= 0) { hrs[j] = *(const u32x4*)(P + (size_t)(base + m) * EV_N + 2048 + c0); crs[j] = *(const u32x4*)(P + (size_t)(base + m) * EV_N + 3072 + c0); }
            else { hrs[j] = (u32x4){0u, 0u, 0u, 0u}; crs[j] = hrs[j]; } }
        {
            float o[8] = {oa.x, oa.y, oa.z, oa.w, ob.x, ob.y, ob.z, ob.w}; float ss = 0.f;
#pragma unroll
            for (int e = 0; e < 8; ++e) ss += o[e] * o[e];
            ss = sum16_(ss);
            const float r = rsqrtf(ss * (1.f / 128.f) + 1e-6f);
            const float z[8] = {bflo(zr.x), bfhi(zr.x), bflo(zr.y), bfhi(zr.y), bflo(zr.z), bfhi(zr.z), bflo(zr.w), bfhi(zr.w)};
            float w[8];
#pragma unroll
            for (int e = 0; e < 8; ++e) w[e] = o[e] * r * gnv[e] * siluf_(z[e]);
            u32x4 st; st.x = pk2(w[0], w[1]); st.y = pk2(w[2], w[3]); st.z = pk2(w[4], w[5]); st.w = pk2(w[6], w[7]);
            *(u32x4*)(MIX + (size_t)tok * D + c0) = st;
        }
        {
            float y[8], cxl[8];
#pragma unroll
            for (int e = 0; e < 8; ++e) { y[e] = 0.f; cxl[e] = 0.f; }
#pragma unroll
            for (int j = 0; j < 3; ++j) {
                const int m = t - 2 + j; float cx[8];
                if (m >= 0) { const u32x4 hr = hrs[j]; const u32x4 cr = crs[j];
                    cx[0] = bflo(hr.x) * bflo(cr.x); cx[1] = bfhi(hr.x) * bfhi(cr.x); cx[2] = bflo(hr.y) * bflo(cr.y); cx[3] = bfhi(hr.y) * bfhi(cr.y);
                    cx[4] = bflo(hr.z) * bflo(cr.z); cx[5] = bfhi(hr.z) * bfhi(cr.z); cx[6] = bflo(hr.w) * bflo(cr.w); cx[7] = bfhi(hr.w) * bfhi(cr.w); }
                else if (buf) {
#pragma unroll
                    for (int e = 0; e < 8; ++e) cx[e] = buf[(size_t)(2 + m) * 512 + c0 + e]; }
                else {
#pragma unroll
                    for (int e = 0; e < 8; ++e) cx[e] = 0.f; }
#pragma unroll
                for (int e = 0; e < 8; ++e) { y[e] += wbv[j][e] * cx[e]; cxl[e] = cx[e]; }
            }
            const float gb[8] = {bflo(br.x), bfhi(br.x), bflo(br.y), bfhi(br.y), bflo(br.z), bfhi(br.z), bflo(br.w), bfhi(br.w)};
            u32x4 st; st.x = pk2(gb[0] * y[0], gb[1] * y[1]); st.y = pk2(gb[2] * y[2], gb[3] * y[3]); st.z = pk2(gb[4] * y[4], gb[5] * y[5]); st.w = pk2(gb[6] * y[6], gb[7] * y[7]);
            *(u32x4*)(MIX + (size_t)tok * D + 512 + c0) = st;
            if (tok < NP) { if (t >= SEQ - 2) {
#pragma unroll
                for (int e = 0; e < 8; ++e) pout()[O_CBP + (size_t)((tok / SEQ) * 2 + (t - (SEQ - 2))) * 512 + c0 + e] = cxl[e]; } }
            else if (t >= DSQ - 2) {
#pragma unroll
                for (int e = 0; e < 8; ++e) pout()[O_CBS + (size_t)(((tok - NP) / DSQ) * 2 + (t - (DSQ - 2))) * 512 + c0 + e] = cxl[e]; }
        }
    }
}

DEV void phase_odd_a(const Params& p, const bf16_t* P, const float* EXT, float* GATES, bf16_t* UG, bf16_t* VLN, int gw, int ngw, int lane, int tok_end) {
    const float* ln_g = pin(27); const float* ln_b = pin(28);
    float* out = pout();
    const f32x4 g0 = *(const f32x4*)(ln_g + lane * 8), g1 = *(const f32x4*)(ln_g + lane * 8 + 4), b0 = *(const f32x4*)(ln_b + lane * 8), b1 = *(const f32x4*)(ln_b + lane * 8 + 4);
    for (int tok = gw; tok < tok_end; tok += ngw) {
        const int c0 = lane * 8;
        const float ext = lane < 24 ? EXT[(size_t)tok * 24 + lane] : 0.f;
        u32x4 ka = {0u, 0u, 0u, 0u}, kb_ = ka;
        if (lane < 48) { ka = *(const u32x4*)(P + (size_t)tok * OD_N + 512 + lane * 16); kb_ = *(const u32x4*)(P + (size_t)tok * OD_N + 512 + lane * 16 + 8); }
        const u32x4 ur = *(const u32x4*)(P + (size_t)tok * OD_N + 1280 + c0); const u32x4 vr = *(const u32x4*)(P + (size_t)tok * OD_N + 1792 + c0);
        if (lane < 24) GATES[(size_t)tok * 24 + lane] = sigmoidf_(ext);
        if (lane < 48) {
            const int br = lane >> 4, idx = (lane & 15) * 16;
            float* dst = nullptr;
            if (tok < NP) { const int t = tok % SEQ;
                if (br == 0) dst = out + O_CMP + (size_t)tok * 256 + idx;
                else if (br == 1) dst = out + O_SLP + (size_t)tok * 256 + idx;
                else if (t >= SEQ - 512) dst = out + O_WNP + ((size_t)(tok / SEQ) * 512 + (t - (SEQ - 512))) * 256 + idx;
            } else { const int s = tok - NP;
                if (br == 0) dst = out + O_CMS + (size_t)s * 256 + idx;
                else if (br == 1) dst = out + O_SLS + (size_t)s * 256 + idx;
                else dst = out + O_WNS + ((size_t)(s / DSQ) * 512 + 504 + (s % DSQ)) * 256 + idx; }
            if (dst) { const u32x4 a = ka, b = kb_;
                __builtin_nontemporal_store((f32x4){bflo(a.x), bfhi(a.x), bflo(a.y), bfhi(a.y)}, (f32x4*)dst); __builtin_nontemporal_store((f32x4){bflo(a.z), bfhi(a.z), bflo(a.w), bfhi(a.w)}, (f32x4*)dst + 1);
                __builtin_nontemporal_store((f32x4){bflo(b.x), bfhi(b.x), bflo(b.y), bfhi(b.y)}, (f32x4*)dst + 2); __builtin_nontemporal_store((f32x4){bflo(b.z), bfhi(b.z), bflo(b.w), bfhi(b.w)}, (f32x4*)dst + 3); }
        }
        const float uu[8] = {bflo(ur.x), bfhi(ur.x), bflo(ur.y), bfhi(ur.y), bflo(ur.z), bfhi(ur.z), bflo(ur.w), bfhi(ur.w)};
        float vv[8] = {bflo(vr.x), bfhi(vr.x), bflo(vr.y), bfhi(vr.y), bflo(vr.z), bfhi(vr.z), bflo(vr.w), bfhi(vr.w)};
        float s = 0.f, ug[8];
#pragma unroll
        for (int e = 0; e < 8; ++e) { ug[e] = geluf_(uu[e]); vv[e] = geluf_(vv[e]); s += vv[e]; }
        { u32x4 w; w.x = pk2(ug[0], ug[1]); w.y = pk2(ug[2], ug[3]); w.z = pk2(ug[4], ug[5]); w.w = pk2(ug[6], ug[7]); *(u32x4*)(UG + (size_t)tok * 512 + c0) = w; }
        const float mu = wave_sum(s) * (1.f / 512.f); float q = 0.f;
#pragma unroll
        for (int e = 0; e < 8; ++e) { vv[e] -= mu; q += vv[e] * vv[e]; }
        const float r = rsqrtf(wave_sum(q) * (1.f / 512.f) + 1e-6f);
        const f32x4 o0 = (f32x4){vv[0], vv[1], vv[2], vv[3]} * r * g0 + b0, o1 = (f32x4){vv[4], vv[5], vv[6], vv[7]} * r * g1 + b1;
        { u32x4 w; w.x = pk2(o0[0], o0[1]); w.y = pk2(o0[2], o0[3]); w.z = pk2(o1[0], o1[1]); w.w = pk2(o1[2], o1[3]); *(u32x4*)(VLN + (size_t)tok * 512 + c0) = w; }
        if (tok >= NP) { ((f32x4*)(out + O_DV + (size_t)(tok - NP) * 512 + c0))[0] = o0; ((f32x4*)(out + O_DV + (size_t)(tok - NP) * 512 + c0))[1] = o1; }
    }
}
constexpr unsigned WINCOPY_N4 = 128u * 504u * 64u;
DEV void phase_win_copy(unsigned lo, unsigned hi) {
    const int tid = opaque_tid();
    const float* src_ = pin(7); float* out = pout();
    const unsigned n4 = hi;
    const unsigned step = NTHR;
    unsigned i0 = lo + tid;
    for (; i0 + 7u * step < n4; i0 += 8u * step) {
        f32x4 v[8];
#pragma unroll
        for (int u = 0; u < 8; ++u) { const unsigned i = i0 + u * step; const unsigned db = i / (504u * 64u), r = i % (504u * 64u); v[u] = __builtin_nontemporal_load((const f32x4*)(src_ + (size_t)db * 512 * 256 + 8 * 256) + r); }
#pragma unroll
        for (int u = 0; u < 8; ++u) { const unsigned i = i0 + u * step; const unsigned db = i / (504u * 64u), r = i % (504u * 64u); __builtin_nontemporal_store(v[u], (f32x4*)(out + O_WNS + (size_t)db * 512 * 256) + r); }
    }
    for (; i0 < n4; i0 += step) { const unsigned db = i0 / (504u * 64u), r = i0 % (504u * 64u); ((f32x4*)(out + O_WNS + (size_t)db * 512 * 256))[r] = ((const f32x4*)(src_ + (size_t)db * 512 * 256 + 8 * 256))[r]; }
}

DEV void phase_vtp(const bf16_t* P, bf16_t* VTP, LAS unsigned char* lds) {
    const int tid = opaque_tid();
    for (int item = blockIdx.x; item < 256; item += gridDim.x) {
        const int seq = item >> 6, tb = item & 63;
        { const int tok = tid >> 3, part = tid & 7, v = part >> 1, half = part & 1;
          const bf16_t* src_ = P + ((size_t)seq * SEQ + tb * 64 + tok) * OD_N + 512 + ((v >> 1) + 1) * 256 + 128 + (v & 1) * 64 + half * 32;
#pragma unroll
          for (int i = 0; i < 4; ++i) { const u32x4 w = *(const u32x4*)(src_ + i * 8); const unsigned ww[4] = {w.x, w.y, w.z, w.w};
#pragma unroll
              for (int e = 0; e < 4; ++e) { const int dh = half * 32 + i * 8 + 2 * e;
                  *(LAS bf16_t*)(lds + ((v * 64 + dh) * 72 + tok) * 2) = (bf16_t)(ww[e] & 0xffffu); *(LAS bf16_t*)(lds + ((v * 64 + dh + 1) * 72 + tok) * 2) = (bf16_t)(ww[e] >> 16); } } }
        lds_barrier();
#pragma unroll
        for (int i = 0; i < 4; ++i) { const int id = tid + i * 512, v = id >> 9, dh = (id >> 3) & 63, sg = id & 7;
            *(u32x4*)(VTP + ((size_t)(((v >> 1) * 4 + seq) * 2 + (v & 1)) * 64 + dh) * SEQ + tb * 64 + sg * 8) = *(const LAS u32x4*)(lds + ((v * 64 + dh) * 72 + sg * 8) * 2); }
        lds_barrier();
    }
}

struct RowRef { const float* f; const bf16_t* h; };
DEV float rr_get(const RowRef& r, int d) { return r.f ? r.f[d] : bf2f(r.h[d]); }
DEV RowRef kv_row(const Params& p, const bf16_t* P, int seqidx, int br, int kv, int g, int pos) {
    RowRef r; r.f = nullptr; r.h = nullptr;
    const int co = 512 + br * 256 + kv * 128 + g * 64;
    if (seqidx < 4) { r.h = P + ((size_t)seqidx * SEQ + pos) * OD_N + co; return r; }
    const int db = seqidx - 4;
    if (pos >= PAST) { r.h = P + ((size_t)NP + db * DSQ + (pos - PAST)) * OD_N + co; return r; }
    if (br == 2) { r.f = pin(7) + ((((size_t)db * 512 + (pos - (PAST - 512))) * 2 + kv) * 2 + g) * 64; return r; }
    const int page = ppt()[db * 16 + (pos >> 7)];
    r.f = (br == 0 ? pin(5) : pin(6)) + ((((size_t)page * 128 + (pos & 127)) * 2 + kv) * 2 + g) * 64;
    return r;
}
DEV size_t vct_off(int seqidx, int g) { return seqidx < 4 ? (size_t)(seqidx * 2 + g) * 64 * 256 : (size_t)4 * 2 * 64 * 256 + (size_t)((seqidx - 4) * 2 + g) * 64 * 128; }
DEV size_t kc_off(int seqidx, int g, int j) { return seqidx < 4 ? ((size_t)(seqidx * 2 + g) * 256 + j) * 64 : ((size_t)4 * 2 * 256 + (size_t)((seqidx - 4) * 2 + g) * 128 + j) * 64; }

DEV void phase_compress_naive(const Params& p, const bf16_t* P, float* KCF, LAS unsigned char* lds, int gw, int ngw, int lane, int wave) {
    LAS float* hid = (LAS float*)lds + wave * 128;
    const float* pe = pin(22); const float* w1 = pin(23); const float* w2 = pin(24);
    const int n_p = 4 * 2 * 255 * 2, n_s = 128 * 2 * 127 * 2;
    for (int it = gw; it < n_p + n_s; it += ngw) {
        int seqidx, g, j, kv;
        if (it < n_p) { kv = it & 1; int r = it >> 1; j = r % 255; r /= 255; g = r & 1; seqidx = r >> 1; }
        else { int r = it - n_p; kv = r & 1; r >>= 1; j = r % 127; r /= 127; g = r & 1; seqidx = 4 + (r >> 1); }
        float a0 = 0.f, a1 = 0.f;
        for (int s = 0; s < 32; ++s) {
            const RowRef rr = kv_row(p, P, seqidx, 0, kv, g, 16 * j + s);
            for (int d = 0; d < 64; ++d) {
                const float x = rr_get(rr, d) + pe[(size_t)(kv * 32 + s) * 64 + d];
                const float* wr_ = w1 + ((size_t)(kv * 32 + s) * 64 + d) * 128;
                a0 += x * wr_[lane]; a1 += x * wr_[lane + 64];
            }
        }
        hid[lane] = siluf_(a0); hid[lane + 64] = siluf_(a1);
        asm volatile("s_waitcnt lgkmcnt(0)" ::: "memory");
        float o = 0.f;
        for (int h = 0; h < 128; ++h) o += hid[h] * w2[(size_t)kv * 8192 + h * 64 + lane];
        KCF[(size_t)kv * KC_ELEMS + kc_off(seqidx, g, j) + lane] = o;
        asm volatile("s_waitcnt lgkmcnt(0)" ::: "memory");
    }
}

DEV void phase_attn_naive(const Params& p, const bf16_t* P, const float* KCF, const float* GATES, bf16_t* MIX, LAS unsigned char* lds, int gw, int ngw, int lane, int wave) {
    LAS float* qs = (LAS float*)lds + wave * 1216;
    LAS float* pbuf = qs + 64;
    LAS float* pc = pbuf + 1024;
    LAS int* blk = (LAS int*)pc;
    const float NEG = -1e30f;
    for (int it = gw; it < 4 * 2 * SEQ + 128 * 2 * DSQ; it += ngw) {
        int seqidx, g, ti, qpos, tok, nc, ns, wstart;
        if (it < 4 * 2 * SEQ) { ti = it % SEQ; const int r = it / SEQ; g = r & 1; seqidx = r >> 1; qpos = ti; tok = seqidx * SEQ + ti; nc = 255; ns = 64; wstart = 0; }
        else { const int r0 = it - 4 * 2 * SEQ; ti = r0 % DSQ; const int r = r0 / DSQ; g = r & 1; seqidx = 4 + (r >> 1); qpos = PAST + ti; tok = NP + (seqidx - 4) * DSQ + ti; nc = 127; ns = 33; wstart = PAST - 512; }
        const int cur = qpos >> 6;
        float imp = 0.f; float oc[4];
        for (int r = 0; r < 4; ++r) {
            const int h = g * 4 + r; const float slope = exp2f(-(float)(h + 1));
            qs[lane] = bf2f(P[(size_t)tok * OD_N + h * 64 + lane]) * 0.125f;
            asm volatile("s_waitcnt lgkmcnt(0)" ::: "memory");
            float sc[4]; float mx = NEG;
            for (int jj = 0; jj < 4; ++jj) { const int j = jj * 64 + lane; const bool ok = j < nc && 16 * j + 31 <= qpos; float s = NEG;
                if (ok) { const float* kr = KCF + kc_off(seqidx, g, j); s = 0.f; for (int d = 0; d < 64; ++d) s += qs[d] * kr[d]; s -= slope * (float)(qpos - (16 * j + 31)); }
                sc[jj] = s; mx = fmaxf(mx, s); }
            for (int o = 1; o < 64; o <<= 1) mx = fmaxf(mx, __shfl_xor(mx, o));
            float sum = 0.f;
            for (int jj = 0; jj < 4; ++jj) { sc[jj] = sc[jj] > -1e29f ? __expf(sc[jj] - mx) : 0.f; sum += sc[jj]; }
            sum = fmaxf(wave_sum(sum), 1e-30f);
            for (int jj = 0; jj < 4; ++jj) pbuf[jj * 64 + lane] = sc[jj] / sum;
            asm volatile("s_waitcnt lgkmcnt(0)" ::: "memory");
            float o = 0.f;
            for (int j = 0; j < nc; ++j) o += pbuf[j] * KCF[KC_ELEMS + kc_off(seqidx, g, j) + lane];
            oc[r] = o;
            for (int j = 4 * lane - 1; j <= 4 * lane + 3; ++j) if (j >= 0 && j < nc) {
                const int lo = max(16 * j, 64 * lane), hi = min(16 * j + 32, 64 * lane + 64); if (hi > lo) imp += pbuf[j] * ((float)(hi - lo) * (1.f / 32.f)); }
            asm volatile("s_waitcnt lgkmcnt(0)" ::: "memory");
        }
        const bool valid = lane < ns && lane <= cur; const bool forced = lane == 0 || lane == cur || lane == cur - 1;
        const float score = valid ? (forced ? 1e4f : imp) : NEG;
        int rank = 0;
        for (int s2 = 0; s2 < ns; ++s2) { const float o = __shfl(score, s2); rank += (o > score || (o == score && s2 < lane)) ? 1 : 0; }
        const unsigned long long selmask = __ballot(valid && rank < 16);
        if (lane == 0) { int n = 0; for (int s2 = 0; s2 < 64; ++s2) if ((selmask >> s2) & 1ull) blk[n++] = s2; for (; n < 16; ++n) blk[n] = -1; }
        asm volatile("s_waitcnt lgkmcnt(0)" ::: "memory");
        const int nsel = __popcll(selmask);
        for (int r = 0; r < 4; ++r) {
            const int h = g * 4 + r; const float slope = exp2f(-(float)(h + 1));
            qs[lane] = bf2f(P[(size_t)tok * OD_N + h * 64 + lane]) * 0.125f;
            asm volatile("s_waitcnt lgkmcnt(0)" ::: "memory");
            float res[2];
            for (int brn = 1; brn <= 2; ++brn) {
                const int wlo = max(wstart, qpos - 511);
                const int nkeys = brn == 1 ? nsel * 64 : (qpos - wlo + 1);
                float mx = NEG;
                for (int i0 = 0; i0 < nkeys; i0 += 64) { const int i = i0 + lane; float s = NEG;
                    if (i < nkeys) { const int pos = brn == 1 ? blk[i >> 6] * 64 + (i & 63) : wlo + i;
                        if (pos <= qpos) { const RowRef kr = kv_row(p, P, seqidx, brn, 0, g, pos); s = 0.f; for (int d = 0; d < 64; ++d) s += qs[d] * rr_get(kr, d); s -= slope * (float)(qpos - pos); } }
                    if (i < 1024) pbuf[i] = s; mx = fmaxf(mx, s); }
                for (int o = 1; o < 64; o <<= 1) mx = fmaxf(mx, __shfl_xor(mx, o));
                asm volatile("s_waitcnt lgkmcnt(0)" ::: "memory");
                float sum = 0.f;
                for (int i0 = 0; i0 < nkeys; i0 += 64) { const int i = i0 + lane; if (i < nkeys) { const float s = pbuf[i]; const float e = s > -1e29f ? __expf(s - mx) : 0.f; pbuf[i] = e; sum += e; } }
                sum = fmaxf(wave_sum(sum), 1e-30f);
                asm volatile("s_waitcnt lgkmcnt(0)" ::: "memory");
                float o = 0.f;
                for (int i = 0; i < nkeys; ++i) { const float e = pbuf[i]; if (e != 0.f) { const int pos = brn == 1 ? blk[i >> 6] * 64 + (i & 63) : wlo + i; const RowRef vr = kv_row(p, P, seqidx, brn, 1, g, pos); o += e * rr_get(vr, lane); } }
                res[brn - 1] = o / sum;
                asm volatile("s_waitcnt lgkmcnt(0)" ::: "memory");
            }
            const float* gt = GATES + (size_t)tok * 24 + h * 3;
            MIX[(size_t)tok * D + h * 64 + lane] = (bf16_t)f2bf(gt[0] * oc[r] + gt[1] * res[0] + gt[2] * res[1]);
        }
    }
}

template <bool SMP>
DEV void phase_compress(const Params& p, const bf16_t* P, unsigned char* ws, LAS unsigned char* lds, int first, int stride, int item_end) {
    constexpr int CA0 = 0, CA1 = 17920, PB = 35840, HID = 68608, ARS = 272;
    const int tid = opaque_tid(), lane = tid & 63, wave = __builtin_amdgcn_readfirstlane(tid >> 6), fr = lane & 15, fq = lane >> 4;
    const bf16_t* W1t = (const bf16_t*)(ws + WS_WC1); const bf16_t* W2t = (const bf16_t*)(ws + WS_WC2); const float* cb = (const float*)(ws + WS_CBIAS);
    const int srow = tid >> 3, piece = tid & 7, sl = piece >> 2, d0 = (piece & 3) * 16;
    const int q16 = tid & 15, segid = tid >> 4, slS = segid & 1, rS = segid >> 1;
    const int colbase = (wave < 4 ? 32 * wave : 128 + 32 * (wave - 4)), shift = wave < 4 ? 0 : 1;
    const bf16_t* W1w = W1t + ((size_t)colbase + fr) * 1024 + fq * 8;
    auto loadB = [&](bf16x8 (&bb)[4][2], int kvsel, int c8) {
#pragma unroll
        for (int k4 = 0; k4 < 4; ++k4)
#pragma unroll
            for (int ct = 0; ct < 2; ++ct) bb[k4][ct] = *(const bf16x8*)(W1w + ((size_t)kvsel * 256 + ct * 16) * 1024 + c8 * 128 + k4 * 32);
    };
    bf16x8 bA[4][2], bB[4][2];
    if (first < item_end) loadB(bA, first & 1, 0);
    for (int item = first; item < item_end; item += stride) {
        int kv, g, nb, seqidx, nh;
        if (!SMP) { kv = item & 1; g = (item >> 1) & 1; nb = (item >> 2) & 3; seqidx = item >> 4; nh = 256; }
        else { const int i2 = item - 64; kv = i2 & 1; g = (i2 >> 1) & 1; nb = (i2 >> 2) & 1; seqidx = 4 + (i2 >> 3); nh = 128; }
        const int nc = nh - 1;
        f32x4 acc[4][2];
#pragma unroll
        for (int rt = 0; rt < 4; ++rt)
#pragma unroll
            for (int ct = 0; ct < 2; ++ct) acc[rt][ct] = (f32x4){0.f, 0.f, 0.f, 0.f};
        auto mm = [&](LAS unsigned char* buf, bf16x8 (&bc)[4][2]) {
#pragma unroll
            for (int k4 = 0; k4 < 4; ++k4) {
#pragma unroll
                for (int rt = 0; rt < 4; ++rt) { const bf16x8 a = lds_frag(buf, rt * 16 + fr + shift, ARS, k4 * 64 + fq * 16);
#pragma unroll
                    for (int ct = 0; ct < 2; ++ct) acc[rt][ct] = __builtin_amdgcn_mfma_f32_16x16x32_bf16(a, bc[k4][ct], acc[rt][ct], 0, 0, 0); }
            }
        };
        if constexpr (SMP) {
            int pg[4];
#pragma unroll
            for (int i = 0; i < 4; ++i) pg[i] = ppt()[(seqidx - 4) * 16 + ((nb * 64 + i * 16 + rS) >> 3)];
            const bool has_e = nb * 64 + 64 < nh;
            const int page_e = has_e ? ppt()[(seqidx - 4) * 16 + ((nb * 64 + 64) >> 3)] : 0;
            const float* cbase = pin(5) + (size_t)(kv * 2 + g) * 64 + 4 * q16;
            auto fetchS = [&](int c8, f32x4 (&v)[4], f32x4& ve) {
                const int tap = 2 * c8 + slS;
#pragma unroll
                for (int i = 0; i < 4; ++i) { const int pos = 16 * (nb * 64 + i * 16 + rS) + tap; v[i] = *(const f32x4*)(cbase + ((size_t)pg[i] * 128 + (pos & 127)) * 256); }
                if (tid < 32) { if (has_e) { const int pos = 16 * (nb * 64 + 64) + tap; ve = *(const f32x4*)(cbase + ((size_t)page_e * 128 + (pos & 127)) * 256); } else ve = (f32x4){0.f, 0.f, 0.f, 0.f}; }
            };
            f32x4 ra[4], rb[4], ea, eb;
            fetchS(0, ra, ea); fetchS(1, rb, eb);
            auto chunkS = [&](int c8, f32x4 (&v)[4], f32x4& ve, bf16x8 (&bc)[4][2], bf16x8 (&bn)[4][2]) {
                LAS unsigned char* buf = lds + ((c8 & 1) ? CA1 : CA0);
#pragma unroll
                for (int i = 0; i < 4; ++i) { u32x2 w; w.x = pk2(v[i].x, v[i].y); w.y = pk2(v[i].z, v[i].w); *(LAS u32x2*)(buf + (i * 16 + rS) * ARS + (slS * 64 + 4 * q16) * 2) = w; }
                if (tid < 32) { u32x2 w; w.x = pk2(ve.x, ve.y); w.y = pk2(ve.z, ve.w); *(LAS u32x2*)(buf + 64 * ARS + (slS * 64 + 4 * q16) * 2) = w; }
                lds_barrier();
                if (c8 + 2 < 8) fetchS(c8 + 2, v, ve);
                loadB(bn, c8 == 7 ? ((item + stride) & 1) : kv, (c8 + 1) & 7);
                mm(buf, bc);
            };
            for (int c8 = 0; c8 < 8; c8 += 2) { chunkS(c8, ra, ea, bA, bB); chunkS(c8 + 1, rb, eb, bB, bA); }
        } else {
            auto fetchA = [&](int c8, int row, u32x4& o0, u32x4& o1) {
                const int n = nb * 64 + row;
                if (n >= nh) { o0 = (u32x4){0u, 0u, 0u, 0u}; o1 = o0; return; }
                const int pos = 16 * n + 2 * c8 + sl;
                const bf16_t* src_ = P + ((size_t)seqidx * SEQ + pos) * OD_N + 512 + kv * 128 + g * 64 + d0; o0 = *(const u32x4*)src_; o1 = *(const u32x4*)(src_ + 8);
            };
            u32x4 r0, r1, e0, e1, s0, s1, f0, f1;
            fetchA(0, srow, r0, r1); if (tid < 8) fetchA(0, 64, e0, e1);
            fetchA(1, srow, s0, s1); if (tid < 8) fetchA(1, 64, f0, f1);
            auto chunk = [&](int c8, u32x4& q0, u32x4& q1, u32x4& x0, u32x4& x1, bf16x8 (&bc)[4][2], bf16x8 (&bn)[4][2]) {
                LAS unsigned char* buf = lds + ((c8 & 1) ? CA1 : CA0);
                *(LAS u32x4*)(buf + srow * ARS + (sl * 64 + d0) * 2) = q0; *(LAS u32x4*)(buf + srow * ARS + (sl * 64 + d0) * 2 + 16) = q1;
                if (tid < 8) { *(LAS u32x4*)(buf + 64 * ARS + (sl * 64 + d0) * 2) = x0; *(LAS u32x4*)(buf + 64 * ARS + (sl * 64 + d0) * 2 + 16) = x1; }
                lds_barrier();
                if (c8 + 2 < 8) { fetchA(c8 + 2, srow, q0, q1); if (tid < 8) fetchA(c8 + 2, 64, x0, x1); }
                loadB(bn, c8 == 7 ? ((item + stride) & 1) : kv, (c8 + 1) & 7);
                mm(buf, bc);
            };
            for (int c8 = 0; c8 < 8; c8 += 2) { chunk(c8, r0, r1, e0, e1, bA, bB); chunk(c8 + 1, s0, s1, f0, f1, bB, bA); }
        }
        lds_barrier();
        LAS float* PBm = (LAS float*)(lds + PB);
        if (wave >= 4) {
#pragma unroll
            for (int rt = 0; rt < 4; ++rt)
#pragma unroll
                for (int ct = 0; ct < 2; ++ct)
#pragma unroll
                    for (int jj = 0; jj < 4; ++jj) PBm[(rt * 16 + fq * 4 + jj) * 128 + 32 * (wave - 4) + ct * 16 + fr] = acc[rt][ct][jj];
        }
        lds_barrier();
        if (wave < 4) {
#pragma unroll
            for (int rt = 0; rt < 4; ++rt)
#pragma unroll
                for (int ct = 0; ct < 2; ++ct) { const int hc = 32 * wave + ct * 16 + fr; const float bia = cb[kv * 128 + hc];
#pragma unroll
                    for (int jj = 0; jj < 4; ++jj) { const int i = rt * 16 + fq * 4 + jj;
                        *(LAS bf16_t*)(lds + HID + i * ARS + hc * 2) = (bf16_t)f2bf(siluf_(acc[rt][ct][jj] + PBm[i * 128 + hc] + bia)); } }
        }
        lds_barrier();
        {
            const int rt = wave >> 1;
            bf16_t* OUT = (bf16_t*)(ws + (kv == 0 ? WS_KC : WS_VC));
#pragma unroll
            for (int ti = 0; ti < 2; ++ti) { const int ct2 = (wave & 1) * 2 + ti; f32x4 a2 = {0.f, 0.f, 0.f, 0.f};
#pragma unroll
                for (int k4 = 0; k4 < 4; ++k4) { const bf16x8 a = lds_frag(lds + HID, rt * 16 + fr, ARS, k4 * 64 + fq * 16);
                    const bf16x8 b = *(const bf16x8*)(W2t + ((size_t)kv * 64 + ct2 * 16 + fr) * 128 + k4 * 32 + fq * 8);
                    a2 = __builtin_amdgcn_mfma_f32_16x16x32_bf16(a, b, a2, 0, 0, 0); }
                if (kv == 0) {
#pragma unroll
                    for (int jj = 0; jj < 4; ++jj) { const int j = nb * 64 + rt * 16 + fq * 4 + jj; if (j < nc) OUT[kc_off(seqidx, g, j) + ct2 * 16 + fr] = (bf16_t)f2bf(a2[jj]); }
                } else {
                    const int j0 = nb * 64 + rt * 16 + fq * 4;
                    u32x2 w; w.x = pk2(a2[0], a2[1]); w.y = pk2(a2[2], j0 + 3 < nc ? a2[3] : 0.f);
                    *(u32x2*)(OUT + vct_off(seqidx, g) + (size_t)(ct2 * 16 + fr) * nh + j0) = w;
                } }
        }
        lds_barrier();
    }
}

DEV void phase_compress_s(const Params& p, unsigned char* ws, LAS unsigned char* lds, int first, int stride, int item_end) {
    constexpr int CA0 = 0, CA1 = 18688, PB = 0, PBS = 132, HID = 67584, ARS = 144, HRS = 272;
    const int tid = opaque_tid(), lane = tid & 63, wave = __builtin_amdgcn_readfirstlane(tid >> 6), fr = lane & 15, fq = lane >> 4;
    const bf16_t* W1t = (const bf16_t*)(ws + WS_WC1); const bf16_t* W2t = (const bf16_t*)(ws + WS_WC2); const float* cb = (const float*)(ws + WS_CBIAS);
    const int q16 = tid & 15, r32 = tid >> 4;
    const int colbase = (wave < 4 ? 32 * wave : 128 + 32 * (wave - 4)), shift = wave < 4 ? 0 : 1;
    const bf16_t* W1w = W1t + ((size_t)colbase + fr) * 1024 + fq * 8;
    auto loadB = [&](bf16x8 (&bb)[2][2], int kvsel, int c16) {
#pragma unroll
        for (int k2 = 0; k2 < 2; ++k2)
#pragma unroll
            for (int ct = 0; ct < 2; ++ct) bb[k2][ct] = *(const bf16x8*)(W1w + ((size_t)kvsel * 256 + ct * 16) * 1024 + c16 * 64 + k2 * 32);
    };
    bf16x8 bA[2][2], bB[2][2];
    if (first < item_end) loadB(bA, first & 1, 0);
    if (tid < 18) { *(LAS u32x2*)(lds + CA0 + 128 * ARS + tid * 8) = (u32x2){0u, 0u}; *(LAS u32x2*)(lds + CA1 + 128 * ARS + tid * 8) = (u32x2){0u, 0u}; }
    for (int item = first; item < item_end; item += stride) {
        const int kv = item & 1, g = (item >> 1) & 1, seqidx = 4 + (item >> 2);
        constexpr int nh = 128, nc = 127;
        f32x4 acc[8][2];
#pragma unroll
        for (int rt = 0; rt < 8; ++rt)
#pragma unroll
            for (int ct = 0; ct < 2; ++ct) acc[rt][ct] = (f32x4){0.f, 0.f, 0.f, 0.f};
        int pg[4];
#pragma unroll
        for (int i = 0; i < 4; ++i) pg[i] = ppt()[(seqidx - 4) * 16 + ((i * 32 + r32) >> 3)];
        const float* cbase = pin(5) + (size_t)(kv * 2 + g) * 64 + 4 * q16;
        auto fetchS = [&](int c16, f32x4 (&v)[4]) {
#pragma unroll
            for (int i = 0; i < 4; ++i) { const int pos = 16 * (i * 32 + r32) + c16; v[i] = __builtin_nontemporal_load((const f32x4*)(cbase + ((size_t)pg[i] * 128 + (pos & 127)) * 256)); }
        };
        f32x4 ra[4], rb[4], rc[4];
        fetchS(0, ra); fetchS(1, rb); fetchS(2, rc);
        auto chunkS = [&](int c16, f32x4 (&v)[4], bf16x8 (&bc)[2][2], bf16x8 (&bn)[2][2]) {
            LAS unsigned char* buf = lds + ((c16 & 1) ? CA1 : CA0);
#pragma unroll
            for (int i = 0; i < 4; ++i) { u32x2 w; w.x = pk2(v[i].x, v[i].y); w.y = pk2(v[i].z, v[i].w); *(LAS u32x2*)(buf + (i * 32 + r32) * ARS + q16 * 8) = w; }
            lds_barrier();
            if (c16 + 3 < 16) fetchS(c16 + 3, v);
            loadB(bn, c16 == 15 ? ((item + stride) & 1) : kv, (c16 + 1) & 15);
#pragma unroll
            for (int k2 = 0; k2 < 2; ++k2) {
#pragma unroll
                for (int rt = 0; rt < 8; ++rt) { const bf16x8 a = lds_frag(buf, rt * 16 + fr + shift, ARS, k2 * 64 + fq * 16);
#pragma unroll
                    for (int ct = 0; ct < 2; ++ct) acc[rt][ct] = __builtin_amdgcn_mfma_f32_16x16x32_bf16(a, bc[k2][ct], acc[rt][ct], 0, 0, 0);
                    if ((rt & 3) == 3) __builtin_amdgcn_sched_barrier(0); }
            }
        };
        chunkS(0, ra, bA, bB); chunkS(1, rb, bB, bA); chunkS(2, rc, bA, bB); chunkS(3, ra, bB, bA); chunkS(4, rb, bA, bB); chunkS(5, rc, bB, bA); chunkS(6, ra, bA, bB); chunkS(7, rb, bB, bA);
        chunkS(8, rc, bA, bB); chunkS(9, ra, bB, bA); chunkS(10, rb, bA, bB); chunkS(11, rc, bB, bA); chunkS(12, ra, bA, bB); chunkS(13, rb, bB, bA); chunkS(14, rc, bA, bB); chunkS(15, ra, bB, bA);
        lds_barrier();
        LAS float* PBm = (LAS float*)(lds + PB);
        if (wave >= 4) {
#pragma unroll
            for (int rt = 0; rt < 8; ++rt)
#pragma unroll
                for (int ct = 0; ct < 2; ++ct)
#pragma unroll
                    for (int jj = 0; jj < 4; ++jj) PBm[(rt * 16 + fq * 4 + jj) * PBS + 32 * (wave - 4) + ct * 16 + fr] = acc[rt][ct][jj];
        }
        lds_barrier();
        if (wave < 4) {
#pragma unroll
            for (int rt = 0; rt < 8; ++rt)
#pragma unroll
                for (int ct = 0; ct < 2; ++ct) { const int hc = 32 * wave + ct * 16 + fr; const float bia = cb[kv * 128 + hc];
#pragma unroll
                    for (int jj = 0; jj < 4; ++jj) { const int i = rt * 16 + fq * 4 + jj;
                        *(LAS bf16_t*)(lds + HID + i * HRS + hc * 2) = (bf16_t)f2bf(siluf_(acc[rt][ct][jj] + PBm[i * PBS + hc] + bia)); } }
        }
        lds_barrier();
        {
            const int rt = wave;
            bf16_t* OUT = (bf16_t*)(ws + (kv == 0 ? WS_KC : WS_VC));
#pragma unroll
            for (int ct2 = 0; ct2 < 4; ++ct2) { f32x4 a2 = {0.f, 0.f, 0.f, 0.f};
#pragma unroll
                for (int k4 = 0; k4 < 4; ++k4) { const bf16x8 a = lds_frag(lds + HID, rt * 16 + fr, HRS, k4 * 64 + fq * 16);
                    const bf16x8 b = *(const bf16x8*)(W2t + ((size_t)kv * 64 + ct2 * 16 + fr) * 128 + k4 * 32 + fq * 8);
                    a2 = __builtin_amdgcn_mfma_f32_16x16x32_bf16(a, b, a2, 0, 0, 0); }
                if (kv == 0) {
#pragma unroll
                    for (int jj = 0; jj < 4; ++jj) { const int j = rt * 16 + fq * 4 + jj; if (j < nc) OUT[kc_off(seqidx, g, j) + ct2 * 16 + fr] = (bf16_t)f2bf(a2[jj]); }
                } else {
                    const int j0 = rt * 16 + fq * 4;
                    u32x2 w; w.x = pk2(a2[0], a2[1]); w.y = pk2(a2[2], j0 + 3 < nc ? a2[3] : 0.f);
                    *(u32x2*)(OUT + vct_off(seqidx, g) + (size_t)(ct2 * 16 + fr) * nh + j0) = w;
                } }
        }
        lds_barrier();
        if (tid < 18) { *(LAS u32x2*)(lds + CA0 + 128 * ARS + tid * 8) = (u32x2){0u, 0u}; *(LAS u32x2*)(lds + CA1 + 128 * ARS + tid * 8) = (u32x2){0u, 0u}; }
    }
    lds_barrier();
}

struct KVRegs { u32x4 k, v; };
DEV u32x4 load8(const RowRef& r, int seg) {
    if (r.h) return *(const u32x4*)(r.h + seg * 8);
    if (r.f) { const f32x4 a = *(const f32x4*)(r.f + seg * 8), b = *(const f32x4*)(r.f + seg * 8 + 4); u32x4 o; o.x = pk2(a.x, a.y); o.y = pk2(a.z, a.w); o.z = pk2(b.x, b.y); o.w = pk2(b.z, b.w); return o; }
    return (u32x4){0u, 0u, 0u, 0u};
}
constexpr int AT_BUF = 18432, AT_VT = 9216, AT_PW = 36864, AT_PSUM = 55296, AT_SELM = 88064, AT_PC = 88320, AT_RS = 144;
DEV void attn_scores(LAS unsigned char* kt, const bf16x8 (&Qf)[2], const f32x4 (&cb)[4], f32x4 (&s)[4], int fr, int fq) {
    __builtin_amdgcn_s_setprio(1);
#pragma unroll
    for (int ct = 0; ct < 4; ++ct) { f32x4 acc = cb[ct];
#pragma unroll
        for (int k2 = 0; k2 < 2; ++k2) acc = __builtin_amdgcn_mfma_f32_16x16x32_bf16(lds_frag(kt, ct * 16 + fr, AT_RS, k2 * 64 + fq * 16), Qf[k2], acc, 0, 0, 0);
        s[ct] = acc; }
    __builtin_amdgcn_s_setprio(0);
}
DEV void attn_softmax_pv(LAS unsigned char* vt, const f32x4 (&s)[4], f32x4 (&O)[4], f32x4& L, float& m, float b0, int fr, int fq) {
    float v = fmaxf(fmaxf(fmaxf(s[0][0], s[0][1]), fmaxf(s[0][2], s[0][3])), fmaxf(fmaxf(s[1][0], s[1][1]), fmaxf(s[1][2], s[1][3])));
    v = fmaxf(v, fmaxf(fmaxf(fmaxf(s[2][0], s[2][1]), fmaxf(s[2][2], s[2][3])), fmaxf(fmaxf(s[3][0], s[3][1]), fmaxf(s[3][2], s[3][3]))));
    v = xrow_max(v);
    const float mn = fmaxf(m, v + b0), alpha = __builtin_amdgcn_exp2f(m - mn), nb = b0 - mn; m = mn;
    float pv[4][4];
#pragma unroll
    for (int ct = 0; ct < 4; ++ct)
#pragma unroll
        for (int jj = 0; jj < 4; ++jj) pv[ct][jj] = __builtin_amdgcn_exp2f(s[ct][jj] + nb);
#pragma unroll
    for (int dt = 0; dt < 4; ++dt) O[dt] *= alpha;
    L *= alpha;
    const u32x4 one4 = {0x3F803F80u, 0x3F803F80u, 0x3F803F80u, 0x3F803F80u};
    __builtin_amdgcn_s_setprio(1);
#pragma unroll
    for (int ks = 0; ks < 2; ++ks) {
        u32x4 pb; pb.x = pk2(pv[2 * ks][0], pv[2 * ks][1]); pb.y = pk2(pv[2 * ks][2], pv[2 * ks][3]); pb.z = pk2(pv[2 * ks + 1][0], pv[2 * ks + 1][1]); pb.w = pk2(pv[2 * ks + 1][2], pv[2 * ks + 1][3]);
        const bf16x8 Pb = __builtin_bit_cast(bf16x8, pb);
#pragma unroll
        for (int dt = 0; dt < 4; ++dt) {
            const int lb = fr * AT_RS + ((((fq >> 1) ^ (fr >> 3)) & 1) << 4) + (fq & 1) * 8;
            const u32x2 a0 = *(const LAS u32x2*)(vt + dt * 16 * AT_RS + lb + (((ks ^ (dt >> 1)) * 4 + ((0 ^ (dt & 1)) * 2)) << 4)), a1 = *(const LAS u32x2*)(vt + dt * 16 * AT_RS + lb + (((ks ^ (dt >> 1)) * 4 + ((1 ^ (dt & 1)) * 2)) << 4));
            const u32x4 av = {a0.x, a0.y, a1.x, a1.y};
            O[dt] = __builtin_amdgcn_mfma_f32_16x16x32_bf16(__builtin_bit_cast(bf16x8, av), Pb, O[dt], 0, 0, 0);
        }
        L = __builtin_amdgcn_mfma_f32_16x16x32_bf16(__builtin_bit_cast(bf16x8, one4), Pb, L, 0, 0, 0);
    }
    __builtin_amdgcn_s_setprio(0);
}
DEV float row_sum4(float v) { return xrow_sum(v); }

struct AttnCtx {
    int seqidx, g, nc, nh, wstart; bool prompt;
    int pt_lane;
};
template <int BR>
DEV void attn_fetch(const Params& p, const bf16_t* P, const bf16_t* KC, const bf16_t* VCT, const bf16_t* VTP, const AttnCtx& c, int kb, int key, int seg, KVRegs& R, bool want_v) {
    const int lane_ = threadIdx.x & 63;
    if (BR == 0) {
        const int j = kb * 64 + key;
        R.k = j < c.nc ? *(const u32x4*)(KC + kc_off(c.seqidx, c.g, j) + seg * 8) : (u32x4){0u, 0u, 0u, 0u};
        if (want_v) R.v = *(const u32x4*)(VCT + vct_off(c.seqidx, c.g) + (size_t)key * c.nh + kb * 64 + seg * 8);
    } else {
        const int pos = kb * 64 + key;
        if (c.prompt) {
            R.k = *(const u32x4*)(P + ((size_t)c.seqidx * SEQ + pos) * OD_N + 512 + BR * 256 + c.g * 64 + seg * 8);
            R.v = *(const u32x4*)(VTP + ((size_t)(((BR - 1) * 4 + c.seqidx) * 2 + c.g) * 64 + key) * SEQ + kb * 64 + seg * 8);
        } else {
            if (pos >= PAST + DSQ) { R.k = (u32x4){0u, 0u, 0u, 0u}; R.v = R.k; }
            else if (pos >= PAST) { const bf16_t* b = P + ((size_t)NP + (c.seqidx - 4) * DSQ + (pos - PAST)) * OD_N + 512 + BR * 256 + c.g * 64 + seg * 8; R.k = *(const u32x4*)b; R.v = *(const u32x4*)(b + 128); }
            else {
                const float* b;
                if (BR == 2) b = pin(7) + (((size_t)(c.seqidx - 4) * 512 + (pos - (PAST - 512))) * 4 + c.g) * 64 + seg * 8;
                else { const int page = __shfl(c.pt_lane, (pos >> 7) | (lane_ & 48)); b = pin(6) + (((size_t)page * 128 + (pos & 127)) * 4 + c.g) * 64 + seg * 8; }
                const f32x4 k0 = *(const f32x4*)b, k1 = *(const f32x4*)(b + 4), v0 = *(const f32x4*)(b + 128), v1 = *(const f32x4*)(b + 132);
                R.k.x = pk2(k0.x, k0.y); R.k.y = pk2(k0.z, k0.w); R.k.z = pk2(k1.x, k1.y); R.k.w = pk2(k1.z, k1.w);
                R.v.x = pk2(v0.x, v0.y); R.v.y = pk2(v0.z, v0.w); R.v.z = pk2(v1.x, v1.y); R.v.w = pk2(v1.z, v1.w);
            }
        }
    }
}
DEV void attn_store(LAS unsigned char* buf, const KVRegs& r, int key, int seg, bool vtrans, bool want_v) {
    *(LAS u32x4*)(buf + key * AT_RS + seg * 16) = r.k;
    if (!want_v) return;
    if (vtrans) *(LAS u32x4*)(buf + AT_VT + key * AT_RS + seg * 16) = r.v;
    else { const unsigned w[4] = {r.v.x, r.v.y, r.v.z, r.v.w};
#pragma unroll
        for (int e = 0; e < 4; ++e) { *(LAS bf16_t*)(buf + AT_VT + (seg * 8 + 2 * e) * AT_RS + key * 2) = (bf16_t)(w[e] & 0xffffu); *(LAS bf16_t*)(buf + AT_VT + (seg * 8 + 2 * e + 1) * AT_RS + key * 2) = (bf16_t)(w[e] >> 16); } }
}

struct KV2 { u32x4 k0, v0, k1, v1; };
constexpr int A2_BUFSTRIDE_S = 36864, A2_PSUM = 73728, A2_SELM = 106496, A2_PC = 106752;
DEV u32x4 pack8(const float* b) { const f32x4 a = *(const f32x4*)b, c = *(const f32x4*)(b + 4); u32x4 o; o.x = pk2(a.x, a.y); o.y = pk2(a.z, a.w); o.z = pk2(c.x, c.y); o.w = pk2(c.z, c.w); return o; }
template <int BR>
DEV void attn_fetch2(const bf16_t* P, const bf16_t* KC, const bf16_t* VCT, const bf16_t* VTP, const AttnCtx& c, int kb, int key, int seg, u32x4& Rk0, u32x4& Rv0, u32x4& Rk1, u32x4& Rv1, bool want_v) {
    const int lane_ = threadIdx.x & 63;
    const u32x4 Z = {0u, 0u, 0u, 0u};
    if (c.prompt) {
        if (BR == 0) { const int j = kb * 64 + key;
            Rk0 = j < c.nc ? *(const u32x4*)(KC + kc_off(c.seqidx, c.g, j) + seg * 8) : Z;
            if (want_v) Rv0 = *(const u32x4*)(VCT + vct_off(c.seqidx, c.g) + (size_t)key * c.nh + kb * 64 + seg * 8); }
        else { const int pos = kb * 64 + key;
            Rk0 = *(const u32x4*)(P + ((size_t)c.seqidx * SEQ + pos) * OD_N + 512 + BR * 256 + c.g * 64 + seg * 8);
            Rv0 = *(const u32x4*)(VTP + ((size_t)(((BR - 1) * 4 + c.seqidx) * 2 + c.g) * 64 + key) * SEQ + kb * 64 + seg * 8); }
    } else {
        if (BR == 0) { const int j = kb * 64 + key;
            Rk0 = j < c.nc ? *(const u32x4*)(KC + kc_off(c.seqidx, 0, j) + seg * 8) : Z;
            Rk1 = j < c.nc ? *(const u32x4*)(KC + kc_off(c.seqidx, 1, j) + seg * 8) : Z;
            if (want_v) { const bf16_t* vb = VCT + vct_off(c.seqidx, 0) + (size_t)key * c.nh + kb * 64 + seg * 8;
                Rv0 = *(const u32x4*)vb; asm volatile("" : "+v"(Rv0));
                Rv1 = *(const u32x4*)(vb + 64 * 128); asm volatile("" : "+v"(Rv1)); } }
        else { const int pos = kb * 64 + key;
            if (pos >= PAST + DSQ) { Rk0 = Z; Rk1 = Z; Rv0 = Z; Rv1 = Z; }
            else if (pos >= PAST) { const bf16_t* b = P + ((size_t)NP + (c.seqidx - 4) * DSQ + (pos - PAST)) * OD_N + 512 + BR * 256 + seg * 8;
                Rk0 = *(const u32x4*)b; Rk1 = *(const u32x4*)(b + 64); Rv0 = *(const u32x4*)(b + 128); Rv1 = *(const u32x4*)(b + 192); }
            else { const float* b;
                if (BR == 2) b = pin(7) + ((size_t)(c.seqidx - 4) * 512 + (pos - (PAST - 512))) * 256 + seg * 8;
                else { const int page = __shfl(c.pt_lane, (pos >> 7) | (lane_ & 48)); b = pin(6) + ((size_t)page * 128 + (pos & 127)) * 256 + seg * 8; }
                Rk0 = pack8(b); Rk1 = pack8(b + 64); Rv0 = pack8(b + 128); Rv1 = pack8(b + 192); }
        }
    }
}
template <int BR>
DEV void attn_fetch1(const bf16_t* P, const bf16_t* KC, const bf16_t* VCT, const bf16_t* VTP, const AttnCtx& c, int g, int kb, int key, int seg, u32x4& Rk, u32x4& Rv, bool want_v) {
    const int lane_ = threadIdx.x & 63;
    const u32x4 Z = {0u, 0u, 0u, 0u};
    if (BR == 0) { const int j = kb * 64 + key;
        Rk = j < c.nc ? *(const u32x4*)(KC + kc_off(c.seqidx, g, j) + seg * 8) : Z;
        if (want_v) Rv = *(const u32x4*)(VCT + vct_off(c.seqidx, g) + (size_t)key * c.nh + kb * 64 + seg * 8);
    } else if (c.prompt) { const int pos = kb * 64 + key;
        Rk = *(const u32x4*)(P + ((size_t)c.seqidx * SEQ + pos) * OD_N + 512 + BR * 256 + g * 64 + seg * 8);
        Rv = *(const u32x4*)(VTP + ((size_t)(((BR - 1) * 4 + c.seqidx) * 2 + g) * 64 + key) * SEQ + kb * 64 + seg * 8);
    } else { const int pos = kb * 64 + key;
        if (pos >= PAST + DSQ) { Rk = Z; Rv = Z; }
        else if (pos >= PAST) { const bf16_t* b = P + ((size_t)NP + (c.seqidx - 4) * DSQ + (pos - PAST)) * OD_N + 512 + BR * 256 + g * 64 + seg * 8; Rk = *(const u32x4*)b; Rv = *(const u32x4*)(b + 128); }
        else { const float* b;
            if (BR == 2) b = pin(7) + ((size_t)(c.seqidx - 4) * 512 + (pos - (PAST - 512))) * 256 + g * 64 + seg * 8;
            else { const int page = __shfl(c.pt_lane, (pos >> 7) | (lane_ & 48)); b = pin(6) + ((size_t)page * 128 + (pos & 127)) * 256 + g * 64 + seg * 8; }
            Rk = pack8(b); Rv = pack8(b + 128); }
    }
}
DEV void attn_store1(LAS unsigned char* b, const u32x4& k, const u32x4& v, int key, int seg, bool vtrans, bool want_v) {
    *(LAS u32x4*)(b + key * AT_RS + seg * 16) = k;
    if (want_v) {
        if (vtrans) *(LAS u32x4*)(b + AT_VT + key * AT_RS + ((seg ^ ((key >> 3) & 7)) << 4)) = v;
        else { const unsigned w[4] = {v.x, v.y, v.z, v.w}; const int ksw = ((((key >> 3) ^ seg) & 7) << 4) + (key & 7) * 2;
#pragma unroll
            for (int e = 0; e < 4; ++e) { *(LAS bf16_t*)(b + AT_VT + (seg * 8 + 2 * e) * AT_RS + ksw) = (bf16_t)(w[e] & 0xffffu); *(LAS bf16_t*)(b + AT_VT + (seg * 8 + 2 * e + 1) * AT_RS + ksw) = (bf16_t)(w[e] >> 16); } }
    }
}
DEV void attn_store2(LAS unsigned char* buf, const u32x4& k0, const u32x4& v0, const u32x4& k1, const u32x4& v1, int key, int seg, bool vtrans, bool want_v, int nslots) {
    attn_store1(buf, k0, v0, key, seg, vtrans, want_v);
    if (nslots > 1) attn_store1(buf + 18432, k1, v1, key, seg, vtrans, want_v);
}

DEV void phase_attn(const Params& p, const bf16_t* P, const bf16_t* KC, const bf16_t* VCT, const bf16_t* VTP, const float* GATES, bf16_t* MIX, LAS unsigned char* lds) {
    const int tid = opaque_tid(), lane = tid & 63, wave = __builtin_amdgcn_readfirstlane(tid >> 6), fr = lane & 15, fq = lane >> 4;
    const int r = wave & 3, qsub = wave >> 2, key = tid >> 3, seg = tid & 7;
    LAS float* PSUM = (LAS float*)(lds + A2_PSUM);
    LAS float* PC = (LAS float*)(lds + A2_PC);
    LAS unsigned long long* SELM = (LAS unsigned long long*)(lds + A2_SELM);
    const float NEG = -1e30f;
    unsigned* qctr = (unsigned*)(pws() + WS_BAR) + 3520;
    LAS int* qslot = (LAS int*)(lds + 147456 - 1024 + 16);
#if PROFILE == 2
    LAS unsigned* TA = (LAS unsigned*)(lds + 147456 - 512) + 64;
    if (tid == 0) for (int i = 0; i < 16; ++i) TA[i] = 0;
    unsigned long long tprev = 0;
#define ASEC(k) do { if (tid == 0) { const unsigned long long tn = __builtin_amdgcn_s_memrealtime(); TA[k] += (unsigned)(tn - tprev); tprev = tn; } } while (0)
#define ACNT(k) do { if (tid == 0) TA[k] += 1; } while (0)
#else
#define ASEC(k)
#define ACNT(k)
#endif
    int xq = blockIdx.x & 7, ntried = 0; bool sample_done = false;
    for (;;) {
        if (tid == 0) {
            int q = -1;
            if (!sample_done) { const int v = (int)__hip_atomic_fetch_add(qctr, 1u, __ATOMIC_RELAXED, __HIP_MEMORY_SCOPE_AGENT); if (v < 128) q = v; }
            if (q < 0) { int x = xq, k = ntried;
                while (k < 8) { const int v = (int)__hip_atomic_fetch_add(qctr + 1 + x, 1u, __ATOMIC_RELAXED, __HIP_MEMORY_SCOPE_AGENT); if (v < 128) { q = 128 + x * 128 + v; break; } x = (x + 1) & 7; ++k; }
                q = q < 0 ? (1 << 20) : (q | (k << 24)); }
            *qslot = q;
        }
        lds_barrier();
        int q = *qslot;
        lds_barrier();
        if (q >= (1 << 20) && (q & ((1 << 24) - 1)) == (1 << 20)) break;
        if (q >= 128) { sample_done = true; const int k = q >> 24; q &= (1 << 24) - 1; xq = (xq + (k - ntried)) & 7; ntried = k; }
        ASEC(15);
        AttnCtx c; int t0, ns;
        if (q >= 128) { c.prompt = true; const int q2 = q - 128; const int qt = 127 - (q2 & 127); const int pr = q2 >> 7; c.g = pr & 1; c.seqidx = pr >> 1; t0 = qt * 32; c.nc = 255; c.nh = 256; ns = 64; c.wstart = 0; }
        else { c.prompt = false; c.g = qsub; c.seqidx = 4 + q; t0 = PAST; c.nc = 127; c.nh = 128; ns = 33; c.wstart = PAST - 512; }
        c.pt_lane = c.prompt ? 0 : ppt()[(c.seqidx - 4) * 16 + (lane & 15)];
        const bool prompt = c.prompt; const int seqidx = c.seqidx, g = c.g, nc = c.nc, wstart = c.wstart;
        const int bufstride = A2_BUFSTRIDE_S, myslot = qsub * 18432;
        const int gS0 = prompt ? g : 0, gS1 = prompt ? g : 1;
        const int h = g * 4 + r; const float slope = exp2f(-(float)(h + 1)) * 1.4426950408889634f;
        const int qmin = t0, qmax = prompt ? t0 + 31 : t0 + 7;
        const int qminH = prompt ? t0 + 16 * qsub : t0, qmaxH = prompt ? qminH + 15 : t0 + 7;
        int qpos, tokr; bool act;
        if (prompt) { qpos = t0 + qsub * 16 + fr; tokr = seqidx * SEQ + qpos; act = true; }
        else { const int tc = min(fr, 7); qpos = PAST + tc; tokr = NP + (seqidx - 4) * DSQ + tc; act = fr < 8; }
        bf16x8 Qf[2];
        { const size_t tq = prompt ? (size_t)seqidx * SEQ + t0 + qsub * 16 + fr : (size_t)NP + (seqidx - 4) * DSQ + min(fr, 7);
#pragma unroll
          for (int k2 = 0; k2 < 2; ++k2) { const u32x4 qv = *(const u32x4*)(P + tq * OD_N + h * 64 + k2 * 32 + fq * 8);
              u32x4 o; constexpr float QS = 0.125f * 1.4426950408889634f;
              o.x = pk2(bflo(qv.x) * QS, bfhi(qv.x) * QS); o.y = pk2(bflo(qv.y) * QS, bfhi(qv.y) * QS); o.z = pk2(bflo(qv.z) * QS, bfhi(qv.z) * QS); o.w = pk2(bflo(qv.w) * QS, bfhi(qv.w) * QS);
              Qf[k2] = __builtin_bit_cast(bf16x8, o); } }
        for (int i = tid; i < 8192; i += NTHR) PSUM[i] = 0.f;
        f32x4 outv[4];
#pragma unroll
        for (int ct = 0; ct < 4; ++ct) outv[ct] = (f32x4){0.f, 0.f, 0.f, 0.f};
        f32x4 O[4]; f32x4 L = {0.f, 0.f, 0.f, 0.f}; float m = -1e20f, inv = 0.f;
        u32x4 rk0 = {0u, 0u, 0u, 0u}, rv0 = rk0, rk1 = rk0, rv1 = rk0;
        unsigned long long selrow = 0ull, umaskA = 0ull, umaskB = 0ull, amask = 0ull;
        const int ntc = prompt ? min(4, ((qmax - 31) >> 4) / 64 + 1) : 2;
#pragma unroll
        for (int stage = 0; stage < 4; ++stage) {
            constexpr int dummy = 0; (void)dummy;
            const int BRs = stage == 0 || stage == 1 ? 0 : stage - 1;
            unsigned long long remA, remB;
            if (stage <= 1) { remA = (1ull << ntc) - 1ull; remB = remA; }
            else if (stage == 2) { remA = umaskA; remB = umaskB; }
            else { const int qa = t0, qb = prompt ? t0 + 16 : t0, ea = prompt ? t0 + 15 : t0 + 7, eb = prompt ? t0 + 31 : t0 + 7;
                   const int loA = max(wstart, qa - 511) >> 6, hiA = ea >> 6, loB = max(wstart, qb - 511) >> 6, hiB = eb >> 6;
                   remA = (hiA >= 63 ? ~0ull : ((1ull << (hiA + 1)) - 1ull)) & ~((1ull << loA) - 1ull); remB = (hiB >= 63 ? ~0ull : ((1ull << (hiB + 1)) - 1ull)) & ~((1ull << loB) - 1ull); }
            remA = __builtin_amdgcn_readfirstlane((unsigned)remA) | ((unsigned long long)__builtin_amdgcn_readfirstlane((unsigned)(remA >> 32)) << 32);
            remB = __builtin_amdgcn_readfirstlane((unsigned)remB) | ((unsigned long long)__builtin_amdgcn_readfirstlane((unsigned)(remB >> 32)) << 32);
            const bool want_v = stage != 1;
            const bool vtrans = BRs == 0 || prompt;
            if (stage != 1) {
#pragma unroll
                for (int ct = 0; ct < 4; ++ct) O[ct] = (f32x4){0.f, 0.f, 0.f, 0.f};
                m = -1e20f; L = (f32x4){0.f, 0.f, 0.f, 0.f};
            }
            f32x4 cb[4];
            { const float bstep = BRs == 0 ? 16.f * slope : slope;
#pragma unroll
              for (int ct = 0; ct < 4; ++ct)
#pragma unroll
                  for (int jj = 0; jj < 4; ++jj) cb[ct][jj] = bstep * (float)(fq * 4 + ct * 16 + jj); }
            if (remA | remB) {
                unsigned long long rfA = remA, rfB = remB;
                if (rfA) { const int kb0 = __builtin_ctzll(rfA); rfA &= rfA - 1ull; if (BRs == 0) attn_fetch1<0>(P, KC, VCT, VTP, c, gS0, kb0, key, seg, rk0, rv0, want_v); else if (BRs == 1) attn_fetch1<1>(P, KC, VCT, VTP, c, gS0, kb0, key, seg, rk0, rv0, want_v); else attn_fetch1<2>(P, KC, VCT, VTP, c, gS0, kb0, key, seg, rk0, rv0, want_v); attn_store1(lds, rk0, rv0, key, seg, vtrans, want_v); }
                if (rfB) { const int kb0 = __builtin_ctzll(rfB); rfB &= rfB - 1ull; if (BRs == 0) attn_fetch1<0>(P, KC, VCT, VTP, c, gS1, kb0, key, seg, rk1, rv1, want_v); else if (BRs == 1) attn_fetch1<1>(P, KC, VCT, VTP, c, gS1, kb0, key, seg, rk1, rv1, want_v); else attn_fetch1<2>(P, KC, VCT, VTP, c, gS1, kb0, key, seg, rk1, rv1, want_v); attn_store1(lds + 18432, rk1, rv1, key, seg, vtrans, want_v); }
                if (rfA) { const int kb1 = __builtin_ctzll(rfA); rfA &= rfA - 1ull; if (BRs == 0) attn_fetch1<0>(P, KC, VCT, VTP, c, gS0, kb1, key, seg, rk0, rv0, want_v); else if (BRs == 1) attn_fetch1<1>(P, KC, VCT, VTP, c, gS0, kb1, key, seg, rk0, rv0, want_v); else attn_fetch1<2>(P, KC, VCT, VTP, c, gS0, kb1, key, seg, rk0, rv0, want_v); }
                if (rfB) { const int kb1 = __builtin_ctzll(rfB); rfB &= rfB - 1ull; if (BRs == 0) attn_fetch1<0>(P, KC, VCT, VTP, c, gS1, kb1, key, seg, rk1, rv1, want_v); else if (BRs == 1) attn_fetch1<1>(P, KC, VCT, VTP, c, gS1, kb1, key, seg, rk1, rv1, want_v); else attn_fetch1<2>(P, KC, VCT, VTP, c, gS1, kb1, key, seg, rk1, rv1, want_v); }
                lds_barrier();
                int cur = 0;
                while (remA | remB) {
                    int kbA = -1, kbB = -1;
                    if (remA) { kbA = __builtin_ctzll(remA); remA &= remA - 1ull; }
                    if (remB) { kbB = __builtin_ctzll(remB); remB &= remB - 1ull; }
                    const int kb = qsub ? kbB : kbA;
                    ACNT(prompt ? 10 : 11);
                    LAS unsigned char* buf = lds + cur * bufstride + myslot;
                    if (kb >= 0 || stage == 1) {
                    f32x4 s[4];
                    attn_scores(buf, Qf, cb, s, fr, fq);
                    bool interior;
                    if (BRs == 0) interior = (kb * 64 + 63 < nc) && (16 * (kb * 64 + 63) + 31 <= qminH);
                    else if (BRs == 1) interior = ((amask >> kb) & 1ull) != 0ull && (kb * 64 + 63 <= qminH);
                    else interior = (kb * 64 + 63 <= qminH) && (qmaxH - kb * 64 <= 511) && (kb * 64 >= wstart);
                    const int col0 = kb * 64 + fq * 4;
                    const int kp0 = BRs == 0 ? 16 * col0 + 31 : col0;
                    const float b0 = slope * (float)(BRs == 0 ? 1024 * kb + 31 : 64 * kb);
                    if (!interior) {
                        asm volatile("; boundary tile" ::: "memory");
                        const int d0 = qpos - kp0;
                        const bool selok = BRs == 1 ? (((selrow >> kb) & 1ull) != 0ull) : true;
#pragma unroll
                        for (int ct = 0; ct < 4; ++ct)
#pragma unroll
                            for (int jj = 0; jj < 4; ++jj) {
                                const int c = ct * 16 + jj; bool ok;
                                if (BRs == 0) ok = (col0 + c < nc) && (d0 >= 16 * c);
                                else if (BRs == 1) ok = selok && (d0 >= c);
                                else ok = (d0 >= c) && (d0 < 512 + c) && (kp0 + c >= wstart);
                                s[ct][jj] = ok ? s[ct][jj] : NEG; }
                    }
                    if (stage != 1) attn_softmax_pv(buf + AT_VT, s, O, L, m, b0, fr, fq);
                    else {
#pragma unroll
                        for (int ct = 0; ct < 4; ++ct) { f32x4 pq;
#pragma unroll
                            for (int jj = 0; jj < 4; ++jj) pq[jj] = __builtin_amdgcn_exp2f(s[ct][jj] + (b0 - m)) * inv;
                            *(LAS f32x4*)(PC + (wave * 16 + fr) * 68 + ct * 16 + fq * 4) = pq; }
                        lds_barrier();
                        { const int q2 = tid >> 8, t2 = (tid >> 4) & 15, k0 = (tid & 15) * 4;
                          f32x4 a = *(const LAS f32x4*)(PC + ((q2 * 4 + 0) * 16 + t2) * 68 + k0);
                          a += *(const LAS f32x4*)(PC + ((q2 * 4 + 1) * 16 + t2) * 68 + k0); a += *(const LAS f32x4*)(PC + ((q2 * 4 + 2) * 16 + t2) * 68 + k0); a += *(const LAS f32x4*)(PC + ((q2 * 4 + 3) * 16 + t2) * 68 + k0);
                          *(LAS f32x4*)(PSUM + (q2 * 16 + t2) * 256 + kb * 64 + k0) = a; }
                    }
                    }
                    if (remA) { attn_store1(lds + (cur ^ 1) * bufstride, rk0, rv0, key, seg, vtrans, want_v);
                        if (rfA) { const int kbn = __builtin_ctzll(rfA); rfA &= rfA - 1ull; if (BRs == 0) attn_fetch1<0>(P, KC, VCT, VTP, c, gS0, kbn, key, seg, rk0, rv0, want_v); else if (BRs == 1) attn_fetch1<1>(P, KC, VCT, VTP, c, gS0, kbn, key, seg, rk0, rv0, want_v); else attn_fetch1<2>(P, KC, VCT, VTP, c, gS0, kbn, key, seg, rk0, rv0, want_v); } }
                    if (remB) { attn_store1(lds + (cur ^ 1) * bufstride + 18432, rk1, rv1, key, seg, vtrans, want_v);
                        if (rfB) { const int kbn = __builtin_ctzll(rfB); rfB &= rfB - 1ull; if (BRs == 0) attn_fetch1<0>(P, KC, VCT, VTP, c, gS1, kbn, key, seg, rk1, rv1, want_v); else if (BRs == 1) attn_fetch1<1>(P, KC, VCT, VTP, c, gS1, kbn, key, seg, rk1, rv1, want_v); else attn_fetch1<2>(P, KC, VCT, VTP, c, gS1, kbn, key, seg, rk1, rv1, want_v); } }
                    lds_barrier();
                    cur ^= 1;
                }
            }
            ASEC((prompt ? 0 : 5) + stage);
            if (stage == 0) {
                inv = 1.f / fmaxf(L[0], 1e-30f); const float gt = GATES[(size_t)tokr * 24 + h * 3 + 0] * inv;
#pragma unroll
                for (int ct = 0; ct < 4; ++ct) outv[ct] += gt * O[ct];
            } else if (stage == 1) {
                unsigned kq[4], T[4]; bool vld[4];
#pragma unroll
                for (int i = 0; i < 4; ++i) {
                    const int ql = wave * 4 + i, qs_ = ql >> 4, t_ = ql & 15;
                    const int qp = prompt ? t0 + ql : PAST + min(t_, 7); const int curb = qp >> 6;
                    float imp = 0.f;
#pragma unroll
                    for (int dj = -1; dj <= 3; ++dj) { const int j = 4 * lane + dj; if (j >= 0 && j < nc) { const int lo = max(16 * j, 64 * lane), hi = min(16 * j + 32, 64 * lane + 64); imp += PSUM[(qs_ * 16 + t_) * 256 + j] * ((float)(hi - lo) * (1.f / 32.f)); } }
                    const bool valid = lane < ns && lane <= curb; const bool forced = lane == 0 || lane == curb || lane == curb - 1;
                    const float score = lane < ns ? (valid ? (forced ? 1e4f : imp) : NEG) : -3e38f;
                    unsigned k_ = __float_as_uint(score); k_ ^= ((unsigned)((int)k_ >> 31)) | 0x80000000u;
                    kq[i] = k_; vld[i] = valid; T[i] = 0u;
                }
#pragma unroll
                for (int b = 31; b >= 0; --b)
#pragma unroll
                    for (int i = 0; i < 4; ++i) { const unsigned cand = T[i] | (1u << b); const unsigned long long bm = __builtin_amdgcn_ballot_w64(kq[i] >= cand); int cnt; asm("s_bcnt1_i32_b64 %0, %1" : "=s"(cnt) : "s"(bm) : "scc"); T[i] = cnt >= 16 ? cand : T[i]; }
#pragma unroll
                for (int i = 0; i < 4; ++i) {
                    const int ql = wave * 4 + i, t_ = ql & 15; const bool qact = prompt || t_ < 8;
                    const unsigned long long gtm = __ballot(kq[i] > T[i]), tie = __ballot(kq[i] == T[i]);
                    const int need = 16 - __popcll(gtm);
                    const int below = __builtin_amdgcn_mbcnt_hi((unsigned)(tie >> 32), __builtin_amdgcn_mbcnt_lo((unsigned)tie, 0u));
                    const unsigned long long msk = __ballot(vld[i] && (kq[i] > T[i] || (kq[i] == T[i] && below < need)));
                    if (lane == 0) SELM[ql] = qact ? msk : 0ull;
                }
                lds_barrier();
                { const bool lact = lane < 32 && (prompt || (lane & 15) < 8);
                  unsigned long long u = lane < 32 ? SELM[lane] : 0ull; unsigned long long a = lact ? u : ~0ull;
                  unsigned ul = (unsigned)u, uh = (unsigned)(u >> 32), al = (unsigned)a, ah = (unsigned)(a >> 32);
                  ul |= dpp_u<DPP_XOR1>(ul); uh |= dpp_u<DPP_XOR1>(uh); al &= dpp_u<DPP_XOR1>(al); ah &= dpp_u<DPP_XOR1>(ah);
                  ul |= dpp_u<DPP_XOR2>(ul); uh |= dpp_u<DPP_XOR2>(uh); al &= dpp_u<DPP_XOR2>(al); ah &= dpp_u<DPP_XOR2>(ah);
                  ul |= dpp_u<DPP_HMIRROR>(ul); uh |= dpp_u<DPP_HMIRROR>(uh); al &= dpp_u<DPP_HMIRROR>(al); ah &= dpp_u<DPP_HMIRROR>(ah);
                  ul |= dpp_u<DPP_MIRROR>(ul); uh |= dpp_u<DPP_MIRROR>(uh); al &= dpp_u<DPP_MIRROR>(al); ah &= dpp_u<DPP_MIRROR>(ah);
                  umaskA = (unsigned long long)(unsigned)__builtin_amdgcn_readlane((int)ul, 0) | ((unsigned long long)(unsigned)__builtin_amdgcn_readlane((int)uh, 0) << 32);
                  umaskB = (unsigned long long)(unsigned)__builtin_amdgcn_readlane((int)ul, 16) | ((unsigned long long)(unsigned)__builtin_amdgcn_readlane((int)uh, 16) << 32);
                  { const unsigned long long aA = (unsigned long long)(unsigned)__builtin_amdgcn_readlane((int)al, 0) | ((unsigned long long)(unsigned)__builtin_amdgcn_readlane((int)ah, 0) << 32);
                    const unsigned long long aB = (unsigned long long)(unsigned)__builtin_amdgcn_readlane((int)al, 16) | ((unsigned long long)(unsigned)__builtin_amdgcn_readlane((int)ah, 16) << 32);
                    amask = qsub ? aB : aA; }
                  selrow = SELM[qsub * 16 + fr]; }
                ASEC(prompt ? 4 : 9);
            } else {
                const float gt = GATES[(size_t)tokr * 24 + h * 3 + (stage - 1)] / fmaxf(L[0], 1e-30f);
#pragma unroll
                for (int ct = 0; ct < 4; ++ct) outv[ct] += gt * O[ct];
            }
        }
        if (act) {
#pragma unroll
            for (int dt = 0; dt < 4; ++dt) { u32x2 w; w.x = pk2(outv[dt][0], outv[dt][1]); w.y = pk2(outv[dt][2], outv[dt][3]);
                *(u32x2*)(MIX + (size_t)tokr * D + h * 64 + dt * 16 + fq * 4) = w; }
        }
        lds_barrier();
    }
}

DEV void phase_chunkmlp(const Params& p, unsigned char* ws, const bf16_t* UG, const bf16_t* VLN, bf16_t* MIX, LAS unsigned char* lds) {
    constexpr int VRS = 272;
    const int tid = opaque_tid(), lane = tid & 63, wave = __builtin_amdgcn_readfirstlane(tid >> 6), fr = lane & 15, fq = lane >> 4;
    const bf16_t* WDS = (const bf16_t*)(ws + WS_WDS); const float* bsd = pin(26);
    for (int item = blockIdx.x; item < 1024; item += gridDim.x) {
        const int g = item & 7, n = (item >> 3) & 31, b = item >> 8;
        const size_t tok0 = (size_t)b * SEQ + n * 128;
        const int nks = (16 * wave + 15) / 32 + 1;
        const int s = tid >> 2, part = tid & 3, tl = 16 * wave + fr;
        const bf16_t* src_ = VLN + (tok0 + s) * 512 + g * 64 + part * 16;
        const u32x4 va = *(const u32x4*)src_, vb = *(const u32x4*)(src_ + 8);
        bf16x8 wf[4];
#pragma unroll
        for (int k4 = 0; k4 < 4; ++k4) wf[k4] = k4 < nks ? *(const bf16x8*)(WDS + ((size_t)g * 128 + tl) * 128 + k4 * 32 + fq * 8) : (bf16x8){0, 0, 0, 0, 0, 0, 0, 0};
        f32x4 ug[4];
#pragma unroll
        for (int ct = 0; ct < 4; ++ct) { const u32x2 w = *(const u32x2*)(UG + (tok0 + tl) * 512 + g * 64 + ct * 16 + fq * 4); ug[ct] = (f32x4){bflo(w.x), bfhi(w.x), bflo(w.y), bfhi(w.y)}; }
        const float bb = bsd[g * 128 + tl];
        { const unsigned vw[8] = {va.x, va.y, va.z, va.w, vb.x, vb.y, vb.z, vb.w};
#pragma unroll
          for (int e = 0; e < 8; ++e) { *(LAS bf16_t*)(lds + (part * 16 + 2 * e) * VRS + s * 2) = (bf16_t)(vw[e] & 0xffffu); *(LAS bf16_t*)(lds + (part * 16 + 2 * e + 1) * VRS + s * 2) = (bf16_t)(vw[e] >> 16); } }
        lds_barrier();
        f32x4 acc[4];
#pragma unroll
        for (int ct = 0; ct < 4; ++ct) acc[ct] = (f32x4){0.f, 0.f, 0.f, 0.f};
#pragma unroll
        for (int k4 = 0; k4 < 4; ++k4) if (k4 < nks) {
#pragma unroll
            for (int ct = 0; ct < 4; ++ct) acc[ct] = __builtin_amdgcn_mfma_f32_16x16x32_bf16(lds_frag(lds, ct * 16 + fr, VRS, k4 * 64 + fq * 16), wf[k4], acc[ct], 0, 0, 0);
        }
#pragma unroll
        for (int ct = 0; ct < 4; ++ct) { u32x2 w; w.x = pk2(ug[ct][0] * (acc[ct][0] + bb), ug[ct][1] * (acc[ct][1] + bb)); w.y = pk2(ug[ct][2] * (acc[ct][2] + bb), ug[ct][3] * (acc[ct][3] + bb));
            *(u32x2*)(MIX + (tok0 + tl) * D + 512 + g * 64 + ct * 16 + fq * 4) = w; }
        lds_barrier();
    }
}

DEV void phase_chunkmlp_naive(const Params& p, const bf16_t* UG, const bf16_t* VLN, bf16_t* MIX, int tok_lo, int gw, int ngw, int lane) {
    const float* wsd = pin(25); const float* bsd = pin(26);
    const size_t gt = (size_t)gw * 64 + lane, ngt = (size_t)ngw * 64;
    for (size_t i = (size_t)tok_lo * 512 + gt; i < (size_t)NT * 512; i += ngt) {
        const int tok = (int)(i >> 9), ch = (int)(i & 511), g = ch >> 6;
        const int tc = tok < NP ? (tok % SEQ) & 127 : (tok - NP) % DSQ;
        float m = bsd[g * 128 + tc];
        const float* wr_ = wsd + ((size_t)g * 128 + tc) * 128;
        for (int s = 0; s <= tc; ++s) m += wr_[s] * bf2f(VLN[(size_t)(tok - tc + s) * 512 + ch]);
        MIX[(size_t)tok * D + 512 + ch] = (bf16_t)f2bf(bf2f(UG[i]) * m);
    }
}

#define XB_TMO      128
#define XB_XCNT(j)  (256  + 64 * (j))
#define XB_XSUB(j)  (1280 + 64 * (j))
#define XB_XGEN(j)  (2304 + 64 * (j))
#define XB_TOP      3328
#define XB_TOPGEN   3392
#define XCD_BAR_WORDS 3456
#define XB_SPIN_CAP (1u << 20)
DEV unsigned xb_ld(unsigned* p)              { return __hip_atomic_load(p, __ATOMIC_RELAXED, __HIP_MEMORY_SCOPE_AGENT); }
DEV unsigned xb_add(unsigned* p, unsigned v) { return __hip_atomic_fetch_add(p, v, __ATOMIC_RELAXED, __HIP_MEMORY_SCOPE_AGENT); }
DEV unsigned xb_xcc_id() { return (unsigned)__builtin_amdgcn_s_getreg((3 << 11) | 20) & 0xFu; }
#define XB_SPIN(cond, bar) do { unsigned _sp = 0; while (cond) { __builtin_amdgcn_s_sleep(1); \
    if ((++_sp & 255u) == 0u) { if (xb_ld(&(bar)[XB_TMO])) break; if (_sp > XB_SPIN_CAP) { atomicAdd(&(bar)[XB_TMO], 1u); break; } } } } while (0)
struct XcdBarrier { unsigned* bar; unsigned x; volatile LAS unsigned* st; };
DEV XcdBarrier xcd_barrier_post(unsigned* bar, volatile LAS unsigned* st) {
    XcdBarrier b; b.bar = bar; b.x = xb_xcc_id(); b.st = st;
    if (threadIdx.x == 0) (void)xb_add(&bar[XB_XCNT(b.x)], 1u);
    return b;
}
DEV void xcd_barrier_complete(unsigned* bar, unsigned x, unsigned& nloc, unsigned& nx) {
    const unsigned G = gridDim.x * gridDim.y * gridDim.z;
    unsigned sum, cnt, mine, sp = 0u;
    for (;;) {
        sum = 0u; cnt = 0u; mine = 0u;
#pragma unroll
        for (unsigned j = 0; j < 16; ++j) { const unsigned c = xb_ld(&bar[XB_XCNT(j)]); sum += c; cnt += (c > 0u) ? 1u : 0u; mine = (j == x) ? c : mine; }
        if (sum == G) break;
        __builtin_amdgcn_s_sleep(1);
        if ((++sp & 255u) == 0u) { if (xb_ld(&bar[XB_TMO])) break; if (sp > XB_SPIN_CAP) { atomicAdd(&bar[XB_TMO], 1u); break; } }
    }
    nloc = mine > 0u ? mine : 1u; nx = cnt > 0u ? cnt : 1u;
}
DEV void xcd_barrier(const XcdBarrier& b, LAS unsigned long long* stamp = nullptr) {
    asm volatile("s_waitcnt vmcnt(0)" ::: "memory");
    __syncthreads();
    if (threadIdx.x == 0) {
        unsigned* bar = b.bar;
        __builtin_amdgcn_s_waitcnt(0);
        unsigned nloc = b.st[0], nx = b.st[1];
        if (nloc == 0u) { xcd_barrier_complete(bar, b.x, nloc, nx); b.st[0] = nloc; b.st[1] = nx; }
        const unsigned old = xb_add(&bar[XB_XSUB(b.x)], 1u);
        const unsigned gen = old / nloc;
        if (old + 1u == (gen + 1u) * nloc) {
            __builtin_amdgcn_fence(__ATOMIC_RELEASE, "agent");
            asm volatile("s_waitcnt vmcnt(0)" ::: "memory");
            const unsigned og = xb_add(&bar[XB_TOP], 1u);
            const unsigned tg = og / nx;
            if (og + 1u == (tg + 1u) * nx) xb_add(&bar[XB_TOPGEN], 1u);
            else XB_SPIN(xb_ld(&bar[XB_TOPGEN]) == tg, bar);
            __builtin_amdgcn_fence(__ATOMIC_ACQUIRE, "agent");
            xb_add(&bar[XB_XGEN(b.x)], 1u);
            asm volatile("s_waitcnt vmcnt(0)" ::: "memory");
        } else {
            XB_SPIN(xb_ld(&bar[XB_XGEN(b.x)]) == gen, bar);
            __builtin_amdgcn_fence(__ATOMIC_ACQUIRE, "agent");
            asm volatile("s_waitcnt vmcnt(0)" ::: "memory");
        }
        if (stamp) *stamp = __builtin_amdgcn_s_memrealtime();
    }
    __syncthreads();
}

#if PROFILE == 3
#define PROF_T0() unsigned long long pt0_ = __builtin_amdgcn_s_memrealtime()
#define PROF_MAX(slot) do { const unsigned long long pt1_ = __builtin_amdgcn_s_memrealtime(); if (threadIdx.x == 0) atomicMax((unsigned*)(pws() + WS_BAR) + 3600 + (slot), (unsigned)(pt1_ - pt0_)); pt0_ = pt1_; } while (0)
#else
#define PROF_T0()
#define PROF_MAX(slot)
#endif
__global__ void __launch_bounds__(NTHR, 2) fwd_kernel(Params p) {
    extern __shared__ __attribute__((aligned(16))) unsigned char lds_raw[];
    LAS unsigned char* lds = (LAS unsigned char*)lds_raw;
    cg::grid_group grid = cg::this_grid();
    const int G = gridDim.x;
    if (threadIdx.x < 2) ((volatile LAS unsigned*)(lds + 147456 - 1024))[threadIdx.x] = 0u;
    if (threadIdx.x == 0) { LAS unsigned long long* t = (LAS unsigned long long*)(lds + PTAB_OFF);
#pragma unroll
        for (int i = 0; i < 29; ++i) t[i] = (unsigned long long)p.in[i];
        t[29] = (unsigned long long)p.out; t[30] = (unsigned long long)p.ws; }
    __syncthreads();
    const XcdBarrier xbar = xcd_barrier_post((unsigned*)(pws() + WS_BAR), (volatile LAS unsigned*)(lds + 147456 - 1024));
#define PH_IDS const int tid_ = opaque_tid(), lane = tid_ & 63, wave = __builtin_amdgcn_readfirstlane(tid_ >> 6), gw = blockIdx.x * 8 + wave, ngw = G * 8; (void)lane; (void)gw; (void)ngw
#define ws pws()
#define X ((float*)(pws() + WS_X))
#define H ((bf16_t*)(pws() + WS_H))
#define ACT ((bf16_t*)(pws() + WS_ACT))
#define Y ((float*)(pws() + WS_Y))
#define P ((bf16_t*)(pws() + WS_P))
#define EXT ((float*)(pws() + WS_EXT))
#define MIX ((bf16_t*)(pws() + WS_MIX))
#define OB ((float*)(pws() + WS_OB))
#define QKV ((float*)(pws() + WS_QKV))
#define GB ((float*)(pws() + WS_GB))
#define GATES ((float*)(pws() + WS_GATES))
#define UG ((bf16_t*)(pws() + WS_UG))
#define VLN ((bf16_t*)(pws() + WS_VLN))
#define YT ((float*)(pws() + WS_YT))
#define norm_g pin(9)
#define RSTD ((float*)(pws() + WS_RSTD))
#if PROFILE
    LAS unsigned long long* TS = (LAS unsigned long long*)(lds + 147456 - 512); int nst = 0;
    if (blockIdx.x == 0 && threadIdx.x == 0) TS[nst] = __builtin_amdgcn_s_memrealtime();
    ++nst;
#define GSYNC() do { xcd_barrier(xbar, TS + nst); ++nst; } while (0)
#define GSYNC_CG() do { grid.sync(); if (blockIdx.x == 0 && threadIdx.x == 0) TS[nst] = __builtin_amdgcn_s_memrealtime(); ++nst; } while (0)
#else
#define GSYNC() xcd_barrier(xbar)
#define GSYNC_CG() grid.sync()
#endif
#define FFN(mat) do { gemm_phase(lds, H, (const bf16_t*)(ws + WS_WGU) + (size_t)(mat) * 5632 * 1024, NT, 5632, 1024, EpiSwiglu{ACT, RSTD}); GSYNC(); \
                      gemm_phase(lds, ACT, (const bf16_t*)(ws + WS_WD) + (size_t)(mat) * 1024 * FF, NP, 1024, FF, EpiBf16{(bf16_t*)Y, D}); \
                      gemm_phase(lds, ACT, (const bf16_t*)(ws + WS_WD) + (size_t)(mat) * 1024 * FF, NS, 1024, FF, EpiBf16{(bf16_t*)YT - (size_t)NP * D, D, (size_t)NS * D}, NP, 11); GSYNC(); } while (0)

#if DEBUG_FILL
    { PH_IDS; for (size_t i = (size_t)gw * 64 + lane; i < O_END; i += (size_t)ngw * 64) pout()[i] = 0.f; }
#endif
    { PH_IDS; phase_prep(p, lds, gw, ngw, lane, wave); }
    { PH_IDS; RowNormArgs a{}; a.x_in_p = pin(0); a.x_in_s = pin(1); a.xb = H; a.write_x = true; a.rstd = RSTD; phase_rownorm(a, gw, ngw, lane); }
    GSYNC_CG();
    FFN(0);
    { PH_IDS; RowNormArgs a{}; a.Ysrc = Y; a.Yt = (const bf16_t*)YT; a.ntp = 11; a.g_post = norm_g + 1 * D; a.scale = 0.5f; a.xb = H; a.write_x = true; a.rstd = RSTD;
      phase_rownorm(a, gw, ngw, lane); }
    GSYNC();
    gemm_phase(lds, H, (const bf16_t*)(ws + WS_WEIN), NT, EV_N + 256, 1024, EpiInProj{P, EV_N, EV_N, EXT, 8, RSTD});
    GSYNC();
    { PROF_T0(); { PH_IDS; phase_even_a(p, P, EXT, QKV, GB, NP, gw, ngw, lane); } PROF_MAX(5);
    phase_chunk_prep(p, P, EXT, ws, lds); PROF_MAX(6); }
    GSYNC();
    { PROF_T0();
    if (blockIdx.x < 64) { phase_scan(p, ws, OB, lds, blockIdx.x); PROF_MAX(0); }
    else { delta_recurrence(p, QKV, GB, OB, lds, 16 + (int)blockIdx.x - 64, G - 64, 16, 16 + 512); PROF_MAX(1);
           phase_compress_s(p, ws, lds, (int)blockIdx.x - 64, G - 64, 512);
           { const int nS = G - 64, sidx = (int)blockIdx.x - 64, heavy = 512 % nS;
             const unsigned W = heavy ? (unsigned)(heavy + (nS - heavy) * 8) : (unsigned)nS;
             const unsigned c0 = !heavy || sidx < heavy ? (unsigned)sidx : (unsigned)(heavy + (sidx - heavy) * 8), c1 = c0 + (!heavy || sidx < heavy ? 1u : 8u);
             phase_win_copy((unsigned)((unsigned long long)WINCOPY_N4 * c0 / W), (unsigned)((unsigned long long)WINCOPY_N4 * c1 / W)); }
           PROF_MAX(7); } }
    GSYNC();
    { PH_IDS; phase_even_c(p, P, OB, MIX, gw, ngw, lane); }
    GSYNC();
    gemm_phase(lds, MIX, (const bf16_t*)(ws + WS_WEOUT), NP, 1024, 1024, EpiBf16{(bf16_t*)Y, D});
    gemm_phase(lds, MIX, (const bf16_t*)(ws + WS_WEOUT), NS, 1024, 1024, EpiBf16{(bf16_t*)YT - (size_t)NP * D, D, (size_t)NS * D}, NP, 4);
    GSYNC();
    { PH_IDS; RowNormArgs a{};  a.Ysrc = Y; a.Yt = (const bf16_t*)YT; a.ntp = 4; a.g_post = norm_g + 3 * D; a.scale = 1.f; a.xb = H; a.write_x = true; a.rstd = RSTD; phase_rownorm(a, gw, ngw, lane); }
    GSYNC();
    FFN(1);
    { PH_IDS; RowNormArgs a{};  a.Ysrc = Y; a.Yt = (const bf16_t*)YT; a.ntp = 11; a.g_post = norm_g + 5 * D; a.scale = 0.5f; a.xb = H; a.write_x = true; a.rstd = RSTD; phase_rownorm(a, gw, ngw, lane); }
    GSYNC();
    FFN(2);
    { PH_IDS; RowNormArgs a{};  a.Ysrc = Y; a.Yt = (const bf16_t*)YT; a.ntp = 11; a.g_post = norm_g + 7 * D; a.scale = 0.5f; a.xb = H; a.write_x = true; a.rstd = RSTD;
      phase_rownorm(a, gw, ngw, lane); }
    GSYNC();
    gemm_phase(lds, H, (const bf16_t*)(ws + WS_WOIN), NT, OD_N + 256, 1024, EpiInProj{P, OD_N, OD_N, EXT, 24, RSTD});
    GSYNC();
    { PROF_T0(); { PH_IDS; const int bid = (int)blockIdx.x, nc_ = min(64, (int)G);
        const unsigned W = (unsigned)(nc_ * 1 + ((int)G - nc_) * 7), c0 = (unsigned)(bid < nc_ ? bid * 1 : nc_ * 1 + (bid - nc_) * 7), c1 = c0 + (bid < nc_ ? 1u : 7u);
        const int lo = (int)((unsigned long long)NT * c0 / W), hi = (int)((unsigned long long)NT * c1 / W);
        phase_odd_a(p, P, EXT, GATES, UG, VLN, lo + wave, 8, lane, hi); } PROF_MAX(2); }
    { PROF_T0();
    phase_vtp(P, (bf16_t*)(ws + WS_VTP), lds); PROF_MAX(3);
    phase_compress<false>(p, P, ws, lds, blockIdx.x, G, 64); PROF_MAX(4); }
    GSYNC();

    phase_attn(p, P, (const bf16_t*)(ws + WS_KC), (const bf16_t*)(ws + WS_VC), (const bf16_t*)(ws + WS_VTP), GATES, MIX, lds);

    phase_chunkmlp(p, ws, UG, VLN, MIX, lds);
#if PROFILE == 2
    if (threadIdx.x == 0) { unsigned* W = (unsigned*)(pws() + WS_BAR) + 3600; LAS unsigned* TA = (LAS unsigned*)(lds + 147456 - 512) + 64; for (int i = 0; i < 12; ++i) atomicMax(W + i, TA[i]); }
#endif
    { PH_IDS; phase_chunkmlp_naive(p, UG, VLN, MIX, NP, gw, ngw, lane); }
    GSYNC();
    gemm_phase(lds, MIX, (const bf16_t*)(ws + WS_WOOUT), NP, 1024, 1024, EpiBf16{(bf16_t*)Y, D});
    gemm_phase(lds, MIX, (const bf16_t*)(ws + WS_WOOUT), NS, 1024, 1024, EpiBf16{(bf16_t*)YT - (size_t)NP * D, D, (size_t)NS * D}, NP, 4);
    GSYNC();
    { PH_IDS; RowNormArgs a{};  a.Ysrc = Y; a.Yt = (const bf16_t*)YT; a.ntp = 4; a.g_post = norm_g + 9 * D; a.scale = 1.f; a.xb = H; a.write_x = true; a.rstd = RSTD; phase_rownorm(a, gw, ngw, lane); }
    GSYNC();
    FFN(3);
    { PH_IDS; RowNormArgs a{};  a.Ysrc = Y; a.Yt = (const bf16_t*)YT; a.ntp = 11; a.g_post = norm_g + 11 * D; a.scale = 0.5f; a.xb = H; a.write_x = false; a.out_p = pout() + O_YP; a.out_s = pout() + O_YS; phase_rownorm(a, gw, ngw, lane); }
#if PROFILE == 3
    GSYNC();
    if (blockIdx.x == 127 && threadIdx.x < 12) {
        const unsigned tot = ((unsigned*)(pws() + WS_BAR))[3600 + threadIdx.x];
        const int cnt = (int)((tot + 500) / 1000);
        const size_t offs[12] = {O_YP, O_YS, O_DP, O_DS, O_CAP, O_CAS, O_CBP, O_CBS, O_CMP, O_CMS, O_SLP, O_SLS};
        for (int i = 0; i < cnt && i < 4000; ++i) ((unsigned*)pout())[offs[threadIdx.x] + i] = 0xAAAAAAAAu;
    }
#elif PROFILE == 2
    GSYNC();
    if (blockIdx.x == 127 && threadIdx.x < 12) {
        const unsigned tot = ((unsigned*)(pws() + WS_BAR))[3600 + threadIdx.x];
        const int cnt = threadIdx.x >= 10 ? (int)tot : (int)((tot + 500) / 1000);
        const size_t offs[12] = {O_YP, O_YS, O_DP, O_DS, O_CAP, O_CAS, O_CBP, O_CBS, O_CMP, O_CMS, O_SLP, O_SLS};
        for (int i = 0; i < cnt && i < 4000; ++i) ((unsigned*)pout())[offs[threadIdx.x] + i] = 0xAAAAAAAAu;
    }
#elif PROFILE
    GSYNC();
    if (blockIdx.x == 0 && threadIdx.x < 13) {
        const int cat_of[24] = {0, 1, 2, 4, 6, 8, 9, 10, 7, 3, 1, 2, 3, 1, 2, 5, 6, 11, 12, 7, 3, 1, 2, 3};
        unsigned long long tot = 0;
        for (int i = 0; i < 24; ++i) if (cat_of[i] == (int)threadIdx.x) tot += TS[i + 1] - TS[i];
        const int cnt = (int)((tot + 500) / 1000);
        const size_t offs[13] = {O_YP, O_YS, O_DP, O_DS, O_CAP, O_CAS, O_CBP, O_CBS, O_CMP, O_CMS, O_SLP, O_SLS, O_WNP};
        for (int i = 0; i < cnt && i < 4000; ++i) ((unsigned*)pout())[offs[threadIdx.x] + i] = 0xAAAAAAAAu;
    }
#endif
}

#undef ws
#undef X
#undef H
#undef ACT
#undef Y
#undef P
#undef EXT
#undef MIX
#undef OB
#undef QKV
#undef GB
#undef GATES
#undef UG
#undef VLN
#undef YT
#undef norm_g
#undef RSTD
extern "C" void kernel_launch(void* const* d_in, const int* in_sizes, int n_in, void* d_out, int out_size, void* d_ws, size_t ws_size, hipStream_t stream) {
    constexpr int LDS_BYTES = 147456;
    static int grid = 0;
    if (grid == 0) {
        int dev = 0, cus = 0, per_cu = 0;
        hipGetDevice(&dev);
        hipDeviceGetAttribute(&cus, hipDeviceAttributeMultiprocessorCount, dev);
        hipFuncSetAttribute((const void*)fwd_kernel, hipFuncAttributeMaxDynamicSharedMemorySize, LDS_BYTES);
        hipOccupancyMaxActiveBlocksPerMultiprocessor(&per_cu, (const void*)fwd_kernel, NTHR, LDS_BYTES);
        if (per_cu < 1) { fprintf(stderr, "occupancy query says %d blocks/CU\n", per_cu); per_cu = 1; }
        grid = cus;
        if (ws_size < WS_END) { fprintf(stderr, "workspace too small: %zu < %zu\n", ws_size, (size_t)WS_END); grid = -1; }
        if (n_in != 29) { fprintf(stderr, "expected 29 inputs, got %d\n", n_in); grid = -1; }
    }
    if (grid < 0) return;
    Params p{};
    for (int i = 0; i < 29; ++i) p.in[i] = (const float*)d_in[i];
    p.page_table = (const int*)d_in[8];
    p.out = (float*)d_out; p.ws = (unsigned char*)d_ws;
    (void)hipMemsetAsync((unsigned char*)d_ws + WS_BAR, 0, 16384, stream);
    void* args[] = {&p};
    hipError_t e = hipLaunchCooperativeKernel((const void*)fwd_kernel, dim3(grid), dim3(NTHR), args, LDS_BYTES, stream);
    if (e != hipSuccess) fprintf(stderr, "cooperative launch failed: %s (grid %d)\n", hipGetErrorString(e), grid);
}
```

```cpp
#include <hip/hip_runtime.h>
#include <hip/hip_cooperative_groups.h>
#include <cstdio>
#include <cstdint>
namespace cg = cooperative_groups;
#define DEBUG_FILL 0
#ifndef PROFILE
#define PROFILE 0
#endif
#ifndef GEMM_SP2
#define GEMM_SP2 1
#endif
#define PV_A 0
#define PV_B 3
#ifndef ATT_ABL
#define ATT_ABL 0
#endif

typedef unsigned short bf16_t;
typedef short bf16x8 __attribute__((ext_vector_type(8)));
typedef float f32x4 __attribute__((ext_vector_type(4)));
typedef unsigned u32x4 __attribute__((ext_vector_type(4)));
typedef unsigned u32x2 __attribute__((ext_vector_type(2)));
#define DEV __device__ __forceinline__
#define LAS __attribute__((address_space(3)))

constexpr int D = 1024, NP = 16384, NS = 1024, NT = NP + NS, SEQ = 4096, NB = 4, DB = 128, DSQ = 8, PAST = 2048;
constexpr int FF = 2816;
constexpr int EV_N = 3584, EV_SRC = 3592, OD_N = 2304, OD_SRC = 2328;
constexpr int NTHR = 512;

constexpr size_t O_YP = 0, O_YS = O_YP + (size_t)NP * D, O_DP = O_YS + (size_t)NS * D, O_DS = O_DP + 4 * 4 * 128 * 128,
                 O_CAP = O_DS + (size_t)128 * 4 * 128 * 128, O_CAS = O_CAP + 4 * 3 * 1536, O_CBP = O_CAS + 128 * 3 * 1536,
                 O_CBS = O_CBP + 4 * 2 * 512, O_CMP = O_CBS + 128 * 2 * 512, O_CMS = O_CMP + (size_t)NP * 256,
                 O_SLP = O_CMS + (size_t)NS * 256, O_SLS = O_SLP + (size_t)NP * 256, O_WNP = O_SLS + (size_t)NS * 256,
                 O_WNS = O_WNP + 4 * 512 * 256, O_DV = O_WNS + (size_t)128 * 512 * 256, O_END = O_DV + (size_t)NS * 512;

constexpr size_t al256(size_t x) { return (x + 255) & ~(size_t)255; }
constexpr size_t WS_WGU = 0;
constexpr size_t WS_WD = WS_WGU + (size_t)4 * 5632 * 1024 * 2;
constexpr size_t WS_WEIN = WS_WD + (size_t)4 * 1024 * 2816 * 2;
constexpr size_t WS_WEOUT = WS_WEIN + (size_t)(EV_N + 256) * 1024 * 2;
constexpr size_t WS_WOIN = WS_WEOUT + (size_t)1024 * 1024 * 2;
constexpr size_t WS_WOOUT = WS_WOIN + (size_t)(OD_N + 256) * 1024 * 2;
constexpr size_t WS_WC1 = WS_WOOUT + (size_t)1024 * 1024 * 2;
constexpr size_t WS_WC2 = WS_WC1 + (size_t)2 * 256 * 1024 * 2;
constexpr size_t WS_WDS = WS_WC2 + (size_t)2 * 64 * 128 * 2;
constexpr size_t WS_CBIAS = WS_WDS + (size_t)8 * 128 * 128 * 2;
constexpr size_t WS_X = al256(WS_CBIAS + 2 * 128 * 4);
constexpr size_t WS_H = WS_X + (size_t)NT * D * 4;
constexpr size_t WS_ACT = WS_H + (size_t)NT * D * 2;
constexpr size_t WS_Y = WS_ACT + (size_t)NT * FF * 2;
constexpr size_t WS_P = WS_Y + (size_t)NT * D * 4;
constexpr size_t WS_EXT = WS_P + (size_t)NT * EV_N * 2;
constexpr size_t WS_MIX = al256(WS_EXT + (size_t)NT * 24 * 4);
constexpr size_t WS_OB = WS_MIX + (size_t)NT * D * 2;
constexpr size_t WS_CW = WS_OB + (size_t)NT * 512 * 4;
constexpr size_t WS_CQ = WS_CW + (size_t)1024 * 64 * 128 * 2;
constexpr size_t WS_CKT = WS_CQ + (size_t)1024 * 64 * 128 * 2;
constexpr size_t WS_CU = WS_CKT + (size_t)1024 * 64 * 128 * 2;
constexpr size_t WS_CI = WS_CU + (size_t)1024 * 64 * 128 * 4;
constexpr size_t WS_CGL = WS_CI + (size_t)1024 * 64 * 64 * 2;
constexpr size_t WS_KC = al256(WS_CGL + 1024 * 4);
constexpr size_t KC_ELEMS = (size_t)(4 * 2 * 256 + 128 * 2 * 128) * 64;
constexpr size_t WS_VC = WS_KC + KC_ELEMS * 2;
constexpr size_t WS_QKV = al256(WS_VC + KC_ELEMS * 2);
constexpr size_t WS_GB = WS_QKV + (size_t)NT * 1536 * 4;
constexpr size_t WS_GATES = WS_GB + (size_t)NT * 8 * 4;
constexpr size_t WS_UG = al256(WS_GATES + (size_t)NT * 24 * 4);
constexpr size_t WS_VLN = WS_UG + (size_t)NT * 512 * 4;
constexpr size_t WS_KCF = WS_VLN + (size_t)NT * 512 * 4;
constexpr size_t WS_VTP = al256(WS_KCF + KC_ELEMS * 2 * 4);
constexpr size_t WS_YT = WS_VTP + (size_t)2 * 4 * 2 * 64 * 4096 * 2;
constexpr size_t WS_RSTD = WS_YT + (size_t)11 * NS * D * 4;
constexpr size_t WS_BAR = al256(WS_RSTD + (size_t)NT * 4);
constexpr size_t WS_END = WS_BAR + 16384;

struct Params {
    const float* in[29];
    const int* page_table;
    float* out;
    unsigned char* ws;
};

DEV unsigned f2bf(float f) { return (unsigned)__builtin_bit_cast(unsigned short, (__bf16)f); }
typedef __bf16 hwbf16x2 __attribute__((ext_vector_type(2)));
typedef float f32x2_ __attribute__((ext_vector_type(2)));
DEV unsigned pk2(float lo, float hi) { const f32x2_ v = {lo, hi}; return __builtin_bit_cast(unsigned, __builtin_convertvector(v, hwbf16x2)); }
DEV float bf2f(unsigned short v) { return __builtin_bit_cast(float, (unsigned)v << 16); }
DEV float bflo(unsigned v) { return __builtin_bit_cast(float, v << 16); }
DEV float bfhi(unsigned v) { return __builtin_bit_cast(float, v & 0xffff0000u); }
DEV int opaque_tid() { int t = threadIdx.x; asm volatile("" : "+v"(t)); return t; }
constexpr int PTAB_OFF = 147456 - 1024 + 64;
DEV unsigned long long ptab_get(int i) { const unsigned long long v = ((LAS unsigned long long*)(unsigned)PTAB_OFF)[i];
    return (unsigned long long)(unsigned)__builtin_amdgcn_readfirstlane((unsigned)v) | ((unsigned long long)(unsigned)__builtin_amdgcn_readfirstlane((unsigned)(v >> 32)) << 32); }
#define GAS __attribute__((address_space(1)))
DEV const float* pin(int i) { return (const float*)(GAS const float*)ptab_get(i); }
DEV const int* ppt() { return (const int*)(GAS const int*)ptab_get(8); }
DEV float* pout() { return (float*)(GAS float*)ptab_get(29); }
DEV unsigned char* pws() { return (unsigned char*)(GAS unsigned char*)ptab_get(30); }
DEV void lds_barrier() { asm volatile("s_waitcnt lgkmcnt(0)" ::: "memory"); __builtin_amdgcn_s_barrier(); asm volatile("" ::: "memory"); }
template <int CTRL> DEV float dpp_f(float v) { return __builtin_bit_cast(float, __builtin_amdgcn_update_dpp(0, __builtin_bit_cast(int, v), CTRL, 0xf, 0xf, true)); }
template <int CTRL> DEV unsigned dpp_u(unsigned v) { return (unsigned)__builtin_amdgcn_update_dpp(0, (int)v, CTRL, 0xf, 0xf, true); }
constexpr int DPP_XOR1 = 0xB1, DPP_XOR2 = 0x4E, DPP_HMIRROR = 0x141, DPP_MIRROR = 0x140;
DEV float sum8_(float v) { v += dpp_f<DPP_XOR1>(v); v += dpp_f<DPP_XOR2>(v); v += dpp_f<DPP_HMIRROR>(v); return v; }
DEV float sum16_(float v) { v = sum8_(v); v += dpp_f<DPP_MIRROR>(v); return v; }
DEV void swap16_(float v, float& a, float& b) { a = v; b = v; asm volatile("v_nop\n\tv_nop\n\tv_permlane16_swap_b32 %0, %1" : "+v"(a), "+v"(b)); }
DEV void swap32_(float v, float& a, float& b) { a = v; b = v; asm volatile("v_nop\n\tv_nop\n\tv_permlane32_swap_b32 %0, %1" : "+v"(a), "+v"(b)); }
DEV float xrow_sum(float v) { float a, b; swap16_(v, a, b); v = a + b; swap32_(v, a, b); return a + b; }
DEV float xrow_max(float v) { float a, b; swap16_(v, a, b); v = fmaxf(a, b); swap32_(v, a, b); return fmaxf(a, b); }
DEV float wave_sum(float v) { return xrow_sum(sum16_(v)); }
DEV float sigmoidf_(float x) { return __builtin_amdgcn_rcpf(1.f + __expf(-x)); }
DEV float siluf_(float x) { return x * __builtin_amdgcn_rcpf(1.f + __expf(-x)); }
DEV float softplusf_(float x) { return x > 20.f ? x : log1pf(__expf(x)); }
DEV float geluf_(float x) { const float u = 0.7978845608028654f * (x + 0.044715f * x * x * x); return x * __builtin_amdgcn_rcpf(1.f + __expf(-2.f * u)); }

DEV void transpose_item(const float* W, int ldn, int k0, int n0, bf16_t* WT, int ldk, int dst_row0, LAS float* scr, int lane, const float* gk = nullptr) {
    const float gv = gk ? gk[k0 + lane] : 1.f;
#pragma unroll 8
    for (int i = 0; i < 32; ++i) { const int kk = 2 * i + (lane >> 5); scr[kk * 33 + (lane & 31)] = W[(size_t)(k0 + kk) * ldn + n0 + (lane & 31)] * __shfl(gv, kk); }
    asm volatile("s_waitcnt lgkmcnt(0)" ::: "memory");
    const int c = lane & 7;
#pragma unroll
    for (int j = 0; j < 4; ++j) { const int n = (lane >> 3) + 8 * j; const LAS float* s = scr + (8 * c) * 33 + n;
        u32x4 o; o.x = pk2(s[0 * 33], s[1 * 33]); o.y = pk2(s[2 * 33], s[3 * 33]); o.z = pk2(s[4 * 33], s[5 * 33]); o.w = pk2(s[6 * 33], s[7 * 33]);
        *(u32x4*)(WT + (size_t)(dst_row0 + n) * ldk + k0 + 8 * c) = o; }
    asm volatile("s_waitcnt lgkmcnt(0)" ::: "memory");
}

DEV void phase_prep(const Params& p, LAS unsigned char* lds, int gw, int ngw, int lane, int wave) {
    LAS float* scr = (LAS float*)(lds + wave * 16384);
    unsigned char* ws = pws();
    constexpr int I_G = 16 * 88;
    constexpr int I_D = 44 * 32;
    constexpr int I_EIN = 16 * 112, I_SQ = 16 * 32, I_OIN = 16 * 72, I_C1 = 4 * 16 * 4;
    constexpr int T0 = 4 * I_G, T1 = T0 + 4 * I_G, T2 = T1 + 4 * I_D, T3 = T2 + I_EIN, T4 = T3 + I_SQ, T5 = T4 + I_OIN, T6 = T5 + I_SQ, T7 = T6 + I_C1;
    for (int it = gw; it < T7 + 32; it += ngw) {
        if (it >= T7) {
            const int r = it - T7, kb = r & 15;
            if (r < 16) transpose_item(pin(13), EV_SRC, kb * 64, 2048, (bf16_t*)(ws + WS_WEIN), 1024, EV_N, scr, lane, pin(9) + 2 * D);
            else transpose_item(pin(20), OD_SRC, kb * 64, 512, (bf16_t*)(ws + WS_WOIN), 1024, OD_N, scr, lane, pin(9) + 8 * D);
            continue;
        }
        if (it < T1) {
            const bool up = it >= T0; const int r = up ? it - T0 : it; const int mat = r / I_G, rr = r % I_G, kb = rr / 88, nb = rr % 88;
            const float* W = (up ? pin(11) : pin(10)) + (size_t)mat * 1024 * FF;
            bf16_t* WT = (bf16_t*)(ws + WS_WGU) + (size_t)mat * 5632 * 1024;
            const int n0 = nb * 32, pn = n0 / 128, c = n0 % 128;
            transpose_item(W, FF, kb * 64, n0, WT, 1024, pn * 256 + (up ? 128 : 0) + c, scr, lane, pin(9) + ((mat >> 1) * 6 + ((mat & 1) ? 4 : 0)) * D);
        } else if (it < T2) {
            const int r = it - T1, mat = r / I_D, rr = r % I_D, kb = rr / 32, nb = rr % 32;
            transpose_item(pin(12) + (size_t)mat * FF * 1024, 1024, kb * 64, nb * 32, (bf16_t*)(ws + WS_WD) + (size_t)mat * 1024 * FF, FF, nb * 32, scr, lane);
        } else if (it < T3) {
            const int r = it - T2, kb = r / 112, nb = r % 112, dr = nb * 32;
            transpose_item(pin(13), EV_SRC, kb * 64, dr < 2048 ? dr : dr + 8, (bf16_t*)(ws + WS_WEIN), 1024, dr, scr, lane, pin(9) + 2 * D);
        } else if (it < T4) {
            const int r = it - T3, kb = r / 32, nb = r % 32;
            transpose_item(pin(14), 1024, kb * 64, nb * 32, (bf16_t*)(ws + WS_WEOUT), 1024, nb * 32, scr, lane);
        } else if (it < T5) {
            const int r = it - T4, kb = r / 72, nb = r % 72, dr = nb * 32;
            transpose_item(pin(20), OD_SRC, kb * 64, dr < 512 ? dr : dr + 24, (bf16_t*)(ws + WS_WOIN), 1024, dr, scr, lane, pin(9) + 8 * D);
        } else if (it < T6) {
            const int r = it - T5, kb = r / 32, nb = r % 32;
            transpose_item(pin(21), 1024, kb * 64, nb * 32, (bf16_t*)(ws + WS_WOOUT), 1024, nb * 32, scr, lane);
        } else {
            const int r = it - T6, kvh = r / 64, rr = r % 64, kb = rr / 4, nb = rr % 4;
            const float* W = pin(23) + (size_t)(kvh >> 1) * 2048 * 128 + (size_t)(kvh & 1) * 1024 * 128;
            transpose_item(W, 128, kb * 64, nb * 32, (bf16_t*)(ws + WS_WC1) + (size_t)(kvh >> 1) * 256 * 1024, 1024, (kvh & 1) * 128 + nb * 32, scr, lane);
        }
    }
    const int gt = gw * 64 + lane, ngt = ngw * 64;
    for (int i = gt; i < 2 * 64 * 128; i += ngt) {
        const int kv = i / 8192, r = i % 8192, d = r / 128, h = r % 128;
        ((bf16_t*)(ws + WS_WC2))[i] = (bf16_t)f2bf(pin(24)[(size_t)kv * 8192 + h * 64 + d]);
    }
    for (int i = gt; i < 8 * 128 * 128; i += ngt) {
        const int t = (i / 128) % 128, s = i % 128;
        ((bf16_t*)(ws + WS_WDS))[i] = (bf16_t)f2bf(s <= t ? pin(25)[i] : 0.f);
    }
    for (int o = gw; o < 256; o += ngw) {
        const int kv = o / 128, h = o % 128; float acc = 0.f;
        for (int k = lane; k < 2048; k += 64) acc += pin(22)[(size_t)kv * 2048 + k] * pin(23)[((size_t)kv * 2048 + k) * 128 + h];
        acc = wave_sum(acc);
        if (lane == 0) ((float*)(ws + WS_CBIAS))[o] = acc;
    }
}

struct RowNormArgs {
    const float* x_in_p; const float* x_in_s;
    const float* Ysrc;
    const bf16_t* Yt; int ntp;
    const float* g_post; float scale;
    bf16_t* xb;
    float* rstd;
    float* out_p; float* out_s;
    bool write_x;
};
DEV void phase_rownorm(const RowNormArgs& a, int gw, int ngw, int lane) {
    f32x4 gpost[4];
#pragma unroll
    for (int j = 0; j < 4; ++j) gpost[j] = a.Ysrc ? ((const f32x4*)a.g_post)[lane + 64 * j] : (f32x4){0.f, 0.f, 0.f, 0.f};
    for (int row = gw; row < NT; row += ngw) {
        f32x4 v[4];
        if (a.x_in_p) { const float* xr = row < NP ? a.x_in_p + (size_t)row * D : a.x_in_s + (size_t)(row - NP) * D;
#pragma unroll
            for (int j = 0; j < 4; ++j) v[j] = ((const f32x4*)xr)[lane + 64 * j]; }
        else {
#pragma unroll
            for (int j = 0; j < 4; ++j) { const u32x2 w = ((const u32x2*)(a.xb + (size_t)row * D))[lane + 64 * j]; v[j] = (f32x4){bflo(w.x), bfhi(w.x), bflo(w.y), bfhi(w.y)}; } }
        if (a.Ysrc) {
            f32x4 y[4]; float s = 0.f;
#pragma unroll
            for (int j = 0; j < 4; ++j) {
                if (row < NP) { const u32x2 w = ((const u32x2*)((const bf16_t*)a.Ysrc + (size_t)row * D))[lane + 64 * j]; y[j] = (f32x4){bflo(w.x), bfhi(w.x), bflo(w.y), bfhi(w.y)}; }
                else { y[j] = (f32x4){0.f, 0.f, 0.f, 0.f};
                    for (int q = 0; q < a.ntp; ++q) { const u32x2 w = ((const u32x2*)(a.Yt + ((size_t)q * NS + (row - NP)) * D))[lane + 64 * j]; y[j] += (f32x4){bflo(w.x), bfhi(w.x), bflo(w.y), bfhi(w.y)}; } }
                s += (y[j].x * y[j].x + y[j].y * y[j].y) + (y[j].z * y[j].z + y[j].w * y[j].w); }
            const float r = a.scale * rsqrtf(wave_sum(s) * (1.f / D) + 1e-6f);
#pragma unroll
            for (int j = 0; j < 4; ++j) v[j] += y[j] * gpost[j] * r;
        }
        if (a.out_p) {
            float* o = row < NP ? a.out_p + (size_t)row * D : a.out_s + (size_t)(row - NP) * D;
#pragma unroll
            for (int j = 0; j < 4; ++j) __builtin_nontemporal_store(v[j], (f32x4*)o + lane + 64 * j);
        }
        if (a.write_x) {
#pragma unroll
            for (int j = 0; j < 4; ++j) { u32x2 w; w.x = pk2(v[j].x, v[j].y); w.y = pk2(v[j].z, v[j].w); ((u32x2*)(a.xb + (size_t)row * D))[lane + 64 * j] = w; }
        }
        if (a.rstd) {
            float s = 0.f;
#pragma unroll
            for (int j = 0; j < 4; ++j) s += (v[j].x * v[j].x + v[j].y * v[j].y) + (v[j].z * v[j].z + v[j].w * v[j].w);
            const float r = rsqrtf(wave_sum(s) * (1.f / D) + 1e-6f);
            if (lane == 0) a.rstd[row] = r;
        }
    }
}

constexpr int BM = 256, BK = 64, HALF = 128, NXCD = 8, WGM = 8, HT = HALF * BK;
DEV int lds_byte(int r, int c) { const int st = (r >> 4) * 2 + (c >> 5), rr = r & 15, cc = c & 31, ob = rr * 64 + cc * 2; return st * 1024 + (ob ^ (((ob >> 9) & 1) << 5)); }
DEV void stage_rc(int b, int& R, int& C) { const int st = b / 1024, sb = b % 1024, swz = sb ^ (((sb >> 9) & 1) << 5); R = (st >> 1) * 16 + swz / 64; C = (st & 1) * 32 + (swz % 64) / 2; }

struct EpiF32 {
    static constexpr bool ROWSCALE = false;
    float* C0; int ldc; size_t part_stride;
    DEV void operator()(const f32x4 (&acc)[2][2][4][2], int brow, int bcol, int wr, int wc, int fr, int fq, int part, const float (&rs)[8]) const {
        float* C = C0 + (size_t)part * part_stride;
#pragma unroll
        for (int ai = 0; ai < 2; ++ai)
#pragma unroll
            for (int m = 0; m < 4; ++m) { float* rowp = C + (size_t)(brow + ai * HALF + wr * 64 + m * 16 + fr) * ldc + bcol + wc * 32 + fq * 4;
#pragma unroll
                for (int bj = 0; bj < 2; ++bj)
#pragma unroll
                    for (int n = 0; n < 2; ++n) *(f32x4*)(rowp + bj * HALF + n * 16) = acc[ai][bj][m][n]; }
    }
};
struct EpiBf16 {
    static constexpr bool ROWSCALE = false;
    bf16_t* C0; int ldc; size_t part_stride;
    DEV void operator()(const f32x4 (&acc)[2][2][4][2], int brow, int bcol, int wr, int wc, int fr, int fq, int part, const float (&rs)[8]) const {
        bf16_t* C = C0 + (size_t)part * part_stride;
#pragma unroll
        for (int ai = 0; ai < 2; ++ai)
#pragma unroll
            for (int m = 0; m < 4; ++m) { bf16_t* rowp = C + (size_t)(brow + ai * HALF + wr * 64 + m * 16 + fr) * ldc + bcol + wc * 32 + fq * 4;
#pragma unroll
                for (int bj = 0; bj < 2; ++bj)
#pragma unroll
                    for (int n = 0; n < 2; ++n) { const f32x4 v = acc[ai][bj][m][n]; u32x2 w; w.x = pk2(v[0], v[1]); w.y = pk2(v[2], v[3]); *(u32x2*)(rowp + bj * HALF + n * 16) = w; } }
    }
};
struct EpiInProj {
    static constexpr bool ROWSCALE = true;
    bf16_t* C; int ldc; int n_main; float* ext; int n_ext; const float* rstd;
    DEV void operator()(const f32x4 (&acc)[2][2][4][2], int brow, int bcol, int wr, int wc, int fr, int fq, int part, const float (&rs)[8]) const {
        if (bcol < n_main) {
#pragma unroll
            for (int ai = 0; ai < 2; ++ai)
#pragma unroll
                for (int m = 0; m < 4; ++m) { const int row = brow + ai * HALF + wr * 64 + m * 16 + fr; const float r = rs[ai * 4 + m]; bf16_t* rowp = C + (size_t)row * ldc + bcol + wc * 32 + fq * 4;
#pragma unroll
                    for (int bj = 0; bj < 2; ++bj)
#pragma unroll
                        for (int n = 0; n < 2; ++n) { const f32x4 v = acc[ai][bj][m][n] * r; u32x2 w; w.x = pk2(v[0], v[1]); w.y = pk2(v[2], v[3]); *(u32x2*)(rowp + bj * HALF + n * 16) = w; } }
            return; }
        if (wc == 0) {
#pragma unroll
            for (int n = 0; n < 2; ++n) { const int c = n * 16 + fq * 4;
                if (c < n_ext) {
#pragma unroll
                    for (int ai = 0; ai < 2; ++ai)
#pragma unroll
                        for (int m = 0; m < 4; ++m) { const int row = brow + ai * HALF + wr * 64 + m * 16 + fr; *(f32x4*)(ext + (size_t)row * 24 + c) = acc[ai][0][m][n] * rs[ai * 4 + m]; }
                } }
        }
    }
};
struct EpiSwiglu {
    static constexpr bool ROWSCALE = true;
    bf16_t* C; const float* rstd;
    DEV void operator()(const f32x4 (&acc)[2][2][4][2], int brow, int bcol, int wr, int wc, int fr, int fq, int part, const float (&rs)[8]) const {
#pragma unroll
        for (int ai = 0; ai < 2; ++ai)
#pragma unroll
            for (int m = 0; m < 4; ++m) { const int row = brow + ai * HALF + wr * 64 + m * 16 + fr; const float r = rs[ai * 4 + m]; bf16_t* rowp = C + (size_t)row * FF + (bcol >> 1) + wc * 32 + fq * 4;
#pragma unroll
                for (int n = 0; n < 2; ++n) { const f32x4 g = acc[ai][0][m][n] * r, u = acc[ai][1][m][n] * r;
                    u32x2 w; w.x = pk2(siluf_(g[0]) * u[0], siluf_(g[1]) * u[1]); w.y = pk2(siluf_(g[2]) * u[2], siluf_(g[3]) * u[3]); *(u32x2*)(rowp + n * 16) = w; } }
    }
};

template <class Epi>
DEV void gemm_phase(LAS unsigned char* lds, const bf16_t* __restrict__ A, const bf16_t* __restrict__ Bt, int M, int N, int K, const Epi& E, int row0 = 0, int nparts = 1) {
    const int tidg = opaque_tid();
    const int wid = __builtin_amdgcn_readfirstlane(tidg >> 6), lane = tidg & 63, wr = wid >> 2, wc = wid & 3, fr = lane & 15, fq = lane >> 4;
    unsigned voff[2];
#pragma unroll
    for (int i = 0; i < 2; ++i) { int R, C; stage_rc(tidg * 16 + i * 8192, R, C); voff[i] = (unsigned)(R * K + C) * 2u; }
    const size_t hstep = (size_t)HALF * K * 2;
    const unsigned ldsw = (unsigned)wid * 1024u;
    const int aoff = lds_byte(wr * 64 + fr, fq * 8), boff = lds_byte(wc * 32 + fr, fq * 8);
#define G_SA(b, h) (((b) * 2 + (h)) * (HT * 2))
#define G_SB(b, h) ((4 + (b) * 2 + (h)) * (HT * 2))
#define STAGE(bufoff, gbase) do { _Pragma("unroll") for (int _i = 0; _i < 2; ++_i) \
      __builtin_amdgcn_global_load_lds((const unsigned*)((const char*)(gbase) + voff[_i]), (LAS unsigned*)(lds + (bufoff) + ldsw + _i * 8192), 16, 0, 0); } while (0)
#define LDA(dst, b, h) do { _Pragma("unroll") for (int m = 0; m < 4; ++m) _Pragma("unroll") for (int k = 0; k < 2; ++k) dst[m][k] = *(const LAS bf16x8*)(lds + G_SA(b, h) + aoff + m * 2048 + k * 1024); } while (0)
#define LDB(dst, b, h) do { _Pragma("unroll") for (int n = 0; n < 2; ++n) _Pragma("unroll") for (int k = 0; k < 2; ++k) dst[n][k] = *(const LAS bf16x8*)(lds + G_SB(b, h) + boff + n * 2048 + k * 1024); } while (0)
#define MMA(ai, bj, At, Bq) do { __builtin_amdgcn_s_setprio(1); \
    _Pragma("unroll") for (int m = 0; m < 4; ++m) _Pragma("unroll") for (int n = 0; n < 2; ++n) _Pragma("unroll") for (int k = 0; k < 2; ++k) \
      acc[ai][bj][m][n] = __builtin_amdgcn_mfma_f32_16x16x32_bf16(Bq[n][k], At[m][k], acc[ai][bj][m][n], 0, 0, 0); \
    __builtin_amdgcn_s_setprio(0); } while (0)
#define WAIT_V(n) asm volatile("s_waitcnt vmcnt(" #n ")" ::: "memory")
#define WAIT_L(n) asm volatile("s_waitcnt lgkmcnt(" #n ")" ::: "memory")
#define BAR __builtin_amdgcn_s_barrier()
#define SCHED __builtin_amdgcn_sched_barrier(0)
    const int nM = M / BM, nN = N / BM, nwg = nM * nN, nunits = nwg * nparts;
    const int nt = K / BK / nparts;
    auto decode = [&](int L, int& brow, int& bcol, int& part, const char*& uA, const char*& uB) {
        part = L % nparts;
        int wgid = L / nparts;
        { const int q = nwg / NXCD, r = nwg % NXCD, xcd = wgid % NXCD, off = wgid / NXCD; wgid = (xcd < r ? xcd * (q + 1) : r * (q + 1) + (xcd - r) * q) + off; }
        const int nig = WGM * nN, gid = wgid / nig, fm = gid * WGM, gsz = min(nM - fm, WGM);
        const int pm = fm + ((wgid % nig) % gsz), pn = (wgid % nig) / gsz; brow = row0 + pm * BM; bcol = pn * BM;
        uA = (const char*)A + ((size_t)brow * K + (size_t)part * nt * BK) * 2; uB = (const char*)Bt + ((size_t)bcol * K + (size_t)part * nt * BK) * 2;
    };
    int L = blockIdx.x;
    if (L < nunits) {
        int brow, bcol, part; const char* cA; const char* cB;
        decode(L, brow, bcol, part, cA, cB);
        f32x4 acc[2][2][4][2];
#pragma unroll
        for (int a = 0; a < 2; ++a)
#pragma unroll
            for (int b = 0; b < 2; ++b)
#pragma unroll
                for (int m = 0; m < 4; ++m)
#pragma unroll
                    for (int n = 0; n < 2; ++n) acc[a][b][m][n] = (f32x4){0.f, 0.f, 0.f, 0.f};
        bf16x8 At[4][2], B0[2][2], B1[2][2];
        float rs[8];
        if constexpr (Epi::ROWSCALE) {
#pragma unroll
            for (int i = 0; i < 8; ++i) rs[i] = E.rstd[brow + (i >> 2) * HALF + wr * 64 + (i & 3) * 16 + fr];
        }
#if GEMM_SP2
        STAGE(G_SB(0, 0), cB); STAGE(G_SB(0, 1), cB + hstep); STAGE(G_SA(0, 0), cA); STAGE(G_SA(0, 1), cA + hstep);
        if (wr == 1) BAR;
        WAIT_V(2); BAR;
        STAGE(G_SB(1, 0), cB + 128); STAGE(G_SA(1, 0), cA + 128); STAGE(G_SB(1, 1), cB + hstep + 128);
        WAIT_V(6); BAR;
#else
        STAGE(G_SB(0, 0), cB); STAGE(G_SA(0, 0), cA);
        STAGE(G_SB(0, 1), cB + hstep); STAGE(G_SA(0, 1), cA + hstep);
        if (wr == 1) BAR;
        WAIT_V(4); BAR;
        STAGE(G_SB(1, 0), cB + 128); STAGE(G_SA(1, 0), cA + 128); STAGE(G_SB(1, 1), cB + hstep + 128);
        WAIT_V(6); BAR;
#endif
        for (;;) {
            const int Ln = L + (int)gridDim.x; const bool has_next = Ln < nunits;
            int nbrow = brow, nbcol = bcol, npart = part; const char* nA = cA; const char* nB = cB;
            if (has_next) decode(Ln, nbrow, nbcol, npart, nA, nB);
            for (int t = 0; t < nt; t += 2) {
                const bool last = (t == nt - 2);
                const char* a1 = cA + (size_t)(t + 1) * 128;
                const char* a2 = last ? nA : cA + (size_t)(t + 2) * 128; const char* b2 = last ? nB : cB + (size_t)(t + 2) * 128;
                const char* a3 = a2 + 128; const char* b3 = b2 + 128;
#if GEMM_SP2
                LDB(B0, 0, 0); LDB(B1, 0, 1); SCHED; LDA(At, 0, 0); STAGE(G_SA(1, 1), a1 + hstep);
                WAIT_V(8); WAIT_L(0); BAR; MMA(0, 0, At, B0); MMA(0, 1, At, B1); BAR; SCHED;
                LDA(At, 0, 1); STAGE(G_SB(0, 0), b2); STAGE(G_SB(0, 1), b2 + hstep); STAGE(G_SA(0, 0), a2);
                WAIT_V(8); WAIT_L(0); BAR; MMA(1, 0, At, B0); MMA(1, 1, At, B1); BAR; SCHED;
                LDB(B0, 1, 0); LDB(B1, 1, 1); SCHED; LDA(At, 1, 0); STAGE(G_SA(0, 1), a2 + hstep);
                WAIT_V(8); WAIT_L(0); BAR; MMA(0, 0, At, B0); MMA(0, 1, At, B1); BAR; SCHED;
                LDA(At, 1, 1); STAGE(G_SB(1, 0), b3); STAGE(G_SB(1, 1), b3 + hstep); STAGE(G_SA(1, 0), a3);
                WAIT_V(8); WAIT_L(0); BAR; MMA(1, 0, At, B0); MMA(1, 1, At, B1); BAR; SCHED;
#else
                LDB(B0, 0, 0); SCHED; LDA(At, 0, 0); STAGE(G_SA(1, 1), a1 + hstep);
                WAIT_L(8); BAR; WAIT_L(0); MMA(0, 0, At, B0); BAR; SCHED;
                LDB(B1, 0, 1); STAGE(G_SB(0, 0), b2);
                BAR; WAIT_L(0); MMA(0, 1, At, B1); BAR;
                LDA(At, 0, 1); STAGE(G_SA(0, 0), a2);
                BAR; WAIT_L(0); MMA(1, 0, At, B0); BAR; SCHED;
                STAGE(G_SB(0, 1), b2 + hstep);
                WAIT_V(6); BAR; MMA(1, 1, At, B1); BAR;
                LDB(B0, 1, 0); SCHED; LDA(At, 1, 0); STAGE(G_SA(0, 1), a2 + hstep);
                WAIT_L(8); BAR; WAIT_L(0); MMA(0, 0, At, B0); BAR; SCHED;
                LDB(B1, 1, 1); STAGE(G_SB(1, 0), b3);
                BAR; WAIT_L(0); MMA(0, 1, At, B1); BAR;
                LDA(At, 1, 1); STAGE(G_SA(1, 0), a3);
                BAR; WAIT_L(0); MMA(1, 0, At, B0); BAR; SCHED;
                STAGE(G_SB(1, 1), b3 + hstep);
                WAIT_V(6); BAR; MMA(1, 1, At, B1); BAR;
#endif
            }
            E(acc, brow, bcol, wr, wc, fr, fq, part, rs);
            if (!has_next) break;
#pragma unroll
            for (int a = 0; a < 2; ++a)
#pragma unroll
                for (int b = 0; b < 2; ++b)
#pragma unroll
                    for (int m = 0; m < 4; ++m)
#pragma unroll
                        for (int n = 0; n < 2; ++n) acc[a][b][m][n] = (f32x4){0.f, 0.f, 0.f, 0.f};
            L = Ln; brow = nbrow; bcol = nbcol; part = npart; cA = nA; cB = nB;
            if constexpr (Epi::ROWSCALE) {
#pragma unroll
                for (int i = 0; i < 8; ++i) rs[i] = E.rstd[brow + (i >> 2) * HALF + wr * 64 + (i & 3) * 16 + fr];
            }
        }
        WAIT_V(0);
        if (wr == 0) BAR;
        BAR;
    }
    __syncthreads();
#undef G_SA
#undef G_SB
#undef STAGE
#undef LDA
#undef LDB
#undef MMA
}

DEV void phase_even_a(const Params& p, const bf16_t* P, const float* EXT, float* QKV, float* GB, int tok_lo, int gw, int ngw, int lane) {
    const float* wconv = pin(15); const float* a_log = pin(16); const float* dt_bias = pin(17);
    for (int tok = tok_lo + gw; tok < NT; tok += ngw) {
        int t, base; const float* buf = nullptr;
        if (tok < NP) { t = tok % SEQ; base = tok - t; } else { t = (tok - NP) % DSQ; base = tok - t; buf = pin(3) + (size_t)((tok - NP) / DSQ) * 3 * 1536; }
        for (int seg = 0; seg < 3; ++seg) {
            const int c0 = seg * 512 + lane * 8;
            float y[8];
#pragma unroll
            for (int e = 0; e < 8; ++e) y[e] = 0.f;
            for (int j = 0; j < 4; ++j) {
                const int m = t - 3 + j; float xv[8];
                if (m >= 0) { const u32x4 r = *(const u32x4*)(P + (size_t)(base + m) * EV_N + c0);
                    xv[0] = bflo(r.x); xv[1] = bfhi(r.x); xv[2] = bflo(r.y); xv[3] = bfhi(r.y); xv[4] = bflo(r.z); xv[5] = bfhi(r.z); xv[6] = bflo(r.w); xv[7] = bfhi(r.w); }
                else if (buf) {
#pragma unroll
                    for (int e = 0; e < 8; ++e) xv[e] = buf[(size_t)(3 + m) * 1536 + c0 + e]; }
                else {
#pragma unroll
                    for (int e = 0; e < 8; ++e) xv[e] = 0.f; }
#pragma unroll
                for (int e = 0; e < 8; ++e) y[e] += wconv[j * 1536 + c0 + e] * xv[e];
            }
            float ss = 0.f;
#pragma unroll
            for (int e = 0; e < 8; ++e) { y[e] = siluf_(y[e]); ss += y[e] * y[e]; }
            if (seg < 2) {
                ss = sum16_(ss);
                const float r = rsqrtf(ss + 1e-6f) * (seg == 0 ? 0.08838834764831845f : 1.f);
#pragma unroll
                for (int e = 0; e < 8; ++e) y[e] *= r;
            }
#pragma unroll
            for (int e = 0; e < 8; ++e) QKV[(size_t)tok * 1536 + c0 + e] = y[e];
        }
        if (lane < 4) {
            const float b = EXT[(size_t)tok * 24 + lane], a = EXT[(size_t)tok * 24 + 4 + lane];
            GB[(size_t)tok * 8 + lane] = -__expf(a_log[lane]) * softplusf_(a + dt_bias[lane]);
            GB[(size_t)tok * 8 + 4 + lane] = sigmoidf_(b);
        }
    }
    const int gt = gw * 64 + lane, ngt = ngw * 64;
    for (int i = gt; i < 4 * 3 * 1536; i += ngt) { const int b = i / 4608, r = (i / 1536) % 3, c = i % 1536; pout()[O_CAP + i] = bf2f(P[(size_t)(b * SEQ + 4093 + r) * EV_N + c]); }
    for (int i = gt; i < 128 * 3 * 1536; i += ngt) { const int b = i / 4608, r = (i / 1536) % 3, c = i % 1536; pout()[O_CAS + i] = bf2f(P[(size_t)(NP + b * 8 + 5 + r) * EV_N + c]); }
}

DEV void delta_recurrence(const Params& p, const float* QKV, const float* GB, float* OB, LAS unsigned char* lds, int first_item, int item_stride, int n_items_lo, int n_items_hi) {
    LAS float* kqT = (LAS float*)lds;
    LAS float* red_kv = kqT + 8 * 512;
    LAS float* red_o = red_kv + 512;
    const int tid = opaque_tid(), part = tid >> 7, j = tid & 127;
    for (int item = first_item; item < n_items_hi; item += item_stride) {
        if (item < n_items_lo) continue;
        const int db = (item - 16) >> 2, h = (item - 16) & 3, base = NP + db * DSQ;
        const float* S0 = pin(2) + (size_t)(db * 4 + h) * 16384; float* Sout = pout() + O_DS + (size_t)(db * 4 + h) * 16384;
        float S[32];
#pragma unroll
        for (int i = 0; i < 32; ++i) S[i] = __builtin_nontemporal_load(S0 + (size_t)(part * 32 + i) * 128 + j);
        if (tid < 384) { const int seg = tid >> 7; const int src = seg == 0 ? 512 : (seg == 1 ? 0 : 1024);
            float x[DSQ];
#pragma unroll
            for (int t = 0; t < DSQ; ++t) x[t] = QKV[(size_t)(base + t) * 1536 + src + h * 128 + j];
#pragma unroll
            for (int t = 0; t < DSQ; ++t) kqT[t * 512 + tid] = x[t]; }
        else if (tid < 384 + 2 * DSQ) { const int t = (tid - 384) >> 1, w = (tid - 384) & 1; kqT[t * 512 + 384 + w] = GB[(size_t)(base + t) * 8 + w * 4 + h]; }
        __syncthreads();
        for (int t = 0; t < DSQ; ++t) {
            const size_t tok = (size_t)(base + t);
            LAS float* kq = kqT + t * 512;
            const float decay = __expf(kq[384]), beta = kq[385];
            float pk = 0.f;
#pragma unroll
            for (int i = 0; i < 32; ++i) { S[i] *= decay; pk += S[i] * kq[part * 32 + i]; }
            red_kv[part * 128 + j] = pk;
            lds_barrier();
            const float kvm = (red_kv[j] + red_kv[128 + j]) + (red_kv[256 + j] + red_kv[384 + j]);
            const float dl = beta * (kq[256 + j] - kvm);
            float po = 0.f;
#pragma unroll
            for (int i = 0; i < 32; ++i) { S[i] += kq[part * 32 + i] * dl; po += S[i] * kq[128 + part * 32 + i]; }
            red_o[part * 128 + j] = po;
            lds_barrier();
            if (part == 0) OB[tok * 512 + h * 128 + j] = (red_o[j] + red_o[128 + j]) + (red_o[256 + j] + red_o[384 + j]);
        }
#pragma unroll
        for (int i = 0; i < 32; ++i) __builtin_nontemporal_store(S[i], Sout + (size_t)(part * 32 + i) * 128 + j);
        __syncthreads();
    }
}

DEV bf16x8 lds_frag(LAS unsigned char* base, int row, int stride_b, int kbyte) { return *(const LAS bf16x8*)(base + row * stride_b + kbyte); }
DEV void phase_chunk_prep(const Params& p, const bf16_t* P, const float* EXT, unsigned char* ws, LAS unsigned char* lds) {
    constexpr int QS = 0, KS = 17408, VBT = 34816, KGT = 53248, KTT = 71680, AM = 90112, TM = 106752, GCS = 115968, BETAS = 116224, WCS = 116736;
    constexpr int RS = 272, TS = 144;
    const int tid = opaque_tid(), lane = tid & 63, wave = __builtin_amdgcn_readfirstlane(tid >> 6), fr = lane & 15, fq = lane >> 4;
    const float* wconv = pin(15); const float* a_log = pin(16); const float* dt_bias = pin(17);
    LAS float* gcs = (LAS float*)(lds + GCS); LAS float* betas = (LAS float*)(lds + BETAS); LAS float* Am = (LAS float*)(lds + AM);
    bf16_t* CW = (bf16_t*)(ws + WS_CW); bf16_t* CQ = (bf16_t*)(ws + WS_CQ); bf16_t* CKT = (bf16_t*)(ws + WS_CKT); float* CU = (float*)(ws + WS_CU);
    bf16_t* CI = (bf16_t*)(ws + WS_CI); float* CGL = (float*)(ws + WS_CGL);
    int h_staged = -1;
    for (int item = blockIdx.x; item < 1024; item += gridDim.x) {
        const int bh = item >> 6, n = item & 63, b = bh >> 2, h = bh & 3;
        const size_t ci = (size_t)item;
        if (h != h_staged) {
            for (int i = tid; i < 1536; i += NTHR) { const int sg = i >> 9, j = (i >> 7) & 3, ch = i & 127; ((LAS float*)(lds + WCS))[i] = wconv[j * 1536 + sg * 512 + h * 128 + ch]; }
            h_staged = h; }
        if (wave == 0) {
            const size_t tok = (size_t)b * SEQ + n * 64 + lane;
            const float a = EXT[tok * 24 + 4 + h], bb = EXT[tok * 24 + h];
            float g = -__expf(a_log[h]) * softplusf_(a + dt_bias[h]);
#pragma unroll
            for (int o = 1; o < 64; o <<= 1) { const float t = __shfl_up(g, o); if (lane >= o) g += t; }
            gcs[lane] = g; betas[lane] = sigmoidf_(bb);
            if (lane == 63) CGL[item] = g;
        }
        lds_barrier();
        {
            const int c = tid >> 3, part = tid & 7, t = n * 64 + c;
            const int csw = (((c >> 3) ^ part) << 4) + (c & 7) * 2;
            const float gc = gcs[c], beta = betas[c], glast = gcs[63];
            const float eg = __expf(gc), et = __expf(glast - gc);
#pragma unroll
            for (int seg = 0; seg < 3; ++seg) {
                const int ch0 = seg * 512 + h * 128 + part * 16;
                float y[16];
#pragma unroll
                for (int e = 0; e < 16; ++e) y[e] = 0.f;
#pragma unroll
                for (int j = 0; j < 4; ++j) {
                    const int m = t - 3 + j;
                    if (m >= 0) {
                        const u32x4 r0 = *(const u32x4*)(P + ((size_t)b * SEQ + m) * EV_N + ch0), r1 = *(const u32x4*)(P + ((size_t)b * SEQ + m) * EV_N + ch0 + 8);
                        const float x[16] = {bflo(r0.x), bfhi(r0.x), bflo(r0.y), bfhi(r0.y), bflo(r0.z), bfhi(r0.z), bflo(r0.w), bfhi(r0.w),
                                             bflo(r1.x), bfhi(r1.x), bflo(r1.y), bfhi(r1.y), bflo(r1.z), bfhi(r1.z), bflo(r1.w), bfhi(r1.w)};
                        const LAS float* wl = (const LAS float*)(lds + WCS) + (seg * 4 + j) * 128 + part * 16;
                        const f32x4 w0 = *(const LAS f32x4*)wl, w1 = *(const LAS f32x4*)(wl + 4), w2 = *(const LAS f32x4*)(wl + 8), w3 = *(const LAS f32x4*)(wl + 12);
                        const float wv[16] = {w0.x, w0.y, w0.z, w0.w, w1.x, w1.y, w1.z, w1.w, w2.x, w2.y, w2.z, w2.w, w3.x, w3.y, w3.z, w3.w};
#pragma unroll
                        for (int e = 0; e < 16; ++e) y[e] += wv[e] * x[e];
                    }
                }
                float ss = 0.f;
#pragma unroll
                for (int e = 0; e < 16; ++e) { y[e] = siluf_(y[e]); ss += y[e] * y[e]; }
                if (seg < 2) {
                    ss = sum8_(ss);
                    const float r = rsqrtf(ss + 1e-6f) * (seg == 0 ? 0.08838834764831845f : 1.f);
#pragma unroll
                    for (int e = 0; e < 16; ++e) y[e] *= r;
                }
                if (seg == 0) {
                    u32x4 a0, a1, d0, d1;
                    a0.x = pk2(y[0], y[1]); a0.y = pk2(y[2], y[3]); a0.z = pk2(y[4], y[5]); a0.w = pk2(y[6], y[7]);
                    a1.x = pk2(y[8], y[9]); a1.y = pk2(y[10], y[11]); a1.z = pk2(y[12], y[13]); a1.w = pk2(y[14], y[15]);
                    *(LAS u32x4*)(lds + QS + c * RS + part * 32) = a0; *(LAS u32x4*)(lds + QS + c * RS + part * 32 + 16) = a1;
                    d0.x = pk2(y[0] * eg, y[1] * eg); d0.y = pk2(y[2] * eg, y[3] * eg); d0.z = pk2(y[4] * eg, y[5] * eg); d0.w = pk2(y[6] * eg, y[7] * eg);
                    d1.x = pk2(y[8] * eg, y[9] * eg); d1.y = pk2(y[10] * eg, y[11] * eg); d1.z = pk2(y[12] * eg, y[13] * eg); d1.w = pk2(y[14] * eg, y[15] * eg);
                    { bf16_t* fb = CQ + ((((ci * 4 + (c >> 4)) * 4 + (part >> 1)) * 64 + (part & 1) * 32 + (c & 15)) << 3); *(u32x4*)fb = d0; *(u32x4*)(fb + 128) = d1; }
                } else if (seg == 1) {
                    u32x4 a0, a1;
                    a0.x = pk2(y[0], y[1]); a0.y = pk2(y[2], y[3]); a0.z = pk2(y[4], y[5]); a0.w = pk2(y[6], y[7]);
                    a1.x = pk2(y[8], y[9]); a1.y = pk2(y[10], y[11]); a1.z = pk2(y[12], y[13]); a1.w = pk2(y[14], y[15]);
                    *(LAS u32x4*)(lds + KS + c * RS + part * 32) = a0; *(LAS u32x4*)(lds + KS + c * RS + part * 32 + 16) = a1;
                    const float bg = beta * eg;
#pragma unroll
                    for (int e = 0; e < 16; ++e) { *(LAS bf16_t*)(lds + KGT + (part * 16 + e) * TS + csw) = (bf16_t)f2bf(y[e] * bg);
                                                   *(LAS bf16_t*)(lds + KTT + (part * 16 + e) * TS + csw) = (bf16_t)f2bf(y[e] * et); }
                } else {
#pragma unroll
                    for (int e = 0; e < 16; ++e) *(LAS bf16_t*)(lds + VBT + (part * 16 + e) * TS + csw) = (bf16_t)f2bf(y[e] * beta);
                }
            }
        }
        lds_barrier();
#pragma unroll
        for (int i = 0; i < 2; ++i) { const int id = tid + i * 512, row = id >> 3, s8 = id & 7;
            *(u32x4*)(CKT + ((((ci * 8 + (row >> 4)) * 2 + (s8 >> 2)) * 64 + (s8 & 3) * 16 + (row & 15)) << 3)) = *(const LAS u32x4*)(lds + KTT + row * TS + ((s8 ^ ((row >> 4) & 7)) << 4)); }
        {
            const int rt = wave >> 1;
#pragma unroll
            for (int ti = 0; ti < 2; ++ti) {
                const int ct = (wave & 1) * 2 + ti;
                f32x4 accK = {0.f, 0.f, 0.f, 0.f}, accQ = {0.f, 0.f, 0.f, 0.f};
#pragma unroll
                for (int k4 = 0; k4 < 4; ++k4) {
                    const bf16x8 aK = lds_frag(lds + KS, rt * 16 + fr, RS, k4 * 64 + fq * 16), aQ = lds_frag(lds + QS, rt * 16 + fr, RS, k4 * 64 + fq * 16), bK = lds_frag(lds + KS, ct * 16 + fr, RS, k4 * 64 + fq * 16);
                    accK = __builtin_amdgcn_mfma_f32_16x16x32_bf16(aK, bK, accK, 0, 0, 0);
                    accQ = __builtin_amdgcn_mfma_f32_16x16x32_bf16(bK, aQ, accQ, 0, 0, 0);
                }
                const int s = ct * 16 + fr; const float gs = gcs[s];
#pragma unroll
                for (int jj = 0; jj < 4; ++jj) { const int c_ = rt * 16 + fq * 4 + jj;
                    const float dm = s <= c_ ? __expf(gcs[c_] - gs) : 0.f;
                    Am[c_ * 65 + s] = s < c_ ? betas[c_] * accK[jj] * dm : 0.f; }
                { const int cq = rt * 16 + fr; const float gq = gcs[cq]; float iv[4];
#pragma unroll
                  for (int jj = 0; jj < 4; ++jj) { const int sq = ct * 16 + fq * 4 + jj; iv[jj] = sq <= cq ? accQ[jj] * __expf(gq - gcs[sq]) : 0.f; }
                  u32x2 w; w.x = pk2(iv[0], iv[1]); w.y = pk2(iv[2], iv[3]);
                  *(u32x2*)(CI + ((((ci * 4 + rt) * 2 + (ct >> 1)) * 64 + ((ct & 1) * 2 + (fq >> 1)) * 16 + fr) << 3) + (fq & 1) * 4) = w; }
            }
        }
        lds_barrier();
        {
            const int j = tid >> 3, pp = tid & 7;
            float Tr[8];
#pragma unroll
            for (int q = 0; q < 8; ++q) Tr[q] = 0.f;
#pragma unroll
            for (int i = 0; i < 64; ++i) {
                float s = 0.f;
#pragma unroll
                for (int q = 0; q < 8; ++q) if (8 * q < i) s += Am[i * 65 + pp + 8 * q] * Tr[q];
                s = sum8_(s);
                const float ti = (i == j ? 1.f : 0.f) - s;
                if (pp == (i & 7)) Tr[i >> 3] = ti;
            }
#pragma unroll
            for (int q = 0; q < 8; ++q) *(LAS bf16_t*)(lds + TM + (pp + 8 * q) * TS + j * 2) = (bf16_t)f2bf(Tr[q]);
        }
        lds_barrier();
        {
            const int rt = wave >> 1;
#pragma unroll
            for (int ti = 0; ti < 4; ++ti) {
                const int ct = (wave & 1) * 4 + ti;
                f32x4 accU = {0.f, 0.f, 0.f, 0.f}, accW = {0.f, 0.f, 0.f, 0.f};
#pragma unroll
                for (int k2 = 0; k2 < 2; ++k2) {
                    const bf16x8 a = lds_frag(lds + TM, rt * 16 + fr, TS, k2 * 64 + fq * 16), bU = lds_frag(lds + VBT, ct * 16 + fr, TS, ((k2 * 4 + fq) ^ ct) << 4), bW = lds_frag(lds + KGT, ct * 16 + fr, TS, ((k2 * 4 + fq) ^ ct) << 4);
                    accU = __builtin_amdgcn_mfma_f32_16x16x32_bf16(a, bU, accU, 0, 0, 0);
                    accW = __builtin_amdgcn_mfma_f32_16x16x32_bf16(bW, a, accW, 0, 0, 0);
                }
                *(f32x4*)(CU + ((((ci * 4 + rt) * 8 + ct) * 64 + lane) << 2)) = accU;
                { u32x2 w; w.x = pk2(accW[0], accW[1]); w.y = pk2(accW[2], accW[3]);
                  *(u32x2*)(CW + ((((ci * 4 + rt) * 4 + (ct >> 1)) * 64 + ((ct & 1) * 2 + (fq >> 1)) * 16 + fr) << 3) + (fq & 1) * 4) = w; }
            }
        }
        lds_barrier();
    }
}

struct ScanFrag { bf16x8 wA[4], qA[4], iA[2], kA[2]; f32x4 u[2]; float gl; };
DEV void scan_load(ScanFrag& f, const bf16_t* CW, const bf16_t* CQ, const bf16_t* CKT, const float* CU, const bf16_t* CI, const float* CGL, size_t ci, bool act, int wave, int sl, int lane) {
    if (act) {
#pragma unroll
        for (int k4 = 0; k4 < 4; ++k4) { f.wA[k4] = *(const bf16x8*)(CW + ((((ci * 4 + wave) * 4 + k4) * 64 + lane) << 3)); f.qA[k4] = *(const bf16x8*)(CQ + ((((ci * 4 + wave) * 4 + k4) * 64 + lane) << 3)); }
#pragma unroll
        for (int k2 = 0; k2 < 2; ++k2) f.iA[k2] = *(const bf16x8*)(CI + ((((ci * 4 + wave) * 2 + k2) * 64 + lane) << 3));
#pragma unroll
        for (int ct = 0; ct < 2; ++ct) f.u[ct] = *(const f32x4*)(CU + ((((ci * 4 + wave) * 8 + sl * 2 + ct) * 64 + lane) << 2));
    }
#pragma unroll
    for (int k2 = 0; k2 < 2; ++k2) f.kA[k2] = *(const bf16x8*)(CKT + ((((ci * 8 + wave) * 2 + k2) * 64 + lane) << 3));
    f.gl = CGL[ci];
}
DEV void phase_scan(const Params& p, unsigned char* ws, float* OB, LAS unsigned char* lds, int unit) {
    constexpr int ST = 0, VNT = 8704, SRS = 272, VRS = 144;
    const int tid = opaque_tid(), lane = tid & 63, wave = __builtin_amdgcn_readfirstlane(tid >> 6), fr = lane & 15, fq = lane >> 4;
    const int bh = (unit & 7) + 8 * (unit >> 5), sl = (unit >> 3) & 3, b = bh >> 2, h = bh & 3; const bool act = wave < 4;
    const bf16_t* CW = (const bf16_t*)(ws + WS_CW); const bf16_t* CQ = (const bf16_t*)(ws + WS_CQ); const bf16_t* CKT = (const bf16_t*)(ws + WS_CKT); const float* CU = (const float*)(ws + WS_CU);
    const bf16_t* CI = (const bf16_t*)(ws + WS_CI); const float* CGL = (const float*)(ws + WS_CGL);
    for (int i = tid; i < (8704 + 4608) / 4; i += NTHR) ((LAS unsigned*)lds)[i] = 0u;
    f32x4 accS[2] = {{0.f, 0.f, 0.f, 0.f}, {0.f, 0.f, 0.f, 0.f}};
    ScanFrag F0, F1, F2;
    scan_load(F0, CW, CQ, CKT, CU, CI, CGL, (size_t)bh * 64, act, wave, sl, lane);
    scan_load(F1, CW, CQ, CKT, CU, CI, CGL, (size_t)bh * 64 + 1, act, wave, sl, lane);
    __syncthreads();
    auto compute = [&](const ScanFrag& cur, int n) {
        f32x4 ao[2] = {{0.f, 0.f, 0.f, 0.f}, {0.f, 0.f, 0.f, 0.f}};
        if (act) {
            f32x4 av[2] = {{0.f, 0.f, 0.f, 0.f}, {0.f, 0.f, 0.f, 0.f}};
#pragma unroll
            for (int k4 = 0; k4 < 4; ++k4)
#pragma unroll
                for (int ct = 0; ct < 2; ++ct) { const bf16x8 bS = lds_frag(lds + ST, ct * 16 + fr, SRS, k4 * 64 + fq * 16);
                    av[ct] = __builtin_amdgcn_mfma_f32_16x16x32_bf16(cur.wA[k4], bS, av[ct], 0, 0, 0); ao[ct] = __builtin_amdgcn_mfma_f32_16x16x32_bf16(cur.qA[k4], bS, ao[ct], 0, 0, 0); }
#pragma unroll
            for (int ct = 0; ct < 2; ++ct) { u32x2 w; w.x = pk2(cur.u[ct][0] - av[ct][0], cur.u[ct][1] - av[ct][1]); w.y = pk2(cur.u[ct][2] - av[ct][2], cur.u[ct][3] - av[ct][3]);
                *(LAS u32x2*)(lds + VNT + (ct * 16 + fr) * VRS + (wave * 16 + fq * 4) * 2) = w; }
        }
        lds_barrier();
        if (act) {
#pragma unroll
            for (int ct = 0; ct < 2; ++ct) {
#pragma unroll
                for (int k2 = 0; k2 < 2; ++k2) { const bf16x8 bV = lds_frag(lds + VNT, ct * 16 + fr, VRS, k2 * 64 + fq * 16); ao[ct] = __builtin_amdgcn_mfma_f32_16x16x32_bf16(cur.iA[k2], bV, ao[ct], 0, 0, 0); }
#pragma unroll
                for (int jj = 0; jj < 4; ++jj) OB[((size_t)b * SEQ + n * 64 + wave * 16 + fq * 4 + jj) * 512 + h * 128 + sl * 32 + ct * 16 + fr] = ao[ct][jj];
            }
        }
        const float dec = __expf(cur.gl);
#pragma unroll
        for (int c2 = 0; c2 < 2; ++c2) {
            accS[c2] *= dec;
#pragma unroll
            for (int k2 = 0; k2 < 2; ++k2) { const bf16x8 bV = lds_frag(lds + VNT, c2 * 16 + fr, VRS, k2 * 64 + fq * 16); accS[c2] = __builtin_amdgcn_mfma_f32_16x16x32_bf16(cur.kA[k2], bV, accS[c2], 0, 0, 0); }
            u32x2 w; w.x = pk2(accS[c2][0], accS[c2][1]); w.y = pk2(accS[c2][2], accS[c2][3]);
            *(LAS u32x2*)(lds + ST + (c2 * 16 + fr) * SRS + (wave * 16 + fq * 4) * 2) = w;
        }
        lds_barrier();
    };
#define SCAN_STEP(n, CUR, NX2) do { if ((n) + 2 < 64) scan_load(NX2, CW, CQ, CKT, CU, CI, CGL, (size_t)bh * 64 + (n) + 2, act, wave, sl, lane); compute(CUR, (n)); } while (0)
    for (int n = 0; n < 63; n += 3) { SCAN_STEP(n, F0, F2); SCAN_STEP(n + 1, F1, F0); SCAN_STEP(n + 2, F2, F1); }
    SCAN_STEP(63, F0, F2);
#undef SCAN_STEP
    float* Sout = pout() + O_DP + (size_t)bh * 16384;
#pragma unroll
    for (int c2 = 0; c2 < 2; ++c2)
#pragma unroll
        for (int jj = 0; jj < 4; ++jj) Sout[(size_t)(wave * 16 + fq * 4 + jj) * 128 + sl * 32 + c2 * 16 + fr] = accS[c2][jj];
    __syncthreads();
}

DEV void phase_even_c(const Params& p, const bf16_t* P, const float* OB, bf16_t* MIX, int gw, int ngw, int lane) {
    const float* gn = pin(18); const float* wb = pin(19);
    float gnv[8], wbv[3][8];
#pragma unroll
    for (int e = 0; e < 8; ++e) { gnv[e] = gn[(lane * 8 + e) & 127];
#pragma unroll
        for (int j = 0; j < 3; ++j) wbv[j][e] = wb[j * 512 + lane * 8 + e]; }
    for (int tok = gw; tok < NT; tok += ngw) {
        int t, base; const float* buf = nullptr;
        if (tok < NP) { t = tok % SEQ; base = tok - t; } else { t = (tok - NP) % DSQ; base = tok - t; buf = pin(4) + (size_t)((tok - NP) / DSQ) * 2 * 512; }
        const int c0 = lane * 8;
        const f32x4 oa = *(const f32x4*)(OB + (size_t)tok * 512 + c0), ob = *(const f32x4*)(OB + (size_t)tok * 512 + c0 + 4);
        const u32x4 zr = *(const u32x4*)(P + (size_t)tok * EV_N + 1536 + c0);
        const u32x4 br = *(const u32x4*)(P + (size_t)tok * EV_N + 2560 + c0);
        u32x4 hrs[3], crs[3];
#pragma unroll
        for (int j = 0; j < 3; ++j) { const int m = t - 2 + j;
            if (m >= 0) { hrs[j] = *(const u32x4*)(P + (size_t)(base + m) * EV_N + 2048 + c0); crs[j] = *(const u32x4*)(P + (size_t)(base + m) * EV_N + 3072 + c0); }
            else { hrs[j] = (u32x4){0u, 0u, 0u, 0u}; crs[j] = hrs[j]; } }
        {
            float o[8] = {oa.x, oa.y, oa.z, oa.w, ob.x, ob.y, ob.z, ob.w}; float ss = 0.f;
#pragma unroll
            for (int e = 0; e < 8; ++e) ss += o[e] * o[e];
            ss = sum16_(ss);
            const float r = rsqrtf(ss * (1.f / 128.f) + 1e-6f);
            const float z[8] = {bflo(zr.x), bfhi(zr.x), bflo(zr.y), bfhi(zr.y), bflo(zr.z), bfhi(zr.z), bflo(zr.w), bfhi(zr.w)};
            float w[8];
#pragma unroll
            for (int e = 0; e < 8; ++e) w[e] = o[e] * r * gnv[e] * siluf_(z[e]);
            u32x4 st; st.x = pk2(w[0], w[1]); st.y = pk2(w[2], w[3]); st.z = pk2(w[4], w[5]); st.w = pk2(w[6], w[7]);
            *(u32x4*)(MIX + (size_t)tok * D + c0) = st;
        }
        {
            float y[8], cxl[8];
#pragma unroll
            for (int e = 0; e < 8; ++e) { y[e] = 0.f; cxl[e] = 0.f; }
#pragma unroll
            for (int j = 0; j < 3; ++j) {
                const int m = t - 2 + j; float cx[8];
                if (m >= 0) { const u32x4 hr = hrs[j]; const u32x4 cr = crs[j];
                    cx[0] = bflo(hr.x) * bflo(cr.x); cx[1] = bfhi(hr.x) * bfhi(cr.x); cx[2] = bflo(hr.y) * bflo(cr.y); cx[3] = bfhi(hr.y) * bfhi(cr.y);
                    cx[4] = bflo(hr.z) * bflo(cr.z); cx[5] = bfhi(hr.z) * bfhi(cr.z); cx[6] = bflo(hr.w) * bflo(cr.w); cx[7] = bfhi(hr.w) * bfhi(cr.w); }
                else if (buf) {
#pragma unroll
                    for (int e = 0; e < 8; ++e) cx[e] = buf[(size_t)(2 + m) * 512 + c0 + e]; }
                else {
#pragma unroll
                    for (int e = 0; e < 8; ++e) cx[e] = 0.f; }
#pragma unroll
                for (int e = 0; e < 8; ++e) { y[e] += wbv[j][e] * cx[e]; cxl[e] = cx[e]; }
            }
            const float gb[8] = {bflo(br.x), bfhi(br.x), bflo(br.y), bfhi(br.y), bflo(br.z), bfhi(br.z), bflo(br.w), bfhi(br.w)};
            u32x4 st; st.x = pk2(gb[0] * y[0], gb[1] * y[1]); st.y = pk2(gb[2] * y[2], gb[3] * y[3]); st.z = pk2(gb[4] * y[4], gb[5] * y[5]); st.w = pk2(gb[6] * y[6], gb[7] * y[7]);
            *(u32x4*)(MIX + (size_t)tok * D + 512 + c0) = st;
            if (tok < NP) { if (t >= SEQ - 2) {
#pragma unroll
                for (int e = 0; e < 8; ++e) pout()[O_CBP + (size_t)((tok / SEQ) * 2 + (t - (SEQ - 2))) * 512 + c0 + e] = cxl[e]; } }
            else if (t >= DSQ - 2) {
#pragma unroll
                for (int e = 0; e < 8; ++e) pout()[O_CBS + (size_t)(((tok - NP) / DSQ) * 2 + (t - (DSQ - 2))) * 512 + c0 + e] = cxl[e]; }
        }
    }
}

DEV void phase_odd_a(const Params& p, const bf16_t* P, const float* EXT, float* GATES, bf16_t* UG, bf16_t* VLN, int gw, int ngw, int lane, int tok_end) {
    const float* ln_g = pin(27); const float* ln_b = pin(28);
    float* out = pout();
    const f32x4 g0 = *(const f32x4*)(ln_g + lane * 8), g1 = *(const f32x4*)(ln_g + lane * 8 + 4), b0 = *(const f32x4*)(ln_b + lane * 8), b1 = *(const f32x4*)(ln_b + lane * 8 + 4);
    for (int tok = gw; tok < tok_end; tok += ngw) {
        const int c0 = lane * 8;
        const float ext = lane < 24 ? EXT[(size_t)tok * 24 + lane] : 0.f;
        u32x4 ka = {0u, 0u, 0u, 0u}, kb_ = ka;
        if (lane < 48) { ka = *(const u32x4*)(P + (size_t)tok * OD_N + 512 + lane * 16); kb_ = *(const u32x4*)(P + (size_t)tok * OD_N + 512 + lane * 16 + 8); }
        const u32x4 ur = *(const u32x4*)(P + (size_t)tok * OD_N + 1280 + c0); const u32x4 vr = *(const u32x4*)(P + (size_t)tok * OD_N + 1792 + c0);
        if (lane < 24) GATES[(size_t)tok * 24 + lane] = sigmoidf_(ext);
        if (lane < 48) {
            const int br = lane >> 4, idx = (lane & 15) * 16;
            float* dst = nullptr;
            if (tok < NP) { const int t = tok % SEQ;
                if (br == 0) dst = out + O_CMP + (size_t)tok * 256 + idx;
                else if (br == 1) dst = out + O_SLP + (size_t)tok * 256 + idx;
                else if (t >= SEQ - 512) dst = out + O_WNP + ((size_t)(tok / SEQ) * 512 + (t - (SEQ - 512))) * 256 + idx;
            } else { const int s = tok - NP;
                if (br == 0) dst = out + O_CMS + (size_t)s * 256 + idx;
                else if (br == 1) dst = out + O_SLS + (size_t)s * 256 + idx;
                else dst = out + O_WNS + ((size_t)(s / DSQ) * 512 + 504 + (s % DSQ)) * 256 + idx; }
            if (dst) { const u32x4 a = ka, b = kb_;
                __builtin_nontemporal_store((f32x4){bflo(a.x), bfhi(a.x), bflo(a.y), bfhi(a.y)}, (f32x4*)dst); __builtin_nontemporal_store((f32x4){bflo(a.z), bfhi(a.z), bflo(a.w), bfhi(a.w)}, (f32x4*)dst + 1);
                __builtin_nontemporal_store((f32x4){bflo(b.x), bfhi(b.x), bflo(b.y), bfhi(b.y)}, (f32x4*)dst + 2); __builtin_nontemporal_store((f32x4){bflo(b.z), bfhi(b.z), bflo(b.w), bfhi(b.w)}, (f32x4*)dst + 3); }
        }
        const float uu[8] = {bflo(ur.x), bfhi(ur.x), bflo(ur.y), bfhi(ur.y), bflo(ur.z), bfhi(ur.z), bflo(ur.w), bfhi(ur.w)};
        float vv[8] = {bflo(vr.x), bfhi(vr.x), bflo(vr.y), bfhi(vr.y), bflo(vr.z), bfhi(vr.z), bflo(vr.w), bfhi(vr.w)};
        float s = 0.f, ug[8];
#pragma unroll
        for (int e = 0; e < 8; ++e) { ug[e] = geluf_(uu[e]); vv[e] = geluf_(vv[e]); s += vv[e]; }
        { u32x4 w; w.x = pk2(ug[0], ug[1]); w.y = pk2(ug[2], ug[3]); w.z = pk2(ug[4], ug[5]); w.w = pk2(ug[6], ug[7]); *(u32x4*)(UG + (size_t)tok * 512 + c0) = w; }
        const float mu = wave_sum(s) * (1.f / 512.f); float q = 0.f;
#pragma unroll
        for (int e = 0; e < 8; ++e) { vv[e] -= mu; q += vv[e] * vv[e]; }
        const float r = rsqrtf(wave_sum(q) * (1.f / 512.f) + 1e-6f);
        const f32x4 o0 = (f32x4){vv[0], vv[1], vv[2], vv[3]} * r * g0 + b0, o1 = (f32x4){vv[4], vv[5], vv[6], vv[7]} * r * g1 + b1;
        { u32x4 w; w.x = pk2(o0[0], o0[1]); w.y = pk2(o0[2], o0[3]); w.z = pk2(o1[0], o1[1]); w.w = pk2(o1[2], o1[3]); *(u32x4*)(VLN + (size_t)tok * 512 + c0) = w; }
        if (tok >= NP) { ((f32x4*)(out + O_DV + (size_t)(tok - NP) * 512 + c0))[0] = o0; ((f32x4*)(out + O_DV + (size_t)(tok - NP) * 512 + c0))[1] = o1; }
    }
}
constexpr unsigned WINCOPY_N4 = 128u * 504u * 64u;
DEV void phase_win_copy(unsigned lo, unsigned hi) {
    const int tid = opaque_tid();
    const float* src_ = pin(7); float* out = pout();
    const unsigned n4 = hi;
    const unsigned step = NTHR;
    unsigned i0 = lo + tid;
    for (; i0 + 7u * step < n4; i0 += 8u * step) {
        f32x4 v[8];
#pragma unroll
        for (int u = 0; u < 8; ++u) { const unsigned i = i0 + u * step; const unsigned db = i / (504u * 64u), r = i % (504u * 64u); v[u] = __builtin_nontemporal_load((const f32x4*)(src_ + (size_t)db * 512 * 256 + 8 * 256) + r); }
#pragma unroll
        for (int u = 0; u < 8; ++u) { const unsigned i = i0 + u * step; const unsigned db = i / (504u * 64u), r = i % (504u * 64u); __builtin_nontemporal_store(v[u], (f32x4*)(out + O_WNS + (size_t)db * 512 * 256) + r); }
    }
    for (; i0 < n4; i0 += step) { const unsigned db = i0 / (504u * 64u), r = i0 % (504u * 64u); ((f32x4*)(out + O_WNS + (size_t)db * 512 * 256))[r] = ((const f32x4*)(src_ + (size_t)db * 512 * 256 + 8 * 256))[r]; }
}

DEV void phase_vtp(const bf16_t* P, bf16_t* VTP, LAS unsigned char* lds) {
    const int tid = opaque_tid();
    for (int item = blockIdx.x; item < 256; item += gridDim.x) {
        const int seq = item >> 6, tb = item & 63;
        { const int tok = tid >> 3, part = tid & 7, v = part >> 1, half = part & 1;
          const bf16_t* src_ = P + ((size_t)seq * SEQ + tb * 64 + tok) * OD_N + 512 + ((v >> 1) + 1) * 256 + 128 + (v & 1) * 64 + half * 32;
#pragma unroll
          for (int i = 0; i < 4; ++i) { const u32x4 w = *(const u32x4*)(src_ + i * 8); const unsigned ww[4] = {w.x, w.y, w.z, w.w};
#pragma unroll
              for (int e = 0; e < 4; ++e) { const int dh = half * 32 + i * 8 + 2 * e;
                  *(LAS bf16_t*)(lds + ((v * 64 + dh) * 72 + tok) * 2) = (bf16_t)(ww[e] & 0xffffu); *(LAS bf16_t*)(lds + ((v * 64 + dh + 1) * 72 + tok) * 2) = (bf16_t)(ww[e] >> 16); } } }
        lds_barrier();
#pragma unroll
        for (int i = 0; i < 4; ++i) { const int id = tid + i * 512, v = id >> 9, dh = (id >> 3) & 63, sg = id & 7;
            *(u32x4*)(VTP + ((size_t)(((v >> 1) * 4 + seq) * 2 + (v & 1)) * 64 + dh) * SEQ + tb * 64 + sg * 8) = *(const LAS u32x4*)(lds + ((v * 64 + dh) * 72 + sg * 8) * 2); }
        lds_barrier();
    }
}

struct RowRef { const float* f; const bf16_t* h; };
DEV float rr_get(const RowRef& r, int d) { return r.f ? r.f[d] : bf2f(r.h[d]); }
DEV RowRef kv_row(const Params& p, const bf16_t* P, int seqidx, int br, int kv, int g, int pos) {
    RowRef r; r.f = nullptr; r.h = nullptr;
    const int co = 512 + br * 256 + kv * 128 + g * 64;
    if (seqidx < 4) { r.h = P + ((size_t)seqidx * SEQ + pos) * OD_N + co; return r; }
    const int db = seqidx - 4;
    if (pos >= PAST) { r.h = P + ((size_t)NP + db * DSQ + (pos - PAST)) * OD_N + co; return r; }
    if (br == 2) { r.f = pin(7) + ((((size_t)db * 512 + (pos - (PAST - 512))) * 2 + kv) * 2 + g) * 64; return r; }
    const int page = ppt()[db * 16 + (pos >> 7)];
    r.f = (br == 0 ? pin(5) : pin(6)) + ((((size_t)page * 128 + (pos & 127)) * 2 + kv) * 2 + g) * 64;
    return r;
}
DEV size_t vct_off(int seqidx, int g) { return seqidx < 4 ? (size_t)(seqidx * 2 + g) * 64 * 256 : (size_t)4 * 2 * 64 * 256 + (size_t)((seqidx - 4) * 2 + g) * 64 * 128; }
DEV size_t kc_off(int seqidx, int g, int j) { return seqidx < 4 ? ((size_t)(seqidx * 2 + g) * 256 + j) * 64 : ((size_t)4 * 2 * 256 + (size_t)((seqidx - 4) * 2 + g) * 128 + j) * 64; }

DEV void phase_compress_naive(const Params& p, const bf16_t* P, float* KCF, LAS unsigned char* lds, int gw, int ngw, int lane, int wave) {
    LAS float* hid = (LAS float*)lds + wave * 128;
    const float* pe = pin(22); const float* w1 = pin(23); const float* w2 = pin(24);
    const int n_p = 4 * 2 * 255 * 2, n_s = 128 * 2 * 127 * 2;
    for (int it = gw; it < n_p + n_s; it += ngw) {
        int seqidx, g, j, kv;
        if (it < n_p) { kv = it & 1; int r = it >> 1; j = r % 255; r /= 255; g = r & 1; seqidx = r >> 1; }
        else { int r = it - n_p; kv = r & 1; r >>= 1; j = r % 127; r /= 127; g = r & 1; seqidx = 4 + (r >> 1); }
        float a0 = 0.f, a1 = 0.f;
        for (int s = 0; s < 32; ++s) {
            const RowRef rr = kv_row(p, P, seqidx, 0, kv, g, 16 * j + s);
            for (int d = 0; d < 64; ++d) {
                const float x = rr_get(rr, d) + pe[(size_t)(kv * 32 + s) * 64 + d];
                const float* wr_ = w1 + ((size_t)(kv * 32 + s) * 64 + d) * 128;
                a0 += x * wr_[lane]; a1 += x * wr_[lane + 64];
            }
        }
        hid[lane] = siluf_(a0); hid[lane + 64] = siluf_(a1);
        asm volatile("s_waitcnt lgkmcnt(0)" ::: "memory");
        float o = 0.f;
        for (int h = 0; h < 128; ++h) o += hid[h] * w2[(size_t)kv * 8192 + h * 64 + lane];
        KCF[(size_t)kv * KC_ELEMS + kc_off(seqidx, g, j) + lane] = o;
        asm volatile("s_waitcnt lgkmcnt(0)" ::: "memory");
    }
}

DEV void phase_attn_naive(const Params& p, const bf16_t* P, const float* KCF, const float* GATES, bf16_t* MIX, LAS unsigned char* lds, int gw, int ngw, int lane, int wave) {
    LAS float* qs = (LAS float*)lds + wave * 1216;
    LAS float* pbuf = qs + 64;
    LAS float* pc = pbuf + 1024;
    LAS int* blk = (LAS int*)pc;
    const float NEG = -1e30f;
    for (int it = gw; it < 4 * 2 * SEQ + 128 * 2 * DSQ; it += ngw) {
        int seqidx, g, ti, qpos, tok, nc, ns, wstart;
        if (it < 4 * 2 * SEQ) { ti = it % SEQ; const int r = it / SEQ; g = r & 1; seqidx = r >> 1; qpos = ti; tok = seqidx * SEQ + ti; nc = 255; ns = 64; wstart = 0; }
        else { const int r0 = it - 4 * 2 * SEQ; ti = r0 % DSQ; const int r = r0 / DSQ; g = r & 1; seqidx = 4 + (r >> 1); qpos = PAST + ti; tok = NP + (seqidx - 4) * DSQ + ti; nc = 127; ns = 33; wstart = PAST - 512; }
        const int cur = qpos >> 6;
        float imp = 0.f; float oc[4];
        for (int r = 0; r < 4; ++r) {
            const int h = g * 4 + r; const float slope = exp2f(-(float)(h + 1));
            qs[lane] = bf2f(P[(size_t)tok * OD_N + h * 64 + lane]) * 0.125f;
            asm volatile("s_waitcnt lgkmcnt(0)" ::: "memory");
            float sc[4]; float mx = NEG;
            for (int jj = 0; jj < 4; ++jj) { const int j = jj * 64 + lane; const bool ok = j < nc && 16 * j + 31 <= qpos; float s = NEG;
                if (ok) { const float* kr = KCF + kc_off(seqidx, g, j); s = 0.f; for (int d = 0; d < 64; ++d) s += qs[d] * kr[d]; s -= slope * (float)(qpos - (16 * j + 31)); }
                sc[jj] = s; mx = fmaxf(mx, s); }
            for (int o = 1; o < 64; o <<= 1) mx = fmaxf(mx, __shfl_xor(mx, o));
            float sum = 0.f;
            for (int jj = 0; jj < 4; ++jj) { sc[jj] = sc[jj] > -1e29f ? __expf(sc[jj] - mx) : 0.f; sum += sc[jj]; }
            sum = fmaxf(wave_sum(sum), 1e-30f);
            for (int jj = 0; jj < 4; ++jj) pbuf[jj * 64 + lane] = sc[jj] / sum;
            asm volatile("s_waitcnt lgkmcnt(0)" ::: "memory");
            float o = 0.f;
            for (int j = 0; j < nc; ++j) o += pbuf[j] * KCF[KC_ELEMS + kc_off(seqidx, g, j) + lane];
            oc[r] = o;
            for (int j = 4 * lane - 1; j <= 4 * lane + 3; ++j) if (j >= 0 && j < nc) {
                const int lo = max(16 * j, 64 * lane), hi = min(16 * j + 32, 64 * lane + 64); if (hi > lo) imp += pbuf[j] * ((float)(hi - lo) * (1.f / 32.f)); }
            asm volatile("s_waitcnt lgkmcnt(0)" ::: "memory");
        }
        const bool valid = lane < ns && lane <= cur; const bool forced = lane == 0 || lane == cur || lane == cur - 1;
        const float score = valid ? (forced ? 1e4f : imp) : NEG;
        int rank = 0;
        for (int s2 = 0; s2 < ns; ++s2) { const float o = __shfl(score, s2); rank += (o > score || (o == score && s2 < lane)) ? 1 : 0; }
        const unsigned long long selmask = __ballot(valid && rank < 16);
        if (lane == 0) { int n = 0; for (int s2 = 0; s2 < 64; ++s2) if ((selmask >> s2) & 1ull) blk[n++] = s2; for (; n < 16; ++n) blk[n] = -1; }
        asm volatile("s_waitcnt lgkmcnt(0)" ::: "memory");
        const int nsel = __popcll(selmask);
        for (int r = 0; r < 4; ++r) {
            const int h = g * 4 + r; const float slope = exp2f(-(float)(h + 1));
            qs[lane] = bf2f(P[(size_t)tok * OD_N + h * 64 + lane]) * 0.125f;
            asm volatile("s_waitcnt lgkmcnt(0)" ::: "memory");
            float res[2];
            for (int brn = 1; brn <= 2; ++brn) {
                const int wlo = max(wstart, qpos - 511);
                const int nkeys = brn == 1 ? nsel * 64 : (qpos - wlo + 1);
                float mx = NEG;
                for (int i0 = 0; i0 < nkeys; i0 += 64) { const int i = i0 + lane; float s = NEG;
                    if (i < nkeys) { const int pos = brn == 1 ? blk[i >> 6] * 64 + (i & 63) : wlo + i;
                        if (pos <= qpos) { const RowRef kr = kv_row(p, P, seqidx, brn, 0, g, pos); s = 0.f; for (int d = 0; d < 64; ++d) s += qs[d] * rr_get(kr, d); s -= slope * (float)(qpos - pos); } }
                    if (i < 1024) pbuf[i] = s; mx = fmaxf(mx, s); }
                for (int o = 1; o < 64; o <<= 1) mx = fmaxf(mx, __shfl_xor(mx, o));
                asm volatile("s_waitcnt lgkmcnt(0)" ::: "memory");
                float sum = 0.f;
                for (int i0 = 0; i0 < nkeys; i0 += 64) { const int i = i0 + lane; if (i < nkeys) { const float s = pbuf[i]; const float e = s > -1e29f ? __expf(s - mx) : 0.f; pbuf[i] = e; sum += e; } }
                sum = fmaxf(wave_sum(sum), 1e-30f);
                asm volatile("s_waitcnt lgkmcnt(0)" ::: "memory");
                float o = 0.f;
                for (int i = 0; i < nkeys; ++i) { const float e = pbuf[i]; if (e != 0.f) { const int pos = brn == 1 ? blk[i >> 6] * 64 + (i & 63) : wlo + i; const RowRef vr = kv_row(p, P, seqidx, brn, 1, g, pos); o += e * rr_get(vr, lane); } }
                res[brn - 1] = o / sum;
                asm volatile("s_waitcnt lgkmcnt(0)" ::: "memory");
            }
            const float* gt = GATES + (size_t)tok * 24 + h * 3;
            MIX[(size_t)tok * D + h * 64 + lane] = (bf16_t)f2bf(gt[0] * oc[r] + gt[1] * res[0] + gt[2] * res[1]);
        }
    }
}

template <bool SMP>
DEV void phase_compress(const Params& p, const bf16_t* P, unsigned char* ws, LAS unsigned char* lds, int first, int stride, int item_end) {
    constexpr int CA0 = 0, CA1 = 17920, PB = 35840, HID = 68608, ARS = 272;
    const int tid = opaque_tid(), lane = tid & 63, wave = __builtin_amdgcn_readfirstlane(tid >> 6), fr = lane & 15, fq = lane >> 4;
    const bf16_t* W1t = (const bf16_t*)(ws + WS_WC1); const bf16_t* W2t = (const bf16_t*)(ws + WS_WC2); const float* cb = (const float*)(ws + WS_CBIAS);
    const int srow = tid >> 3, piece = tid & 7, sl = piece >> 2, d0 = (piece & 3) * 16;
    const int q16 = tid & 15, segid = tid >> 4, slS = segid & 1, rS = segid >> 1;
    const int colbase = (wave < 4 ? 32 * wave : 128 + 32 * (wave - 4)), shift = wave < 4 ? 0 : 1;
    const bf16_t* W1w = W1t + ((size_t)colbase + fr) * 1024 + fq * 8;
    auto loadB = [&](bf16x8 (&bb)[4][2], int kvsel, int c8) {
#pragma unroll
        for (int k4 = 0; k4 < 4; ++k4)
#pragma unroll
            for (int ct = 0; ct < 2; ++ct) bb[k4][ct] = *(const bf16x8*)(W1w + ((size_t)kvsel * 256 + ct * 16) * 1024 + c8 * 128 + k4 * 32);
    };
    bf16x8 bA[4][2], bB[4][2];
    if (first < item_end) loadB(bA, first & 1, 0);
    for (int item = first; item < item_end; item += stride) {
        int kv, g, nb, seqidx, nh;
        if (!SMP) { kv = item & 1; g = (item >> 1) & 1; nb = (item >> 2) & 3; seqidx = item >> 4; nh = 256; }
        else { const int i2 = item - 64; kv = i2 & 1; g = (i2 >> 1) & 1; nb = (i2 >> 2) & 1; seqidx = 4 + (i2 >> 3); nh = 128; }
        const int nc = nh - 1;
        f32x4 acc[4][2];
#pragma unroll
        for (int rt = 0; rt < 4; ++rt)
#pragma unroll
            for (int ct = 0; ct < 2; ++ct) acc[rt][ct] = (f32x4){0.f, 0.f, 0.f, 0.f};
        auto mm = [&](LAS unsigned char* buf, bf16x8 (&bc)[4][2]) {
            __builtin_amdgcn_s_setprio(1);
#pragma unroll
            for (int k4 = 0; k4 < 4; ++k4) {
#pragma unroll
                for (int rt = 0; rt < 4; ++rt) { const bf16x8 a = lds_frag(buf, rt * 16 + fr + shift, ARS, k4 * 64 + fq * 16);
#pragma unroll
                    for (int ct = 0; ct < 2; ++ct) acc[rt][ct] = __builtin_amdgcn_mfma_f32_16x16x32_bf16(a, bc[k4][ct], acc[rt][ct], 0, 0, 0); }
            }
            __builtin_amdgcn_s_setprio(0);
        };
        if constexpr (SMP) {
            int pg[4];
#pragma unroll
            for (int i = 0; i < 4; ++i) pg[i] = ppt()[(seqidx - 4) * 16 + ((nb * 64 + i * 16 + rS) >> 3)];
            const bool has_e = nb * 64 + 64 < nh;
            const int page_e = has_e ? ppt()[(seqidx - 4) * 16 + ((nb * 64 + 64) >> 3)] : 0;
            const float* cbase = pin(5) + (size_t)(kv * 2 + g) * 64 + 4 * q16;
            auto fetchS = [&](int c8, f32x4 (&v)[4], f32x4& ve) {
                const int tap = 2 * c8 + slS;
#pragma unroll
                for (int i = 0; i < 4; ++i) { const int pos = 16 * (nb * 64 + i * 16 + rS) + tap; v[i] = *(const f32x4*)(cbase + ((size_t)pg[i] * 128 + (pos & 127)) * 256); }
                if (tid < 32) { if (has_e) { const int pos = 16 * (nb * 64 + 64) + tap; ve = *(const f32x4*)(cbase + ((size_t)page_e * 128 + (pos & 127)) * 256); } else ve = (f32x4){0.f, 0.f, 0.f, 0.f}; }
            };
            f32x4 ra[4], rb[4], ea, eb;
            fetchS(0, ra, ea); fetchS(1, rb, eb);
            auto chunkS = [&](int c8, f32x4 (&v)[4], f32x4& ve, bf16x8 (&bc)[4][2], bf16x8 (&bn)[4][2]) {
                LAS unsigned char* buf = lds + ((c8 & 1) ? CA1 : CA0);
#pragma unroll
                for (int i = 0; i < 4; ++i) { u32x2 w; w.x = pk2(v[i].x, v[i].y); w.y = pk2(v[i].z, v[i].w); *(LAS u32x2*)(buf + (i * 16 + rS) * ARS + (slS * 64 + 4 * q16) * 2) = w; }
                if (tid < 32) { u32x2 w; w.x = pk2(ve.x, ve.y); w.y = pk2(ve.z, ve.w); *(LAS u32x2*)(buf + 64 * ARS + (slS * 64 + 4 * q16) * 2) = w; }
                lds_barrier();
                if (c8 + 2 < 8) fetchS(c8 + 2, v, ve);
                loadB(bn, c8 == 7 ? ((item + stride) & 1) : kv, (c8 + 1) & 7);
                mm(buf, bc);
            };
            for (int c8 = 0; c8 < 8; c8 += 2) { chunkS(c8, ra, ea, bA, bB); chunkS(c8 + 1, rb, eb, bB, bA); }
        } else {
            auto fetchA = [&](int c8, int row, u32x4& o0, u32x4& o1) {
                const int n = nb * 64 + row;
                if (n >= nh) { o0 = (u32x4){0u, 0u, 0u, 0u}; o1 = o0; return; }
                const int pos = 16 * n + 2 * c8 + sl;
                const bf16_t* src_ = P + ((size_t)seqidx * SEQ + pos) * OD_N + 512 + kv * 128 + g * 64 + d0; o0 = *(const u32x4*)src_; o1 = *(const u32x4*)(src_ + 8);
            };
            u32x4 r0, r1, e0, e1, s0, s1, f0, f1;
            fetchA(0, srow, r0, r1); if (tid < 8) fetchA(0, 64, e0, e1);
            fetchA(1, srow, s0, s1); if (tid < 8) fetchA(1, 64, f0, f1);
            auto chunk = [&](int c8, u32x4& q0, u32x4& q1, u32x4& x0, u32x4& x1, bf16x8 (&bc)[4][2], bf16x8 (&bn)[4][2]) {
                LAS unsigned char* buf = lds + ((c8 & 1) ? CA1 : CA0);
                *(LAS u32x4*)(buf + srow * ARS + (sl * 64 + d0) * 2) = q0; *(LAS u32x4*)(buf + srow * ARS + (sl * 64 + d0) * 2 + 16) = q1;
                if (tid < 8) { *(LAS u32x4*)(buf + 64 * ARS + (sl * 64 + d0) * 2) = x0; *(LAS u32x4*)(buf + 64 * ARS + (sl * 64 + d0) * 2 + 16) = x1; }
                lds_barrier();
                if (c8 + 2 < 8) { fetchA(c8 + 2, srow, q0, q1); if (tid < 8) fetchA(c8 + 2, 64, x0, x1); }
                loadB(bn, c8 == 7 ? ((item + stride) & 1) : kv, (c8 + 1) & 7);
                mm(buf, bc);
            };
            for (int c8 = 0; c8 < 8; c8 += 2) { chunk(c8, r0, r1, e0, e1, bA, bB); chunk(c8 + 1, s0, s1, f0, f1, bB, bA); }
        }
        lds_barrier();
        LAS float* PBm = (LAS float*)(lds + PB);
        if (wave >= 4) {
#pragma unroll
            for (int rt = 0; rt < 4; ++rt)
#pragma unroll
                for (int ct = 0; ct < 2; ++ct)
#pragma unroll
                    for (int jj = 0; jj < 4; ++jj) PBm[(rt * 16 + fq * 4 + jj) * 128 + 32 * (wave - 4) + ct * 16 + fr] = acc[rt][ct][jj];
        }
        lds_barrier();
        if (wave < 4) {
#pragma unroll
            for (int rt = 0; rt < 4; ++rt)
#pragma unroll
                for (int ct = 0; ct < 2; ++ct) { const int hc = 32 * wave + ct * 16 + fr; const float bia = cb[kv * 128 + hc];
#pragma unroll
                    for (int jj = 0; jj < 4; ++jj) { const int i = rt * 16 + fq * 4 + jj;
                        *(LAS bf16_t*)(lds + HID + i * ARS + hc * 2) = (bf16_t)f2bf(siluf_(acc[rt][ct][jj] + PBm[i * 128 + hc] + bia)); } }
        }
        lds_barrier();
        {
            const int rt = wave >> 1;
            bf16_t* OUT = (bf16_t*)(ws + (kv == 0 ? WS_KC : WS_VC));
#pragma unroll
            for (int ti = 0; ti < 2; ++ti) { const int ct2 = (wave & 1) * 2 + ti; f32x4 a2 = {0.f, 0.f, 0.f, 0.f};
#pragma unroll
                for (int k4 = 0; k4 < 4; ++k4) { const bf16x8 a = lds_frag(lds + HID, rt * 16 + fr, ARS, k4 * 64 + fq * 16);
                    const bf16x8 b = *(const bf16x8*)(W2t + ((size_t)kv * 64 + ct2 * 16 + fr) * 128 + k4 * 32 + fq * 8);
                    a2 = __builtin_amdgcn_mfma_f32_16x16x32_bf16(a, b, a2, 0, 0, 0); }
                if (kv == 0) {
#pragma unroll
                    for (int jj = 0; jj < 4; ++jj) { const int j = nb * 64 + rt * 16 + fq * 4 + jj; if (j < nc) OUT[kc_off(seqidx, g, j) + ct2 * 16 + fr] = (bf16_t)f2bf(a2[jj]); }
                } else {
                    const int j0 = nb * 64 + rt * 16 + fq * 4;
                    u32x2 w; w.x = pk2(a2[0], a2[1]); w.y = pk2(a2[2], j0 + 3 < nc ? a2[3] : 0.f);
                    *(u32x2*)(OUT + vct_off(seqidx, g) + (size_t)(ct2 * 16 + fr) * nh + j0) = w;
                } }
        }
        lds_barrier();
    }
}

DEV void phase_compress_s(const Params& p, unsigned char* ws, LAS unsigned char* lds, int first, int stride, int item_end) {
    constexpr int CA0 = 0, CA1 = 18688, PB = 0, PBS = 132, HID = 67584, ARS = 144, HRS = 272;
    const int tid = opaque_tid(), lane = tid & 63, wave = __builtin_amdgcn_readfirstlane(tid >> 6), fr = lane & 15, fq = lane >> 4;
    const bf16_t* W1t = (const bf16_t*)(ws + WS_WC1); const bf16_t* W2t = (const bf16_t*)(ws + WS_WC2); const float* cb = (const float*)(ws + WS_CBIAS);
    const int q16 = tid & 15, r32 = tid >> 4;
    const int colbase = (wave < 4 ? 32 * wave : 128 + 32 * (wave - 4)), shift = wave < 4 ? 0 : 1;
    const bf16_t* W1w = W1t + ((size_t)colbase + fr) * 1024 + fq * 8;
    auto loadB = [&](bf16x8 (&bb)[2][2], int kvsel, int c16) {
#pragma unroll
        for (int k2 = 0; k2 < 2; ++k2)
#pragma unroll
            for (int ct = 0; ct < 2; ++ct) bb[k2][ct] = *(const bf16x8*)(W1w + ((size_t)kvsel * 256 + ct * 16) * 1024 + c16 * 64 + k2 * 32);
    };
    bf16x8 bA[2][2], bB[2][2];
    if (first < item_end) loadB(bA, first & 1, 0);
    if (tid < 18) { *(LAS u32x2*)(lds + CA0 + 128 * ARS + tid * 8) = (u32x2){0u, 0u}; *(LAS u32x2*)(lds + CA1 + 128 * ARS + tid * 8) = (u32x2){0u, 0u}; }
    for (int item = first; item < item_end; item += stride) {
        const int kv = item & 1, g = (item >> 1) & 1, seqidx = 4 + (item >> 2);
        constexpr int nh = 128, nc = 127;
        f32x4 acc[8][2];
#pragma unroll
        for (int rt = 0; rt < 8; ++rt)
#pragma unroll
            for (int ct = 0; ct < 2; ++ct) acc[rt][ct] = (f32x4){0.f, 0.f, 0.f, 0.f};
        int pg[4];
#pragma unroll
        for (int i = 0; i < 4; ++i) pg[i] = ppt()[(seqidx - 4) * 16 + ((i * 32 + r32) >> 3)];
        const float* cbase = pin(5) + (size_t)(kv * 2 + g) * 64 + 4 * q16;
        auto fetchS = [&](int c16, f32x4 (&v)[4]) {
#pragma unroll
            for (int i = 0; i < 4; ++i) { const int pos = 16 * (i * 32 + r32) + c16; v[i] = __builtin_nontemporal_load((const f32x4*)(cbase + ((size_t)pg[i] * 128 + (pos & 127)) * 256)); }
        };
        f32x4 ra[4], rb[4], rc[4];
        fetchS(0, ra); fetchS(1, rb); fetchS(2, rc);
        auto chunkS = [&](int c16, f32x4 (&v)[4], bf16x8 (&bc)[2][2], bf16x8 (&bn)[2][2]) {
            LAS unsigned char* buf = lds + ((c16 & 1) ? CA1 : CA0);
#pragma unroll
            for (int i = 0; i < 4; ++i) { u32x2 w; w.x = pk2(v[i].x, v[i].y); w.y = pk2(v[i].z, v[i].w); *(LAS u32x2*)(buf + (i * 32 + r32) * ARS + q16 * 8) = w; }
            lds_barrier();
            if (c16 + 3 < 16) fetchS(c16 + 3, v);
            loadB(bn, c16 == 15 ? ((item + stride) & 1) : kv, (c16 + 1) & 15);
#pragma unroll
            for (int k2 = 0; k2 < 2; ++k2) {
#pragma unroll
                for (int rt = 0; rt < 8; ++rt) { const bf16x8 a = lds_frag(buf, rt * 16 + fr + shift, ARS, k2 * 64 + fq * 16);
#pragma unroll
                    for (int ct = 0; ct < 2; ++ct) acc[rt][ct] = __builtin_amdgcn_mfma_f32_16x16x32_bf16(a, bc[k2][ct], acc[rt][ct], 0, 0, 0);
                    if ((rt & 3) == 3) __builtin_amdgcn_sched_barrier(0); }
            }
        };
        chunkS(0, ra, bA, bB); chunkS(1, rb, bB, bA); chunkS(2, rc, bA, bB); chunkS(3, ra, bB, bA); chunkS(4, rb, bA, bB); chunkS(5, rc, bB, bA); chunkS(6, ra, bA, bB); chunkS(7, rb, bB, bA);
        chunkS(8, rc, bA, bB); chunkS(9, ra, bB, bA); chunkS(10, rb, bA, bB); chunkS(11, rc, bB, bA); chunkS(12, ra, bA, bB); chunkS(13, rb, bB, bA); chunkS(14, rc, bA, bB); chunkS(15, ra, bB, bA);
        lds_barrier();
        LAS float* PBm = (LAS float*)(lds + PB);
        if (wave >= 4) {
#pragma unroll
            for (int rt = 0; rt < 8; ++rt)
#pragma unroll
                for (int ct = 0; ct < 2; ++ct)
#pragma unroll
                    for (int jj = 0; jj < 4; ++jj) PBm[(rt * 16 + fq * 4 + jj) * PBS + 32 * (wave - 4) + ct * 16 + fr] = acc[rt][ct][jj];
        }
        lds_barrier();
        if (wave < 4) {
#pragma unroll
            for (int rt = 0; rt < 8; ++rt)
#pragma unroll
                for (int ct = 0; ct < 2; ++ct) { const int hc = 32 * wave + ct * 16 + fr; const float bia = cb[kv * 128 + hc];
#pragma unroll
                    for (int jj = 0; jj < 4; ++jj) { const int i = rt * 16 + fq * 4 + jj;
                        *(LAS bf16_t*)(lds + HID + i * HRS + hc * 2) = (bf16_t)f2bf(siluf_(acc[rt][ct][jj] + PBm[i * PBS + hc] + bia)); } }
        }
        lds_barrier();
        {
            const int rt = wave;
            bf16_t* OUT = (bf16_t*)(ws + (kv == 0 ? WS_KC : WS_VC));
#pragma unroll
            for (int ct2 = 0; ct2 < 4; ++ct2) { f32x4 a2 = {0.f, 0.f, 0.f, 0.f};
#pragma unroll
                for (int k4 = 0; k4 < 4; ++k4) { const bf16x8 a = lds_frag(lds + HID, rt * 16 + fr, HRS, k4 * 64 + fq * 16);
                    const bf16x8 b = *(const bf16x8*)(W2t + ((size_t)kv * 64 + ct2 * 16 + fr) * 128 + k4 * 32 + fq * 8);
                    a2 = __builtin_amdgcn_mfma_f32_16x16x32_bf16(a, b, a2, 0, 0, 0); }
                if (kv == 0) {
#pragma unroll
                    for (int jj = 0; jj < 4; ++jj) { const int j = rt * 16 + fq * 4 + jj; if (j < nc) OUT[kc_off(seqidx, g, j) + ct2 * 16 + fr] = (bf16_t)f2bf(a2[jj]); }
                } else {
                    const int j0 = rt * 16 + fq * 4;
                    u32x2 w; w.x = pk2(a2[0], a2[1]); w.y = pk2(a2[2], j0 + 3 < nc ? a2[3] : 0.f);
                    *(u32x2*)(OUT + vct_off(seqidx, g) + (size_t)(ct2 * 16 + fr) * nh + j0) = w;
                } }
        }
        lds_barrier();
        if (tid < 18) { *(LAS u32x2*)(lds + CA0 + 128 * ARS + tid * 8) = (u32x2){0u, 0u}; *(LAS u32x2*)(lds + CA1 + 128 * ARS + tid * 8) = (u32x2){0u, 0u}; }
    }
    lds_barrier();
}

struct KVRegs { u32x4 k, v; };
DEV u32x4 load8(const RowRef& r, int seg) {
    if (r.h) return *(const u32x4*)(r.h + seg * 8);
    if (r.f) { const f32x4 a = *(const f32x4*)(r.f + seg * 8), b = *(const f32x4*)(r.f + seg * 8 + 4); u32x4 o; o.x = pk2(a.x, a.y); o.y = pk2(a.z, a.w); o.z = pk2(b.x, b.y); o.w = pk2(b.z, b.w); return o; }
    return (u32x4){0u, 0u, 0u, 0u};
}
constexpr int AT_BUF = 18432, AT_VT = 9216, AT_PW = 36864, AT_PSUM = 55296, AT_SELM = 88064, AT_PC = 88320, AT_RS = 144;
DEV void attn_scores(LAS unsigned char* kt, const bf16x8 (&Qf)[2], const f32x4 (&cb)[4], f32x4 (&s)[4], int fr, int fq) {
    __builtin_amdgcn_s_setprio(1);
#pragma unroll
    for (int ct = 0; ct < 4; ++ct) { f32x4 acc = cb[ct];
#pragma unroll
        for (int k2 = 0; k2 < 2; ++k2) acc = __builtin_amdgcn_mfma_f32_16x16x32_bf16(lds_frag(kt, ct * 16 + fr, AT_RS, k2 * 64 + fq * 16), Qf[k2], acc, 0, 0, 0);
        s[ct] = acc; }
    __builtin_amdgcn_s_setprio(0);
}
DEV void attn_softmax_pv(LAS unsigned char* vt, const f32x4 (&s)[4], f32x4 (&O)[4], f32x4& L, float& m, float b0, int fr, int fq) {
    float v = fmaxf(fmaxf(fmaxf(s[0][0], s[0][1]), fmaxf(s[0][2], s[0][3])), fmaxf(fmaxf(s[1][0], s[1][1]), fmaxf(s[1][2], s[1][3])));
    v = fmaxf(v, fmaxf(fmaxf(fmaxf(s[2][0], s[2][1]), fmaxf(s[2][2], s[2][3])), fmaxf(fmaxf(s[3][0], s[3][1]), fmaxf(s[3][2], s[3][3]))));
    v = xrow_max(v);
    const float mn = fmaxf(m, v + b0), alpha = __builtin_amdgcn_exp2f(m - mn), nb = b0 - mn; m = mn;
    float pv[4][4];
#pragma unroll
    for (int ct = 0; ct < 4; ++ct)
#pragma unroll
        for (int jj = 0; jj < 4; ++jj) pv[ct][jj] = __builtin_amdgcn_exp2f(s[ct][jj] + nb);
#pragma unroll
    for (int dt = 0; dt < 4; ++dt) O[dt] *= alpha;
    L *= alpha;
    const u32x4 one4 = {0x3F803F80u, 0x3F803F80u, 0x3F803F80u, 0x3F803F80u};
    __builtin_amdgcn_s_setprio(1);
#pragma unroll
    for (int ks = 0; ks < 2; ++ks) {
        u32x4 pb; pb.x = pk2(pv[2 * ks][0], pv[2 * ks][1]); pb.y = pk2(pv[2 * ks][2], pv[2 * ks][3]); pb.z = pk2(pv[2 * ks + 1][0], pv[2 * ks + 1][1]); pb.w = pk2(pv[2 * ks + 1][2], pv[2 * ks + 1][3]);
        const bf16x8 Pb = __builtin_bit_cast(bf16x8, pb);
#pragma unroll
        for (int dt = 0; dt < 4; ++dt) {
            const int lb = fr * AT_RS + ((((fq >> 1) ^ (fr >> 3)) & 1) << 4) + (fq & 1) * 8;
            const u32x2 a0 = *(const LAS u32x2*)(vt + dt * 16 * AT_RS + lb + (((ks ^ (dt >> 1)) * 4 + ((0 ^ (dt & 1)) * 2)) << 4)), a1 = *(const LAS u32x2*)(vt + dt * 16 * AT_RS + lb + (((ks ^ (dt >> 1)) * 4 + ((1 ^ (dt & 1)) * 2)) << 4));
            const u32x4 av = {a0.x, a0.y, a1.x, a1.y};
            O[dt] = __builtin_amdgcn_mfma_f32_16x16x32_bf16(__builtin_bit_cast(bf16x8, av), Pb, O[dt], 0, 0, 0);
        }
        L = __builtin_amdgcn_mfma_f32_16x16x32_bf16(__builtin_bit_cast(bf16x8, one4), Pb, L, 0, 0, 0);
    }
    __builtin_amdgcn_s_setprio(0);
}
DEV float row_sum4(float v) { return xrow_sum(v); }

struct AttnCtx {
    int seqidx, g, nc, nh, wstart; bool prompt;
    int pt_lane;
};
template <int BR>
DEV void attn_fetch(const Params& p, const bf16_t* P, const bf16_t* KC, const bf16_t* VCT, const bf16_t* VTP, const AttnCtx& c, int kb, int key, int seg, KVRegs& R, bool want_v) {
    const int lane_ = threadIdx.x & 63;
    if (BR == 0) {
        const int j = kb * 64 + key;
        R.k = j < c.nc ? *(const u32x4*)(KC + kc_off(c.seqidx, c.g, j) + seg * 8) : (u32x4){0u, 0u, 0u, 0u};
        if (want_v) R.v = *(const u32x4*)(VCT + vct_off(c.seqidx, c.g) + (size_t)key * c.nh + kb * 64 + seg * 8);
    } else {
        const int pos = kb * 64 + key;
        if (c.prompt) {
            R.k = *(const u32x4*)(P + ((size_t)c.seqidx * SEQ + pos) * OD_N + 512 + BR * 256 + c.g * 64 + seg * 8);
            R.v = *(const u32x4*)(VTP + ((size_t)(((BR - 1) * 4 + c.seqidx) * 2 + c.g) * 64 + key) * SEQ + kb * 64 + seg * 8);
        } else {
            if (pos >= PAST + DSQ) { R.k = (u32x4){0u, 0u, 0u, 0u}; R.v = R.k; }
            else if (pos >= PAST) { const bf16_t* b = P + ((size_t)NP + (c.seqidx - 4) * DSQ + (pos - PAST)) * OD_N + 512 + BR * 256 + c.g * 64 + seg * 8; R.k = *(const u32x4*)b; R.v = *(const u32x4*)(b + 128); }
            else {
                const float* b;
                if (BR == 2) b = pin(7) + (((size_t)(c.seqidx - 4) * 512 + (pos - (PAST - 512))) * 4 + c.g) * 64 + seg * 8;
                else { const int page = __shfl(c.pt_lane, (pos >> 7) | (lane_ & 48)); b = pin(6) + (((size_t)page * 128 + (pos & 127)) * 4 + c.g) * 64 + seg * 8; }
                const f32x4 k0 = *(const f32x4*)b, k1 = *(const f32x4*)(b + 4), v0 = *(const f32x4*)(b + 128), v1 = *(const f32x4*)(b + 132);
                R.k.x = pk2(k0.x, k0.y); R.k.y = pk2(k0.z, k0.w); R.k.z = pk2(k1.x, k1.y); R.k.w = pk2(k1.z, k1.w);
                R.v.x = pk2(v0.x, v0.y); R.v.y = pk2(v0.z, v0.w); R.v.z = pk2(v1.x, v1.y); R.v.w = pk2(v1.z, v1.w);
            }
        }
    }
}
DEV void attn_store(LAS unsigned char* buf, const KVRegs& r, int key, int seg, bool vtrans, bool want_v) {
    *(LAS u32x4*)(buf + key * AT_RS + seg * 16) = r.k;
    if (!want_v) return;
    if (vtrans) *(LAS u32x4*)(buf + AT_VT + key * AT_RS + seg * 16) = r.v;
    else { const unsigned w[4] = {r.v.x, r.v.y, r.v.z, r.v.w};
#pragma unroll
        for (int e = 0; e < 4; ++e) { *(LAS bf16_t*)(buf + AT_VT + (seg * 8 + 2 * e) * AT_RS + key * 2) = (bf16_t)(w[e] & 0xffffu); *(LAS bf16_t*)(buf + AT_VT + (seg * 8 + 2 * e + 1) * AT_RS + key * 2) = (bf16_t)(w[e] >> 16); } }
}

struct KV2 { u32x4 k0, v0, k1, v1; };
constexpr int A2_BUFSTRIDE_S = 36864, A2_PSUM = 73728, A2_SELM = 106496, A2_PC = 106752;
DEV u32x4 pack8(const float* b) { const f32x4 a = *(const f32x4*)b, c = *(const f32x4*)(b + 4); u32x4 o; o.x = pk2(a.x, a.y); o.y = pk2(a.z, a.w); o.z = pk2(c.x, c.y); o.w = pk2(c.z, c.w); return o; }
template <int BR>
DEV void attn_fetch2(const bf16_t* P, const bf16_t* KC, const bf16_t* VCT, const bf16_t* VTP, const AttnCtx& c, int kb, int key, int seg, u32x4& Rk0, u32x4& Rv0, u32x4& Rk1, u32x4& Rv1, bool want_v) {
    const int lane_ = threadIdx.x & 63;
    const u32x4 Z = {0u, 0u, 0u, 0u};
    if (c.prompt) {
        if (BR == 0) { const int j = kb * 64 + key;
            Rk0 = j < c.nc ? *(const u32x4*)(KC + kc_off(c.seqidx, c.g, j) + seg * 8) : Z;
            if (want_v) Rv0 = *(const u32x4*)(VCT + vct_off(c.seqidx, c.g) + (size_t)key * c.nh + kb * 64 + seg * 8); }
        else { const int pos = kb * 64 + key;
            Rk0 = *(const u32x4*)(P + ((size_t)c.seqidx * SEQ + pos) * OD_N + 512 + BR * 256 + c.g * 64 + seg * 8);
            Rv0 = *(const u32x4*)(VTP + ((size_t)(((BR - 1) * 4 + c.seqidx) * 2 + c.g) * 64 + key) * SEQ + kb * 64 + seg * 8); }
    } else {
        if (BR == 0) { const int j = kb * 64 + key;
            Rk0 = j < c.nc ? *(const u32x4*)(KC + kc_off(c.seqidx, 0, j) + seg * 8) : Z;
            Rk1 = j < c.nc ? *(const u32x4*)(KC + kc_off(c.seqidx, 1, j) + seg * 8) : Z;
            if (want_v) { const bf16_t* vb = VCT + vct_off(c.seqidx, 0) + (size_t)key * c.nh + kb * 64 + seg * 8;
                Rv0 = *(const u32x4*)vb; asm volatile("" : "+v"(Rv0));
                Rv1 = *(const u32x4*)(vb + 64 * 128); asm volatile("" : "+v"(Rv1)); } }
        else { const int pos = kb * 64 + key;
            if (pos >= PAST + DSQ) { Rk0 = Z; Rk1 = Z; Rv0 = Z; Rv1 = Z; }
            else if (pos >= PAST) { const bf16_t* b = P + ((size_t)NP + (c.seqidx - 4) * DSQ + (pos - PAST)) * OD_N + 512 + BR * 256 + seg * 8;
                Rk0 = *(const u32x4*)b; Rk1 = *(const u32x4*)(b + 64); Rv0 = *(const u32x4*)(b + 128); Rv1 = *(const u32x4*)(b + 192); }
            else { const float* b;
                if (BR == 2) b = pin(7) + ((size_t)(c.seqidx - 4) * 512 + (pos - (PAST - 512))) * 256 + seg * 8;
                else { const int page = __shfl(c.pt_lane, (pos >> 7) | (lane_ & 48)); b = pin(6) + ((size_t)page * 128 + (pos & 127)) * 256 + seg * 8; }
                Rk0 = pack8(b); Rk1 = pack8(b + 64); Rv0 = pack8(b + 128); Rv1 = pack8(b + 192); }
        }
    }
}
template <int BR>
DEV void attn_fetch1(const bf16_t* P, const bf16_t* KC, const bf16_t* VCT, const bf16_t* VTP, const AttnCtx& c, int g, int kb, int key, int seg, u32x4& Rk, u32x4& Rv, bool want_v) {
    const int lane_ = threadIdx.x & 63;
    const u32x4 Z = {0u, 0u, 0u, 0u};
    if (BR == 0) { const int j = kb * 64 + key;
        Rk = j < c.nc ? *(const u32x4*)(KC + kc_off(c.seqidx, g, j) + seg * 8) : Z;
        if (want_v) Rv = *(const u32x4*)(VCT + vct_off(c.seqidx, g) + (size_t)key * c.nh + kb * 64 + seg * 8);
    } else if (c.prompt) { const int pos = kb * 64 + key;
        Rk = *(const u32x4*)(P + ((size_t)c.seqidx * SEQ + pos) * OD_N + 512 + BR * 256 + g * 64 + seg * 8);
        Rv = *(const u32x4*)(VTP + ((size_t)(((BR - 1) * 4 + c.seqidx) * 2 + g) * 64 + key) * SEQ + kb * 64 + seg * 8);
    } else { const int pos = kb * 64 + key;
        if (pos >= PAST + DSQ) { Rk = Z; Rv = Z; }
        else if (pos >= PAST) { const bf16_t* b = P + ((size_t)NP + (c.seqidx - 4) * DSQ + (pos - PAST)) * OD_N + 512 + BR * 256 + g * 64 + seg * 8; Rk = *(const u32x4*)b; Rv = *(const u32x4*)(b + 128); }
        else { const float* b;
            if (BR == 2) b = pin(7) + ((size_t)(c.seqidx - 4) * 512 + (pos - (PAST - 512))) * 256 + g * 64 + seg * 8;
            else { const int page = __shfl(c.pt_lane, (pos >> 7) | (lane_ & 48)); b = pin(6) + ((size_t)page * 128 + (pos & 127)) * 256 + g * 64 + seg * 8; }
            Rk = pack8(b); Rv = pack8(b + 128); }
    }
}
DEV void attn_store1(LAS unsigned char* b, const u32x4& k, const u32x4& v, int key, int seg, bool vtrans, bool want_v) {
    *(LAS u32x4*)(b + key * AT_RS + seg * 16) = k;
    if (want_v) {
        if (vtrans) *(LAS u32x4*)(b + AT_VT + key * AT_RS + ((seg ^ ((key >> 3) & 7)) << 4)) = v;
        else { const unsigned w[4] = {v.x, v.y, v.z, v.w}; const int ksw = ((((key >> 3) ^ seg) & 7) << 4) + (key & 7) * 2;
#pragma unroll
            for (int e = 0; e < 4; ++e) { *(LAS bf16_t*)(b + AT_VT + (seg * 8 + 2 * e) * AT_RS + ksw) = (bf16_t)(w[e] & 0xffffu); *(LAS bf16_t*)(b + AT_VT + (seg * 8 + 2 * e + 1) * AT_RS + ksw) = (bf16_t)(w[e] >> 16); } }
    }
}
DEV void attn_store2(LAS unsigned char* buf, const u32x4& k0, const u32x4& v0, const u32x4& k1, const u32x4& v1, int key, int seg, bool vtrans, bool want_v, int nslots) {
    attn_store1(buf, k0, v0, key, seg, vtrans, want_v);
    if (nslots > 1) attn_store1(buf + 18432, k1, v1, key, seg, vtrans, want_v);
}

DEV void phase_attn(const Params& p, const bf16_t* P, const bf16_t* KC, const bf16_t* VCT, const bf16_t* VTP, const float* GATES, bf16_t* MIX, LAS unsigned char* lds) {
    const int tid = opaque_tid(), lane = tid & 63, wave = __builtin_amdgcn_readfirstlane(tid >> 6), fr = lane & 15, fq = lane >> 4;
    const int r = wave & 3, qsub = wave >> 2, key = tid >> 3, seg = tid & 7;
    LAS float* PSUM = (LAS float*)(lds + A2_PSUM);
    LAS float* PC = (LAS float*)(lds + A2_PC);
    LAS unsigned long long* SELM = (LAS unsigned long long*)(lds + A2_SELM);
    const float NEG = -1e30f;
    unsigned* qctr = (unsigned*)(pws() + WS_BAR) + 3520;
    LAS int* qslot = (LAS int*)(lds + 147456 - 1024 + 16);
#if PROFILE == 2
    LAS unsigned* TA = (LAS unsigned*)(lds + 147456 - 512) + 64;
    if (tid == 0) for (int i = 0; i < 16; ++i) TA[i] = 0;
    unsigned long long tprev = 0;
#define ASEC(k) do { if (tid == 0) { const unsigned long long tn = __builtin_amdgcn_s_memrealtime(); TA[k] += (unsigned)(tn - tprev); tprev = tn; } } while (0)
#define ACNT(k) do { if (tid == 0) TA[k] += 1; } while (0)
#else
#define ASEC(k)
#define ACNT(k)
#endif
    int xq = blockIdx.x & 7, ntried = 0; bool sample_done = false;
    for (;;) {
        if (tid == 0) {
            int q = -1;
            if (!sample_done) { const int v = (int)__hip_atomic_fetch_add(qctr, 1u, __ATOMIC_RELAXED, __HIP_MEMORY_SCOPE_AGENT); if (v < 128) q = v; }
            if (q < 0) { int x = xq, k = ntried;
                while (k < 8) { const int v = (int)__hip_atomic_fetch_add(qctr + 1 + x, 1u, __ATOMIC_RELAXED, __HIP_MEMORY_SCOPE_AGENT); if (v < 128) { q = 128 + x * 128 + v; break; } x = (x + 1) & 7; ++k; }
                q = q < 0 ? (1 << 20) : (q | (k << 24)); }
            *qslot = q;
        }
        lds_barrier();
        int q = *qslot;
        lds_barrier();
        if (q >= (1 << 20) && (q & ((1 << 24) - 1)) == (1 << 20)) break;
        if (q >= 128) { sample_done = true; const int k = q >> 24; q &= (1 << 24) - 1; xq = (xq + (k - ntried)) & 7; ntried = k; }
        ASEC(15);
        AttnCtx c; int t0, ns;
        if (q >= 128) { c.prompt = true; const int q2 = q - 128; const int qt = 127 - (q2 & 127); const int pr = q2 >> 7; c.g = pr & 1; c.seqidx = pr >> 1; t0 = qt * 32; c.nc = 255; c.nh = 256; ns = 64; c.wstart = 0; }
        else { c.prompt = false; c.g = qsub; c.seqidx = 4 + q; t0 = PAST; c.nc = 127; c.nh = 128; ns = 33; c.wstart = PAST - 512; }
        c.pt_lane = c.prompt ? 0 : ppt()[(c.seqidx - 4) * 16 + (lane & 15)];
        const bool prompt = c.prompt; const int seqidx = c.seqidx, g = c.g, nc = c.nc, wstart = c.wstart;
        const int bufstride = A2_BUFSTRIDE_S, myslot = qsub * 18432;
        const int gS0 = prompt ? g : 0, gS1 = prompt ? g : 1;
        const int h = g * 4 + r; const float slope = exp2f(-(float)(h + 1)) * 1.4426950408889634f;
        const int qmin = t0, qmax = prompt ? t0 + 31 : t0 + 7;
        const int qminH = prompt ? t0 + 16 * qsub : t0, qmaxH = prompt ? qminH + 15 : t0 + 7;
        int qpos, tokr; bool act;
        if (prompt) { qpos = t0 + qsub * 16 + fr; tokr = seqidx * SEQ + qpos; act = true; }
        else { const int tc = min(fr, 7); qpos = PAST + tc; tokr = NP + (seqidx - 4) * DSQ + tc; act = fr < 8; }
        bf16x8 Qf[2];
        { const size_t tq = prompt ? (size_t)seqidx * SEQ + t0 + qsub * 16 + fr : (size_t)NP + (seqidx - 4) * DSQ + min(fr, 7);
#pragma unroll
          for (int k2 = 0; k2 < 2; ++k2) { const u32x4 qv = *(const u32x4*)(P + tq * OD_N + h * 64 + k2 * 32 + fq * 8);
              u32x4 o; constexpr float QS = 0.125f * 1.4426950408889634f;
              o.x = pk2(bflo(qv.x) * QS, bfhi(qv.x) * QS); o.y = pk2(bflo(qv.y) * QS, bfhi(qv.y) * QS); o.z = pk2(bflo(qv.z) * QS, bfhi(qv.z) * QS); o.w = pk2(bflo(qv.w) * QS, bfhi(qv.w) * QS);
              Qf[k2] = __builtin_bit_cast(bf16x8, o); } }
        for (int i = tid; i < 8192; i += NTHR) PSUM[i] = 0.f;
        f32x4 outv[4];
#pragma unroll
        for (int ct = 0; ct < 4; ++ct) outv[ct] = (f32x4){0.f, 0.f, 0.f, 0.f};
        f32x4 O[4]; f32x4 L = {0.f, 0.f, 0.f, 0.f}; float m = -1e20f, inv = 0.f;
        u32x4 rk0 = {0u, 0u, 0u, 0u}, rv0 = rk0, rk1 = rk0, rv1 = rk0;
        unsigned long long selrow = 0ull, umaskA = 0ull, umaskB = 0ull, amask = 0ull;
        const int ntc = prompt ? min(4, ((qmax - 31) >> 4) / 64 + 1) : 2;
#pragma unroll
        for (int stage = 0; stage < 4; ++stage) {
            constexpr int dummy = 0; (void)dummy;
            const int BRs = stage == 0 || stage == 1 ? 0 : stage - 1;
            unsigned long long remA, remB;
            if (stage <= 1) { remA = (1ull << ntc) - 1ull; remB = remA; }
            else if (stage == 2) { remA = umaskA; remB = umaskB; }
            else { const int qa = t0, qb = prompt ? t0 + 16 : t0, ea = prompt ? t0 + 15 : t0 + 7, eb = prompt ? t0 + 31 : t0 + 7;
                   const int loA = max(wstart, qa - 511) >> 6, hiA = ea >> 6, loB = max(wstart, qb - 511) >> 6, hiB = eb >> 6;
                   remA = (hiA >= 63 ? ~0ull : ((1ull << (hiA + 1)) - 1ull)) & ~((1ull << loA) - 1ull); remB = (hiB >= 63 ? ~0ull : ((1ull << (hiB + 1)) - 1ull)) & ~((1ull << loB) - 1ull); }
            remA = __builtin_amdgcn_readfirstlane((unsigned)remA) | ((unsigned long long)__builtin_amdgcn_readfirstlane((unsigned)(remA >> 32)) << 32);
            remB = __builtin_amdgcn_readfirstlane((unsigned)remB) | ((unsigned long long)__builtin_amdgcn_readfirstlane((unsigned)(remB >> 32)) << 32);
            const bool want_v = stage != 1;
            const bool vtrans = BRs == 0 || prompt;
            if (stage != 1) {
#pragma unroll
                for (int ct = 0; ct < 4; ++ct) O[ct] = (f32x4){0.f, 0.f, 0.f, 0.f};
                m = -1e20f; L = (f32x4){0.f, 0.f, 0.f, 0.f};
            }
            f32x4 cb[4];
            { const float bstep = BRs == 0 ? 16.f * slope : slope;
#pragma unroll
              for (int ct = 0; ct < 4; ++ct)
#pragma unroll
                  for (int jj = 0; jj < 4; ++jj) cb[ct][jj] = bstep * (float)(fq * 4 + ct * 16 + jj); }
            if (remA | remB) {
                unsigned long long rfA = remA, rfB = remB;
                if (rfA) { const int kb0 = __builtin_ctzll(rfA); rfA &= rfA - 1ull; if (BRs == 0) attn_fetch1<0>(P, KC, VCT, VTP, c, gS0, kb0, key, seg, rk0, rv0, want_v); else if (BRs == 1) attn_fetch1<1>(P, KC, VCT, VTP, c, gS0, kb0, key, seg, rk0, rv0, want_v); else attn_fetch1<2>(P, KC, VCT, VTP, c, gS0, kb0, key, seg, rk0, rv0, want_v); attn_store1(lds, rk0, rv0, key, seg, vtrans, want_v); }
                if (rfB) { const int kb0 = __builtin_ctzll(rfB); rfB &= rfB - 1ull; if (BRs == 0) attn_fetch1<0>(P, KC, VCT, VTP, c, gS1, kb0, key, seg, rk1, rv1, want_v); else if (BRs == 1) attn_fetch1<1>(P, KC, VCT, VTP, c, gS1, kb0, key, seg, rk1, rv1, want_v); else attn_fetch1<2>(P, KC, VCT, VTP, c, gS1, kb0, key, seg, rk1, rv1, want_v); attn_store1(lds + 18432, rk1, rv1, key, seg, vtrans, want_v); }
                if (rfA) { const int kb1 = __builtin_ctzll(rfA); rfA &= rfA - 1ull; if (BRs == 0) attn_fetch1<0>(P, KC, VCT, VTP, c, gS0, kb1, key, seg, rk0, rv0, want_v); else if (BRs == 1) attn_fetch1<1>(P, KC, VCT, VTP, c, gS0, kb1, key, seg, rk0, rv0, want_v); else attn_fetch1<2>(P, KC, VCT, VTP, c, gS0, kb1, key, seg, rk0, rv0, want_v); }
                if (rfB) { const int kb1 = __builtin_ctzll(rfB); rfB &= rfB - 1ull; if (BRs == 0) attn_fetch1<0>(P, KC, VCT, VTP, c, gS1, kb1, key, seg, rk1, rv1, want_v); else if (BRs == 1) attn_fetch1<1>(P, KC, VCT, VTP, c, gS1, kb1, key, seg, rk1, rv1, want_v); else attn_fetch1<2>(P, KC, VCT, VTP, c, gS1, kb1, key, seg, rk1, rv1, want_v); }
                lds_barrier();
                int cur = 0;
                while (remA | remB) {
                    int kbA = -1, kbB = -1;
                    if (remA) { kbA = __builtin_ctzll(remA); remA &= remA - 1ull; }
                    if (remB) { kbB = __builtin_ctzll(remB); remB &= remB - 1ull; }
                    const int kb = qsub ? kbB : kbA;
                    ACNT(prompt ? 10 : 11);
                    LAS unsigned char* buf = lds + cur * bufstride + myslot;
                    if (kb >= 0 || stage == 1) {
                    f32x4 s[4];
                    attn_scores(buf, Qf, cb, s, fr, fq);
                    bool interior;
                    if (BRs == 0) interior = (kb * 64 + 63 < nc) && (16 * (kb * 64 + 63) + 31 <= qminH);
                    else if (BRs == 1) interior = ((amask >> kb) & 1ull) != 0ull && (kb * 64 + 63 <= qminH);
                    else interior = (kb * 64 + 63 <= qminH) && (qmaxH - kb * 64 <= 511) && (kb * 64 >= wstart);
                    const int col0 = kb * 64 + fq * 4;
                    const int kp0 = BRs == 0 ? 16 * col0 + 31 : col0;
                    const float b0 = slope * (float)(BRs == 0 ? 1024 * kb + 31 : 64 * kb);
                    if (!interior) {
                        asm volatile("; boundary tile" ::: "memory");
                        const int d0 = qpos - kp0;
                        const bool selok = BRs == 1 ? (((selrow >> kb) & 1ull) != 0ull) : true;
#pragma unroll
                        for (int ct = 0; ct < 4; ++ct)
#pragma unroll
                            for (int jj = 0; jj < 4; ++jj) {
                                const int c = ct * 16 + jj; bool ok;
                                if (BRs == 0) ok = (col0 + c < nc) && (d0 >= 16 * c);
                                else if (BRs == 1) ok = selok && (d0 >= c);
                                else ok = (d0 >= c) && (d0 < 512 + c) && (kp0 + c >= wstart);
                                s[ct][jj] = ok ? s[ct][jj] : NEG; }
                    }
                    if (stage != 1) attn_softmax_pv(buf + AT_VT, s, O, L, m, b0, fr, fq);
                    else {
#pragma unroll
                        for (int ct = 0; ct < 4; ++ct) { f32x4 pq;
#pragma unroll
                            for (int jj = 0; jj < 4; ++jj) pq[jj] = __builtin_amdgcn_exp2f(s[ct][jj] + (b0 - m)) * inv;
                            *(LAS f32x4*)(PC + (wave * 16 + fr) * 68 + ct * 16 + fq * 4) = pq; }
                        lds_barrier();
                        { const int q2 = tid >> 8, t2 = (tid >> 4) & 15, k0 = (tid & 15) * 4;
                          f32x4 a = *(const LAS f32x4*)(PC + ((q2 * 4 + 0) * 16 + t2) * 68 + k0);
                          a += *(const LAS f32x4*)(PC + ((q2 * 4 + 1) * 16 + t2) * 68 + k0); a += *(const LAS f32x4*)(PC + ((q2 * 4 + 2) * 16 + t2) * 68 + k0); a += *(const LAS f32x4*)(PC + ((q2 * 4 + 3) * 16 + t2) * 68 + k0);
                          *(LAS f32x4*)(PSUM + (q2 * 16 + t2) * 256 + kb * 64 + k0) = a; }
                    }
                    }
                    if (remA) { attn_store1(lds + (cur ^ 1) * bufstride, rk0, rv0, key, seg, vtrans, want_v);
                        if (rfA) { const int kbn = __builtin_ctzll(rfA); rfA &= rfA - 1ull; if (BRs == 0) attn_fetch1<0>(P, KC, VCT, VTP, c, gS0, kbn, key, seg, rk0, rv0, want_v); else if (BRs == 1) attn_fetch1<1>(P, KC, VCT, VTP, c, gS0, kbn, key, seg, rk0, rv0, want_v); else attn_fetch1<2>(P, KC, VCT, VTP, c, gS0, kbn, key, seg, rk0, rv0, want_v); } }
                    if (remB) { attn_store1(lds + (cur ^ 1) * bufstride + 18432, rk1, rv1, key, seg, vtrans, want_v);
                        if (rfB) { const int kbn = __builtin_ctzll(rfB); rfB &= rfB - 1ull; if (BRs == 0) attn_fetch1<0>(P, KC, VCT, VTP, c, gS1, kbn, key, seg, rk1, rv1, want_v); else if (BRs == 1) attn_fetch1<1>(P, KC, VCT, VTP, c, gS1, kbn, key, seg, rk1, rv1, want_v); else attn_fetch1<2>(P, KC, VCT, VTP, c, gS1, kbn, key, seg, rk1, rv1, want_v); } }
                    lds_barrier();
                    cur ^= 1;
                }
            }
            ASEC((prompt ? 0 : 5) + stage);
            if (stage == 0) {
                inv = 1.f / fmaxf(L[0], 1e-30f); const float gt = GATES[(size_t)tokr * 24 + h * 3 + 0] * inv;
#pragma unroll
                for (int ct = 0; ct < 4; ++ct) outv[ct] += gt * O[ct];
            } else if (stage == 1) {
                unsigned kq[4], T[4]; bool vld[4];
#pragma unroll
                for (int i = 0; i < 4; ++i) {
                    const int ql = wave * 4 + i, qs_ = ql >> 4, t_ = ql & 15;
                    const int qp = prompt ? t0 + ql : PAST + min(t_, 7); const int curb = qp >> 6;
                    float imp = 0.f;
#pragma unroll
                    for (int dj = -1; dj <= 3; ++dj) { const int j = 4 * lane + dj; if (j >= 0 && j < nc) { const int lo = max(16 * j, 64 * lane), hi = min(16 * j + 32, 64 * lane + 64); imp += PSUM[(qs_ * 16 + t_) * 256 + j] * ((float)(hi - lo) * (1.f / 32.f)); } }
                    const bool valid = lane < ns && lane <= curb; const bool forced = lane == 0 || lane == curb || lane == curb - 1;
                    const float score = lane < ns ? (valid ? (forced ? 1e4f : imp) : NEG) : -3e38f;
                    unsigned k_ = __float_as_uint(score); k_ ^= ((unsigned)((int)k_ >> 31)) | 0x80000000u;
                    kq[i] = k_; vld[i] = valid; T[i] = 0u;
                }
#pragma unroll
                for (int b = 31; b >= 0; --b)
#pragma unroll
                    for (int i = 0; i < 4; ++i) { const unsigned cand = T[i] | (1u << b); const unsigned long long bm = __builtin_amdgcn_ballot_w64(kq[i] >= cand); int cnt; asm("s_bcnt1_i32_b64 %0, %1" : "=s"(cnt) : "s"(bm) : "scc"); T[i] = cnt >= 16 ? cand : T[i]; }
#pragma unroll
                for (int i = 0; i < 4; ++i) {
                    const int ql = wave * 4 + i, t_ = ql & 15; const bool qact = prompt || t_ < 8;
                    const unsigned long long gtm = __ballot(kq[i] > T[i]), tie = __ballot(kq[i] == T[i]);
                    const int need = 16 - __popcll(gtm);
                    const int below = __builtin_amdgcn_mbcnt_hi((unsigned)(tie >> 32), __builtin_amdgcn_mbcnt_lo((unsigned)tie, 0u));
                    const unsigned long long msk = __ballot(vld[i] && (kq[i] > T[i] || (kq[i] == T[i] && below < need)));
                    if (lane == 0) SELM[ql] = qact ? msk : 0ull;
                }
                lds_barrier();
                { const bool lact = lane < 32 && (prompt || (lane & 15) < 8);
                  unsigned long long u = lane < 32 ? SELM[lane] : 0ull; unsigned long long a = lact ? u : ~0ull;
                  unsigned ul = (unsigned)u, uh = (unsigned)(u >> 32), al = (unsigned)a, ah = (unsigned)(a >> 32);
                  ul |= dpp_u<DPP_XOR1>(ul); uh |= dpp_u<DPP_XOR1>(uh); al &= dpp_u<DPP_XOR1>(al); ah &= dpp_u<DPP_XOR1>(ah);
                  ul |= dpp_u<DPP_XOR2>(ul); uh |= dpp_u<DPP_XOR2>(uh); al &= dpp_u<DPP_XOR2>(al); ah &= dpp_u<DPP_XOR2>(ah);
                  ul |= dpp_u<DPP_HMIRROR>(ul); uh |= dpp_u<DPP_HMIRROR>(uh); al &= dpp_u<DPP_HMIRROR>(al); ah &= dpp_u<DPP_HMIRROR>(ah);
                  ul |= dpp_u<DPP_MIRROR>(ul); uh |= dpp_u<DPP_MIRROR>(uh); al &= dpp_u<DPP_MIRROR>(al); ah &= dpp_u<DPP_MIRROR>(ah);
                  umaskA = (unsigned long long)(unsigned)__builtin_amdgcn_readlane((int)ul, 0) | ((unsigned long long)(unsigned)__builtin_amdgcn_readlane((int)uh, 0) << 32);
                  umaskB = (unsigned long long)(unsigned)__builtin_amdgcn_readlane((int)ul, 16) | ((unsigned long long)(unsigned)__builtin_amdgcn_readlane((int)uh, 16) << 32);
                  { const unsigned long long aA = (unsigned long long)(unsigned)__builtin_amdgcn_readlane((int)al, 0) | ((unsigned long long)(unsigned)__builtin_amdgcn_readlane((int)ah, 0) << 32);
                    const unsigned long long aB = (unsigned long long)(unsigned)__builtin_amdgcn_readlane((int)al, 16) | ((unsigned long long)(unsigned)__builtin_amdgcn_readlane((int)ah, 16) << 32);
                    amask = qsub ? aB : aA; }
                  selrow = SELM[qsub * 16 + fr]; }
                ASEC(prompt ? 4 : 9);
            } else {
                const float gt = GATES[(size_t)tokr * 24 + h * 3 + (stage - 1)] / fmaxf(L[0], 1e-30f);
#pragma unroll
                for (int ct = 0; ct < 4; ++ct) outv[ct] += gt * O[ct];
            }
        }
        if (act) {
#pragma unroll
            for (int dt = 0; dt < 4; ++dt) { u32x2 w; w.x = pk2(outv[dt][0], outv[dt][1]); w.y = pk2(outv[dt][2], outv[dt][3]);
                *(u32x2*)(MIX + (size_t)tokr * D + h * 64 + dt * 16 + fq * 4) = w; }
        }
        lds_barrier();
    }
}

DEV void phase_chunkmlp(const Params& p, unsigned char* ws, const bf16_t* UG, const bf16_t* VLN, bf16_t* MIX, LAS unsigned char* lds) {
    constexpr int VRS = 272;
    const int tid = opaque_tid(), lane = tid & 63, wave = __builtin_amdgcn_readfirstlane(tid >> 6), fr = lane & 15, fq = lane >> 4;
    const bf16_t* WDS = (const bf16_t*)(ws + WS_WDS); const float* bsd = pin(26);
    for (int item = blockIdx.x; item < 1024; item += gridDim.x) {
        const int g = item & 7, n = (item >> 3) & 31, b = item >> 8;
        const size_t tok0 = (size_t)b * SEQ + n * 128;
        const int nks = (16 * wave + 15) / 32 + 1;
        const int s = tid >> 2, part = tid & 3, tl = 16 * wave + fr;
        const bf16_t* src_ = VLN + (tok0 + s) * 512 + g * 64 + part * 16;
        const u32x4 va = *(const u32x4*)src_, vb = *(const u32x4*)(src_ + 8);
        bf16x8 wf[4];
#pragma unroll
        for (int k4 = 0; k4 < 4; ++k4) wf[k4] = k4 < nks ? *(const bf16x8*)(WDS + ((size_t)g * 128 + tl) * 128 + k4 * 32 + fq * 8) : (bf16x8){0, 0, 0, 0, 0, 0, 0, 0};
        f32x4 ug[4];
#pragma unroll
        for (int ct = 0; ct < 4; ++ct) { const u32x2 w = *(const u32x2*)(UG + (tok0 + tl) * 512 + g * 64 + ct * 16 + fq * 4); ug[ct] = (f32x4){bflo(w.x), bfhi(w.x), bflo(w.y), bfhi(w.y)}; }
        const float bb = bsd[g * 128 + tl];
        { const unsigned vw[8] = {va.x, va.y, va.z, va.w, vb.x, vb.y, vb.z, vb.w};
#pragma unroll
          for (int e = 0; e < 8; ++e) { *(LAS bf16_t*)(lds + (part * 16 + 2 * e) * VRS + s * 2) = (bf16_t)(vw[e] & 0xffffu); *(LAS bf16_t*)(lds + (part * 16 + 2 * e + 1) * VRS + s * 2) = (bf16_t)(vw[e] >> 16); } }
        lds_barrier();
        f32x4 acc[4];
#pragma unroll
        for (int ct = 0; ct < 4; ++ct) acc[ct] = (f32x4){0.f, 0.f, 0.f, 0.f};
        __builtin_amdgcn_s_setprio(1);
#pragma unroll
        for (int k4 = 0; k4 < 4; ++k4) if (k4 < nks) {
#pragma unroll
            for (int ct = 0; ct < 4; ++ct) acc[ct] = __builtin_amdgcn_mfma_f32_16x16x32_bf16(lds_frag(lds, ct * 16 + fr, VRS, k4 * 64 + fq * 16), wf[k4], acc[ct], 0, 0, 0);
        }
        __builtin_amdgcn_s_setprio(0);
#pragma unroll
        for (int ct = 0; ct < 4; ++ct) { u32x2 w; w.x = pk2(ug[ct][0] * (acc[ct][0] + bb), ug[ct][1] * (acc[ct][1] + bb)); w.y = pk2(ug[ct][2] * (acc[ct][2] + bb), ug[ct][3] * (acc[ct][3] + bb));
            *(u32x2*)(MIX + (tok0 + tl) * D + 512 + g * 64 + ct * 16 + fq * 4) = w; }
        lds_barrier();
    }
}

DEV void phase_chunkmlp_naive(const Params& p, const bf16_t* UG, const bf16_t* VLN, bf16_t* MIX, int tok_lo, int gw, int ngw, int lane) {
    const float* wsd = pin(25); const float* bsd = pin(26);
    const size_t gt = (size_t)gw * 64 + lane, ngt = (size_t)ngw * 64;
    for (size_t i = (size_t)tok_lo * 512 + gt; i < (size_t)NT * 512; i += ngt) {
        const int tok = (int)(i >> 9), ch = (int)(i & 511), g = ch >> 6;
        const int tc = tok < NP ? (tok % SEQ) & 127 : (tok - NP) % DSQ;
        float m = bsd[g * 128 + tc];
        const float* wr_ = wsd + ((size_t)g * 128 + tc) * 128;
        for (int s = 0; s <= tc; ++s) m += wr_[s] * bf2f(VLN[(size_t)(tok - tc + s) * 512 + ch]);
        MIX[(size_t)tok * D + 512 + ch] = (bf16_t)f2bf(bf2f(UG[i]) * m);
    }
}

#define XB_TMO      128
#define XB_XCNT(j)  (256  + 64 * (j))
#define XB_XSUB(j)  (1280 + 64 * (j))
#define XB_XGEN(j)  (2304 + 64 * (j))
#define XB_TOP      3328
#define XB_TOPGEN   3392
#define XCD_BAR_WORDS 3456
#define XB_SPIN_CAP (1u << 20)
DEV unsigned xb_ld(unsigned* p)              { return __hip_atomic_load(p, __ATOMIC_RELAXED, __HIP_MEMORY_SCOPE_AGENT); }
DEV unsigned xb_add(unsigned* p, unsigned v) { return __hip_atomic_fetch_add(p, v, __ATOMIC_RELAXED, __HIP_MEMORY_SCOPE_AGENT); }
DEV unsigned xb_xcc_id() { return (unsigned)__builtin_amdgcn_s_getreg((3 << 11) | 20) & 0xFu; }
#define XB_SPIN(cond, bar) do { unsigned _sp = 0; while (cond) { __builtin_amdgcn_s_sleep(1); \
    if ((++_sp & 255u) == 0u) { if (xb_ld(&(bar)[XB_TMO])) break; if (_sp > XB_SPIN_CAP) { atomicAdd(&(bar)[XB_TMO], 1u); break; } } } } while (0)
struct XcdBarrier { unsigned* bar; unsigned x; volatile LAS unsigned* st; };
DEV XcdBarrier xcd_barrier_post(unsigned* bar, volatile LAS unsigned* st) {
    XcdBarrier b; b.bar = bar; b.x = xb_xcc_id(); b.st = st;
    if (threadIdx.x == 0) (void)xb_add(&bar[XB_XCNT(b.x)], 1u);
    return b;
}
DEV void xcd_barrier_complete(unsigned* bar, unsigned x, unsigned& nloc, unsigned& nx) {
    const unsigned G = gridDim.x * gridDim.y * gridDim.z;
    unsigned sum, cnt, mine, sp = 0u;
    for (;;) {
        sum = 0u; cnt = 0u; mine = 0u;
#pragma unroll
        for (unsigned j = 0; j < 16; ++j) { const unsigned c = xb_ld(&bar[XB_XCNT(j)]); sum += c; cnt += (c > 0u) ? 1u : 0u; mine = (j == x) ? c : mine; }
        if (sum == G) break;
        __builtin_amdgcn_s_sleep(1);
        if ((++sp & 255u) == 0u) { if (xb_ld(&bar[XB_TMO])) break; if (sp > XB_SPIN_CAP) { atomicAdd(&bar[XB_TMO], 1u); break; } }
    }
    nloc = mine > 0u ? mine : 1u; nx = cnt > 0u ? cnt : 1u;
}
DEV void xcd_barrier(const XcdBarrier& b, LAS unsigned long long* stamp = nullptr) {
    asm volatile("s_waitcnt vmcnt(0)" ::: "memory");
    __syncthreads();
    if (threadIdx.x == 0) {
        unsigned* bar = b.bar;
        __builtin_amdgcn_s_waitcnt(0);
        unsigned nloc = b.st[0], nx = b.st[1];
        if (nloc == 0u) { xcd_barrier_complete(bar, b.x, nloc, nx); b.st[0] = nloc; b.st[1] = nx; }
        const unsigned old = xb_add(&bar[XB_XSUB(b.x)], 1u);
        const unsigned gen = old / nloc;
        if (old + 1u == (gen + 1u) * nloc) {
            __builtin_amdgcn_fence(__ATOMIC_RELEASE, "agent");
            asm volatile("s_waitcnt vmcnt(0)" ::: "memory");
            const unsigned og = xb_add(&bar[XB_TOP], 1u);
            const unsigned tg = og / nx;
            if (og + 1u == (tg + 1u) * nx) xb_add(&bar[XB_TOPGEN], 1u);
            else XB_SPIN(xb_ld(&bar[XB_TOPGEN]) == tg, bar);
            __builtin_amdgcn_fence(__ATOMIC_ACQUIRE, "agent");
            xb_add(&bar[XB_XGEN(b.x)], 1u);
            asm volatile("s_waitcnt vmcnt(0)" ::: "memory");
        } else {
            XB_SPIN(xb_ld(&bar[XB_XGEN(b.x)]) == gen, bar);
            __builtin_amdgcn_fence(__ATOMIC_ACQUIRE, "agent");
            asm volatile("s_waitcnt vmcnt(0)" ::: "memory");
        }
        if (stamp) *stamp = __builtin_amdgcn_s_memrealtime();
    }
    __syncthreads();
}

#if PROFILE == 3
#define PROF_T0() unsigned long long pt0_ = __builtin_amdgcn_s_memrealtime()
#define PROF_MAX(slot) do { const unsigned long long pt1_ = __builtin_amdgcn_s_memrealtime(); if (threadIdx.x == 0) atomicMax((unsigned*)(pws() + WS_BAR) + 3600 + (slot), (unsigned)(pt1_ - pt0_)); pt0_ = pt1_; } while (0)
#else
#define PROF_T0()
#define PROF_MAX(slot)
#endif
__global__ void __launch_bounds__(NTHR, 2) fwd_kernel(Params p) {
    extern __shared__ __attribute__((aligned(16))) unsigned char lds_raw[];
    LAS unsigned char* lds = (LAS unsigned char*)lds_raw;
    cg::grid_group grid = cg::this_grid();
    const int G = gridDim.x;
    if (threadIdx.x < 2) ((volatile LAS unsigned*)(lds + 147456 - 1024))[threadIdx.x] = 0u;
    if (threadIdx.x == 0) { LAS unsigned long long* t = (LAS unsigned long long*)(lds + PTAB_OFF);
#pragma unroll
        for (int i = 0; i < 29; ++i) t[i] = (unsigned long long)p.in[i];
        t[29] = (unsigned long long)p.out; t[30] = (unsigned long long)p.ws; }
    __syncthreads();
    const XcdBarrier xbar = xcd_barrier_post((unsigned*)(pws() + WS_BAR), (volatile LAS unsigned*)(lds + 147456 - 1024));
#define PH_IDS const int tid_ = opaque_tid(), lane = tid_ & 63, wave = __builtin_amdgcn_readfirstlane(tid_ >> 6), gw = blockIdx.x * 8 + wave, ngw = G * 8; (void)lane; (void)gw; (void)ngw
#define ws pws()
#define X ((float*)(pws() + WS_X))
#define H ((bf16_t*)(pws() + WS_H))
#define ACT ((bf16_t*)(pws() + WS_ACT))
#define Y ((float*)(pws() + WS_Y))
#define P ((bf16_t*)(pws() + WS_P))
#define EXT ((float*)(pws() + WS_EXT))
#define MIX ((bf16_t*)(pws() + WS_MIX))
#define OB ((float*)(pws() + WS_OB))
#define QKV ((float*)(pws() + WS_QKV))
#define GB ((float*)(pws() + WS_GB))
#define GATES ((float*)(pws() + WS_GATES))
#define UG ((bf16_t*)(pws() + WS_UG))
#define VLN ((bf16_t*)(pws() + WS_VLN))
#define YT ((float*)(pws() + WS_YT))
#define norm_g pin(9)
#define RSTD ((float*)(pws() + WS_RSTD))
#if PROFILE
    LAS unsigned long long* TS = (LAS unsigned long long*)(lds + 147456 - 512); int nst = 0;
    if (blockIdx.x == 0 && threadIdx.x == 0) TS[nst] = __builtin_amdgcn_s_memrealtime();
    ++nst;
#define GSYNC() do { xcd_barrier(xbar, TS + nst); ++nst; } while (0)
#define GSYNC_CG() do { grid.sync(); if (blockIdx.x == 0 && threadIdx.x == 0) TS[nst] = __builtin_amdgcn_s_memrealtime(); ++nst; } while (0)
#else
#define GSYNC() xcd_barrier(xbar)
#define GSYNC_CG() grid.sync()
#endif
#define FFN(mat) do { gemm_phase(lds, H, (const bf16_t*)(ws + WS_WGU) + (size_t)(mat) * 5632 * 1024, NT, 5632, 1024, EpiSwiglu{ACT, RSTD}); GSYNC(); \
                      gemm_phase(lds, ACT, (const bf16_t*)(ws + WS_WD) + (size_t)(mat) * 1024 * FF, NP, 1024, FF, EpiBf16{(bf16_t*)Y, D}); \
                      gemm_phase(lds, ACT, (const bf16_t*)(ws + WS_WD) + (size_t)(mat) * 1024 * FF, NS, 1024, FF, EpiBf16{(bf16_t*)YT - (size_t)NP * D, D, (size_t)NS * D}, NP, 11); GSYNC(); } while (0)

#if DEBUG_FILL
    { PH_IDS; for (size_t i = (size_t)gw * 64 + lane; i < O_END; i += (size_t)ngw * 64) pout()[i] = 0.f; }
#endif
    { PH_IDS; phase_prep(p, lds, gw, ngw, lane, wave); }
    { PH_IDS; RowNormArgs a{}; a.x_in_p = pin(0); a.x_in_s = pin(1); a.xb = H; a.write_x = true; a.rstd = RSTD; phase_rownorm(a, gw, ngw, lane); }
    GSYNC_CG();
    FFN(0);
    { PH_IDS; RowNormArgs a{}; a.Ysrc = Y; a.Yt = (const bf16_t*)YT; a.ntp = 11; a.g_post = norm_g + 1 * D; a.scale = 0.5f; a.xb = H; a.write_x = true; a.rstd = RSTD;
      phase_rownorm(a, gw, ngw, lane); }
    GSYNC();
    gemm_phase(lds, H, (const bf16_t*)(ws + WS_WEIN), NT, EV_N + 256, 1024, EpiInProj{P, EV_N, EV_N, EXT, 8, RSTD});
    GSYNC();
    { PROF_T0(); { PH_IDS; phase_even_a(p, P, EXT, QKV, GB, NP, gw, ngw, lane); } PROF_MAX(5);
    phase_chunk_prep(p, P, EXT, ws, lds); PROF_MAX(6); }
    GSYNC();
    { PROF_T0();
    if (blockIdx.x < 64) { phase_scan(p, ws, OB, lds, blockIdx.x); PROF_MAX(0); }
    else { delta_recurrence(p, QKV, GB, OB, lds, 16 + (int)blockIdx.x - 64, G - 64, 16, 16 + 512); PROF_MAX(1);
           phase_compress_s(p, ws, lds, (int)blockIdx.x - 64, G - 64, 512);
           { const int nS = G - 64, sidx = (int)blockIdx.x - 64, heavy = 512 % nS;
             const unsigned W = heavy ? (unsigned)(heavy + (nS - heavy) * 8) : (unsigned)nS;
             const unsigned c0 = !heavy || sidx < heavy ? (unsigned)sidx : (unsigned)(heavy + (sidx - heavy) * 8), c1 = c0 + (!heavy || sidx < heavy ? 1u : 8u);
             phase_win_copy((unsigned)((unsigned long long)WINCOPY_N4 * c0 / W), (unsigned)((unsigned long long)WINCOPY_N4 * c1 / W)); }
           PROF_MAX(7); } }
    GSYNC();
    { PH_IDS; phase_even_c(p, P, OB, MIX, gw, ngw, lane); }
    GSYNC();
    gemm_phase(lds, MIX, (const bf16_t*)(ws + WS_WEOUT), NP, 1024, 1024, EpiBf16{(bf16_t*)Y, D});
    gemm_phase(lds, MIX, (const bf16_t*)(ws + WS_WEOUT), NS, 1024, 1024, EpiBf16{(bf16_t*)YT - (size_t)NP * D, D, (size_t)NS * D}, NP, 4);
    GSYNC();
    { PH_IDS; RowNormArgs a{};  a.Ysrc = Y; a.Yt = (const bf16_t*)YT; a.ntp = 4; a.g_post = norm_g + 3 * D; a.scale = 1.f; a.xb = H; a.write_x = true; a.rstd = RSTD; phase_rownorm(a, gw, ngw, lane); }
    GSYNC();
    FFN(1);
    { PH_IDS; RowNormArgs a{};  a.Ysrc = Y; a.Yt = (const bf16_t*)YT; a.ntp = 11; a.g_post = norm_g + 5 * D; a.scale = 0.5f; a.xb = H; a.write_x = true; a.rstd = RSTD; phase_rownorm(a, gw, ngw, lane); }
    GSYNC();
    FFN(2);
    { PH_IDS; RowNormArgs a{};  a.Ysrc = Y; a.Yt = (const bf16_t*)YT; a.ntp = 11; a.g_post = norm_g + 7 * D; a.scale = 0.5f; a.xb = H; a.write_x = true; a.rstd = RSTD;
      phase_rownorm(a, gw, ngw, lane); }
    GSYNC();
    gemm_phase(lds, H, (const bf16_t*)(ws + WS_WOIN), NT, OD_N + 256, 1024, EpiInProj{P, OD_N, OD_N, EXT, 24, RSTD});
    GSYNC();
    { PROF_T0(); { PH_IDS; const int bid = (int)blockIdx.x, nc_ = min(64, (int)G);
        const unsigned W = (unsigned)(nc_ * 1 + ((int)G - nc_) * 7), c0 = (unsigned)(bid < nc_ ? bid * 1 : nc_ * 1 + (bid - nc_) * 7), c1 = c0 + (bid < nc_ ? 1u : 7u);
        const int lo = (int)((unsigned long long)NT * c0 / W), hi = (int)((unsigned long long)NT * c1 / W);
        phase_odd_a(p, P, EXT, GATES, UG, VLN, lo + wave, 8, lane, hi); } PROF_MAX(2); }
    { PROF_T0();
    phase_vtp(P, (bf16_t*)(ws + WS_VTP), lds); PROF_MAX(3);
    phase_compress<false>(p, P, ws, lds, blockIdx.x, G, 64); PROF_MAX(4); }
    GSYNC();

    phase_attn(p, P, (const bf16_t*)(ws + WS_KC), (const bf16_t*)(ws + WS_VC), (const bf16_t*)(ws + WS_VTP), GATES, MIX, lds);

    phase_chunkmlp(p, ws, UG, VLN, MIX, lds);
#if PROFILE == 2
    if (threadIdx.x == 0) { unsigned* W = (unsigned*)(pws() + WS_BAR) + 3600; LAS unsigned* TA = (LAS unsigned*)(lds + 147456 - 512) + 64; for (int i = 0; i < 12; ++i) atomicMax(W + i, TA[i]); }
#endif
    { PH_IDS; phase_chunkmlp_naive(p, UG, VLN, MIX, NP, gw, ngw, lane); }
    GSYNC();
    gemm_phase(lds, MIX, (const bf16_t*)(ws + WS_WOOUT), NP, 1024, 1024, EpiBf16{(bf16_t*)Y, D});
    gemm_phase(lds, MIX, (const bf16_t*)(ws + WS_WOOUT), NS, 1024, 1024, EpiBf16{(bf16_t*)YT - (size_t)NP * D, D, (size_t)NS * D}, NP, 4);
    GSYNC();
    { PH_IDS; RowNormArgs a{};  a.Ysrc = Y; a.Yt = (const bf16_t*)YT; a.ntp = 4; a.g_post = norm_g + 9 * D; a.scale = 1.f; a.xb = H; a.write_x = true; a.rstd = RSTD; phase_rownorm(a, gw, ngw, lane); }
    GSYNC();
    FFN(3);
    { PH_IDS; RowNormArgs a{};  a.Ysrc = Y; a.Yt = (const bf16_t*)YT; a.ntp = 11; a.g_post = norm_g + 11 * D; a.scale = 0.5f; a.xb = H; a.write_x = false; a.out_p = pout() + O_YP; a.out_s = pout() + O_YS; phase_rownorm(a, gw, ngw, lane); }
#if PROFILE == 3
    GSYNC();
    if (blockIdx.x == 127 && threadIdx.x < 12) {
        const unsigned tot = ((unsigned*)(pws() + WS_BAR))[3600 + threadIdx.x];
        const int cnt = (int)((tot + 500) / 1000);
        const size_t offs[12] = {O_YP, O_YS, O_DP, O_DS, O_CAP, O_CAS, O_CBP, O_CBS, O_CMP, O_CMS, O_SLP, O_SLS};
        for (int i = 0; i < cnt && i < 4000; ++i) ((unsigned*)pout())[offs[threadIdx.x] + i] = 0xAAAAAAAAu;
    }
#elif PROFILE == 2
    GSYNC();
    if (blockIdx.x == 127 && threadIdx.x < 12) {
        const unsigned tot = ((unsigned*)(pws() + WS_BAR))[3600 + threadIdx.x];
        const int cnt = threadIdx.x >= 10 ? (int)tot : (int)((tot + 500) / 1000);
        const size_t offs[12] = {O_YP, O_YS, O_DP, O_DS, O_CAP, O_CAS, O_CBP, O_CBS, O_CMP, O_CMS, O_SLP, O_SLS};
        for (int i = 0; i < cnt && i < 4000; ++i) ((unsigned*)pout())[offs[threadIdx.x] + i] = 0xAAAAAAAAu;
    }
#elif PROFILE
    GSYNC();
    if (blockIdx.x == 0 && threadIdx.x < 13) {
        const int cat_of[24] = {0, 1, 2, 4, 6, 8, 9, 10, 7, 3, 1, 2, 3, 1, 2, 5, 6, 11, 12, 7, 3, 1, 2, 3};
        unsigned long long tot = 0;
        for (int i = 0; i < 24; ++i) if (cat_of[i] == (int)threadIdx.x) tot += TS[i + 1] - TS[i];
        const int cnt = (int)((tot + 500) / 1000);
        const size_t offs[13] = {O_YP, O_YS, O_DP, O_DS, O_CAP, O_CAS, O_CBP, O_CBS, O_CMP, O_CMS, O_SLP, O_SLS, O_WNP};
        for (int i = 0; i < cnt && i < 4000; ++i) ((unsigned*)pout())[offs[threadIdx.x] + i] = 0xAAAAAAAAu;
    }
#endif
}

#undef ws
#undef X
#undef H
#undef ACT
#undef Y
#undef P
#undef EXT
#undef MIX
#undef OB
#undef QKV
#undef GB
#undef GATES
#undef UG
#undef VLN
#undef YT
#undef norm_g
#undef RSTD
extern "C" void kernel_launch(void* const* d_in, const int* in_sizes, int n_in, void* d_out, int out_size, void* d_ws, size_t ws_size, hipStream_t stream) {
    constexpr int LDS_BYTES = 147456;
    static int grid = 0;
    if (grid == 0) {
        int dev = 0, cus = 0, per_cu = 0;
        hipGetDevice(&dev);
        hipDeviceGetAttribute(&cus, hipDeviceAttributeMultiprocessorCount, dev);
        hipFuncSetAttribute((const void*)fwd_kernel, hipFuncAttributeMaxDynamicSharedMemorySize, LDS_BYTES);
        hipOccupancyMaxActiveBlocksPerMultiprocessor(&per_cu, (const void*)fwd_kernel, NTHR, LDS_BYTES);
        if (per_cu < 1) { fprintf(stderr, "occupancy query says %d blocks/CU\n", per_cu); per_cu = 1; }
        grid = cus;
        if (ws_size < WS_END) { fprintf(stderr, "workspace too small: %zu < %zu\n", ws_size, (size_t)WS_END); grid = -1; }
        if (n_in != 29) { fprintf(stderr, "expected 29 inputs, got %d\n", n_in); grid = -1; }
    }
    if (grid < 0) return;
    Params p{};
    for (int i = 0; i < 29; ++i) p.in[i] = (const float*)d_in[i];
    p.page_table = (const int*)d_in[8];
    p.out = (float*)d_out; p.ws = (unsigned char*)d_ws;
    (void)hipMemsetAsync((unsigned char*)d_ws + WS_BAR, 0, 16384, stream);
    void* args[] = {&p};
    hipError_t e = hipLaunchCooperativeKernel((const void*)fwd_kernel, dim3(grid), dim3(NTHR), args, LDS_BYTES, stream);
    if (e != hipSuccess) fprintf(stderr, "cooperative launch failed: %s (grid %d)\n", hipGetErrorString(e), grid);
}
```
